# Optimizing an MI355X kernel written in HIP

```python
import jax, jax.numpy as jnp
from jax import lax
import numpy as np

D_MODEL = 2048
BATCH = 2
SEQ = 4096
DEPTH = 4

HEAD_DIM = 128
Q_BLOCK = 128
EPS = 1e-6
ATTN_SCALE = HEAD_DIM ** -0.5
FOX_HEADS = 8
FOX_GATE_BIAS = 4.0
HGRN_HEADS = 8
HGRN_KDIM = 128
HGRN_VDIM = 128
HGRN_CHUNK = 64
NSA_HEADS = 16
NSA_KV_HEADS = 4
NSA_GROUP = NSA_HEADS // NSA_KV_HEADS
CMP_BLOCK = 32
CMP_STRIDE = 16
CMP_HIDDEN = 256
SLC_BLOCK = 64
SLC_TOPK = 16
SLC_Q_CHUNK = 16
WINDOW = 512
MEM_LEN = 256
MEM_HEADS = 4
MEM_W = MEM_HEADS * HEAD_DIM
FFN_HIDDEN = -(-8 * D_MODEL // (3 * 256)) * 256

FOX_W = FOX_HEADS * HEAD_DIM
HGRN_KW = HGRN_HEADS * HGRN_KDIM
HGRN_VW = HGRN_HEADS * HGRN_VDIM
EVEN_SIZES = [FOX_W, FOX_W, FOX_W, FOX_HEADS, HGRN_KW, HGRN_KW, HGRN_VW, HGRN_VW]
EVEN_IN = sum(EVEN_SIZES)
EVEN_SPLITS = [int(v) for v in np.cumsum(EVEN_SIZES)[:-1]]
EVEN_OUT = FOX_W + HGRN_VW
NSA_QW = NSA_HEADS * HEAD_DIM
NSA_KVW = NSA_KV_HEADS * HEAD_DIM
ODD_SIZES = [NSA_QW] + [NSA_KVW] * 6 + [3 * NSA_HEADS]
ODD_IN = sum(ODD_SIZES)
ODD_SPLITS = [int(v) for v in np.cumsum(ODD_SIZES)[:-1]]

kernel_name = 'fox_hgrn2_nsa_hybrid'


def rms_norm(x, gain):
    xf = x.astype(jnp.float32)
    y = xf * lax.rsqrt(jnp.mean(xf * xf, axis=-1, keepdims=True) + EPS)
    return (y * gain.astype(jnp.float32)).astype(x.dtype)


def split_heads(t, n):
    B, T, _ = t.shape
    return t.reshape(B, T, n, -1).transpose(0, 2, 1, 3)


def merge_heads(t):
    B, n, T, d = t.shape
    return t.transpose(0, 2, 1, 3).reshape(B, T, n * d)


def alibi_slopes(n):
    return 2.0 ** (-8.0 * jnp.arange(1, n + 1, dtype=jnp.float32) / n)


def masked_softmax(s, mask):
    s = jnp.where(mask, s.astype(jnp.float32), -jnp.inf)
    m = jnp.max(s, axis=-1, keepdims=True)
    m = jnp.where(jnp.isfinite(m), m, 0.0)
    p = jnp.exp(s - m)
    z = jnp.sum(p, axis=-1, keepdims=True)
    return p / jnp.where(z > 0, z, 1.0)


def forgetting_attention(q, k, v, log_f):
    B, H, T, d = q.shape
    c = jnp.cumsum(log_f, axis=-1)
    nb = T // Q_BLOCK
    qb = jnp.moveaxis(q.reshape(B, H, nb, Q_BLOCK, d), 2, 0)
    cb = jnp.moveaxis(c.reshape(B, H, nb, Q_BLOCK), 2, 0)
    kpos = jnp.arange(T)

    def block(args):
        qi, ci, i = args
        tq = i * Q_BLOCK + jnp.arange(Q_BLOCK)
        s = jnp.einsum('bhqd,bhkd->bhqk', qi, k, preferred_element_type=jnp.float32) * ATTN_SCALE
        s = s + ci[..., :, None] - c[..., None, :]
        s = jnp.where(tq[:, None] >= kpos[None, :], s, -jnp.inf)
        p = jax.nn.softmax(s, axis=-1)
        return jnp.einsum('bhqk,bhkd->bhqd', p, v.astype(jnp.float32))

    o = lax.map(block, (qb, cb, jnp.arange(nb)))
    return jnp.moveaxis(o, 0, 2).reshape(B, H, T, d)


def hgrn2_recurrence(q, k, v, log_f):
    B, H, T, dk = q.shape
    dv = v.shape[-1]
    C = HGRN_CHUNK
    nc = T // C

    def to_chunks(t):
        return jnp.moveaxis(t.reshape(B, H, nc, C, t.shape[-1]), 2, 0)

    causal = jnp.tril(jnp.ones((C, C), dtype=bool))[:, :, None]

    def step(S, inp):
        qi, ki, vi, gi = inp
        b = jnp.cumsum(gi, axis=2)
        diff = b[:, :, :, None, :] - b[:, :, None, :, :]
        decay = jnp.exp(jnp.where(causal, diff, -jnp.inf))
        A = jnp.einsum('bhtk,bhtsk,bhsk->bhts', qi, decay, ki)
        o = jnp.einsum('bhts,bhsv->bhtv', A, vi) + jnp.einsum('bhtk,bhkv->bhtv', qi * jnp.exp(b), S)
        b_last = b[:, :, -1:, :]
        S = jnp.exp(b_last[:, :, 0, :])[..., None] * S + jnp.einsum('bhsk,bhsv->bhkv', ki * jnp.exp(b_last - b), vi)
        return S, o

    S0 = jnp.zeros((B, H, dk, dv), jnp.float32)
    _, o = lax.scan(step, S0, tuple(to_chunks(t) for t in (q, k, v, log_f)))
    return jnp.moveaxis(o, 0, 2).reshape(B, H, T, dv)


def even_mixer(h, w_in, w_out, f_bias, q_gain, k_gain, lb, o_gain):
    f32 = jnp.float32
    fq, fk, fv, ff, hq, hf, hi, hg = jnp.split(h @ w_in, EVEN_SPLITS, axis=-1)
    q = rms_norm(split_heads(fq, FOX_HEADS), q_gain)
    k = rms_norm(split_heads(fk, FOX_HEADS), k_gain)
    v = split_heads(fv, FOX_HEADS)
    log_f_fox = jax.nn.log_sigmoid(ff.astype(f32) + f_bias.astype(f32)).transpose(0, 2, 1)
    o_fox = forgetting_attention(q, k, v, log_f_fox)
    z = split_heads(hf, HGRN_HEADS).astype(f32)
    lb_h = lb.astype(f32).reshape(HGRN_HEADS, 1, HGRN_KDIM)
    log_f = jnp.logaddexp(jnp.log(lb_h), jnp.log1p(-lb_h) + jax.nn.log_sigmoid(z))
    k_h = (1.0 - lb_h) * jax.nn.sigmoid(-z)
    q_h = jax.nn.silu(split_heads(hq, HGRN_HEADS).astype(f32))
    o_h = hgrn2_recurrence(q_h, k_h, split_heads(hi, HGRN_HEADS).astype(f32), log_f)
    o_h = rms_norm(o_h, o_gain) * jax.nn.silu(split_heads(hg, HGRN_HEADS).astype(f32))
    o = jnp.concatenate([merge_heads(o_fox), merge_heads(o_h)], axis=-1).astype(h.dtype)
    return o @ w_out


def compress_blocks(t, pe, w1, w2):
    T = t.shape[2]
    n_cmp = (T - CMP_BLOCK) // CMP_STRIDE + 1
    idx = (jnp.arange(n_cmp) * CMP_STRIDE)[:, None] + jnp.arange(CMP_BLOCK)[None, :]
    blocks = t[:, :, idx, :] + pe
    hid = jax.nn.gelu(jnp.einsum('bgnld,ldm->bgnm', blocks, w1))
    return jnp.einsum('bgnm,md->bgnd', hid, w2)


def nsa_mixer(h, w_in, w_out, q_gain, k_gain, pe_k, w1_k, w2_k, pe_v, w1_v, w2_v):
    B, T, _ = h.shape
    G, J, d = NSA_KV_HEADS, NSA_GROUP, HEAD_DIM
    f32 = jnp.float32
    q, kc, vc, ks, vs, kw, vw, gt = jnp.split(h @ w_in, ODD_SPLITS, axis=-1)
    q = rms_norm(q.reshape(B, T, G, J, d).transpose(0, 2, 3, 1, 4), q_gain)

    def kv_heads(t):
        return t.reshape(B, T, G, d).transpose(0, 2, 1, 3)

    k_cmp = rms_norm(compress_blocks(kv_heads(kc), pe_k, w1_k, w2_k), k_gain[0])
    v_cmp = compress_blocks(kv_heads(vc), pe_v, w1_v, w2_v).astype(f32)
    k_slc = rms_norm(kv_heads(ks), k_gain[1])
    v_slc = kv_heads(vs)
    k_win = rms_norm(kv_heads(kw), k_gain[2])
    v_win = kv_heads(vw)
    gates = jax.nn.sigmoid(gt.astype(f32)).reshape(B, T, G, J, 3).transpose(0, 2, 3, 1, 4)
    sl5 = alibi_slopes(NSA_HEADS).reshape(G, J)[None, :, :, None, None]

    n_cmp = (T - CMP_BLOCK) // CMP_STRIDE + 1
    cmp_start = jnp.arange(n_cmp) * CMP_STRIDE
    cmp_end = cmp_start + CMP_BLOCK - 1
    cmp_mid = cmp_start.astype(f32) + 0.5 * (CMP_BLOCK - 1)
    n_slc = T // SLC_BLOCK
    slc_start = jnp.arange(n_slc) * SLC_BLOCK
    overlap = ((cmp_start[:, None] <= slc_start[None, :] + SLC_BLOCK - 1)
               & (cmp_end[:, None] >= slc_start[None, :])).astype(f32)
    n_sel = min(SLC_TOPK, n_slc)
    k_win_p = jnp.pad(k_win, ((0, 0), (0, 0), (WINDOW, 0), (0, 0)))
    v_win_p = jnp.pad(v_win, ((0, 0), (0, 0), (WINDOW, 0), (0, 0))).astype(f32)
    band = jnp.arange(WINDOW + Q_BLOCK)
    blk = jnp.arange(n_slc)

    def query_block(i):
        t = i * Q_BLOCK + jnp.arange(Q_BLOCK)
        qi = lax.dynamic_slice_in_dim(q, i * Q_BLOCK, Q_BLOCK, axis=3)
        s = jnp.einsum('bgjqd,bgnd->bgjqn', qi, k_cmp, preferred_element_type=f32) * ATTN_SCALE
        s = s - sl5 * (t[:, None].astype(f32) - cmp_mid[None, :])
        p_cmp = masked_softmax(s, cmp_end[None, :] <= t[:, None])
        o_cmp = jnp.einsum('bgjqn,bgnd->bgjqd', p_cmp, v_cmp)
        imp = jnp.einsum('bgjqn,nm->bgqm', p_cmp, overlap)
        imp = jnp.where(slc_start[None, :] > t[:, None], -jnp.inf, imp)
        imp = jnp.where((blk[None, :] == (t // SLC_BLOCK)[:, None]) | (blk[None, :] == 0), jnp.inf, imp)
        _, idx = lax.top_k(imp, n_sel)
        kwi = lax.dynamic_slice_in_dim(k_win_p, i * Q_BLOCK, WINDOW + Q_BLOCK, axis=2)
        vwi = lax.dynamic_slice_in_dim(v_win_p, i * Q_BLOCK, WINDOW + Q_BLOCK, axis=2)
        kpos = i * Q_BLOCK - WINDOW + band
        dist = t[:, None] - kpos[None, :]
        s = jnp.einsum('bgjqd,bgkd->bgjqk', qi, kwi, preferred_element_type=f32) * ATTN_SCALE
        s = s - sl5 * dist.astype(f32)
        p_win = masked_softmax(s, (dist >= 0) & (dist < WINDOW) & (kpos[None, :] >= 0))
        o_win = jnp.einsum('bgjqk,bgkd->bgjqd', p_win, vwi)
        return o_cmp, o_win, idx.astype(jnp.int32)

    nb = T // Q_BLOCK
    o_cmp, o_win, idx = lax.map(query_block, jnp.arange(nb))
    o_cmp = jnp.moveaxis(o_cmp, 0, 3).reshape(B, G, J, T, d)
    o_win = jnp.moveaxis(o_win, 0, 3).reshape(B, G, J, T, d)
    idx = jnp.moveaxis(idx, 0, 2).reshape(B, G, T, n_sel)

    c = SLC_Q_CHUNK
    n_sc = T // c
    ks_blocks = k_slc.reshape(B, G, n_slc, SLC_BLOCK, d)
    vs_blocks = v_slc.reshape(B, G, n_slc, SLC_BLOCK, d)
    q_ch = jnp.moveaxis(q.reshape(B, G, J, n_sc, c, d), 3, 0)
    idx_ch = jnp.moveaxis(idx.reshape(B, G, n_sc, c, n_sel), 2, 0)
    bi = jnp.arange(B)[:, None, None, None]
    gi = jnp.arange(G)[None, :, None, None]
    inner = jnp.arange(SLC_BLOCK)
    M = n_sel * SLC_BLOCK

    def select_chunk(args):
        qj, ij, j = args
        t = j * c + jnp.arange(c)
        kg = ks_blocks[bi, gi, ij].reshape(B, G, c, M, d)
        vg = vs_blocks[bi, gi, ij].reshape(B, G, c, M, d).astype(f32)
        kpos = (ij[..., None] * SLC_BLOCK + inner).reshape(B, G, c, M)
        dist = t[None, None, :, None] - kpos
        s = jnp.einsum('bgjcd,bgcmd->bgjcm', qj, kg, preferred_element_type=f32) * ATTN_SCALE
        s = s - sl5 * dist[:, :, None].astype(f32)
        p = masked_softmax(s, (dist >= 0)[:, :, None])
        return jnp.einsum('bgjcm,bgcmd->bgjcd', p, vg)

    o_slc = lax.map(select_chunk, (q_ch, idx_ch, jnp.arange(n_sc)))
    o_slc = jnp.moveaxis(o_slc, 0, 3).reshape(B, G, J, T, d)

    o = gates[..., 0:1] * o_cmp + gates[..., 1:2] * o_slc + gates[..., 2:3] * o_win
    o = o.transpose(0, 3, 1, 2, 4).reshape(B, T, NSA_QW).astype(h.dtype)
    return o @ w_out


def memory_attention(h, mem_n, wq, wkv, wo, q_gain, k_gain):
    q = rms_norm(split_heads(h @ wq, MEM_HEADS), q_gain)
    k, v = jnp.split(mem_n @ wkv, 2, axis=-1)
    k = rms_norm(split_heads(k, MEM_HEADS), k_gain)
    v = split_heads(v, MEM_HEADS).astype(jnp.float32)
    s = jnp.einsum('bhqd,bhkd->bhqk', q, k, preferred_element_type=jnp.float32) * ATTN_SCALE
    p = jax.nn.softmax(s, axis=-1)
    o = jnp.einsum('bhqk,bhkd->bhqd', p, v)
    return merge_heads(o).astype(h.dtype) @ wo


def swiglu(h, w1, w3, w2):
    return (jax.nn.silu(h @ w1) * (h @ w3)) @ w2


def setup_inputs(seed: int = 0) -> dict:
    key = jax.random.key(seed)
    keys = iter(jax.random.split(key, 64))
    f32 = jnp.float32
    n_even = (DEPTH + 1) // 2
    n_odd = DEPTH // 2

    def dense(shape, fan_in):
        return jax.random.normal(next(keys), shape, f32) * (fan_in ** -0.5)

    def gain(shape):
        return 1.0 + 0.02 * jax.random.normal(next(keys), shape, f32)

    def small(shape, scale):
        return scale * jax.random.normal(next(keys), shape, f32)

    return {
        'x': jax.random.normal(next(keys), (BATCH, SEQ, D_MODEL), f32),
        'mem': jax.random.normal(next(keys), (BATCH, MEM_LEN, D_MODEL), f32),
        'norm_mix': gain((DEPTH, D_MODEL)),
        'norm_mem': gain((DEPTH, D_MODEL)),
        'norm_ffn': gain((DEPTH, D_MODEL)),
        'mem_in_gain': gain((DEPTH, D_MODEL)),
        'even_w_in': dense((n_even, D_MODEL, EVEN_IN), D_MODEL),
        'even_w_out': dense((n_even, EVEN_OUT, D_MODEL), EVEN_OUT),
        'fox_f_bias': FOX_GATE_BIAS + small((n_even, FOX_HEADS), 1.0),
        'fox_q_gain': gain((n_even, HEAD_DIM)),
        'fox_k_gain': gain((n_even, HEAD_DIM)),
        'hgrn_lb_logits': small((n_even, HGRN_KW), 1.0),
        'hgrn_o_gain': gain((n_even, HGRN_VDIM)),
        'odd_w_in': dense((n_odd, D_MODEL, ODD_IN), D_MODEL),
        'odd_w_out': dense((n_odd, NSA_QW, D_MODEL), NSA_QW),
        'nsa_q_gain': gain((n_odd, HEAD_DIM)),
        'nsa_k_gain': gain((n_odd, 3, HEAD_DIM)),
        'cmp_pe_k': small((n_odd, CMP_BLOCK, HEAD_DIM), 0.02),
        'cmp_w1_k': dense((n_odd, CMP_BLOCK, HEAD_DIM, CMP_HIDDEN), CMP_BLOCK * HEAD_DIM),
        'cmp_w2_k': dense((n_odd, CMP_HIDDEN, HEAD_DIM), CMP_HIDDEN),
        'cmp_pe_v': small((n_odd, CMP_BLOCK, HEAD_DIM), 0.02),
        'cmp_w1_v': dense((n_odd, CMP_BLOCK, HEAD_DIM, CMP_HIDDEN), CMP_BLOCK * HEAD_DIM),
        'cmp_w2_v': dense((n_odd, CMP_HIDDEN, HEAD_DIM), CMP_HIDDEN),
        'mem_wq': dense((DEPTH, D_MODEL, MEM_W), D_MODEL),
        'mem_wkv': dense((DEPTH, D_MODEL, 2 * MEM_W), D_MODEL),
        'mem_wo': dense((DEPTH, MEM_W, D_MODEL), MEM_W),
        'mem_q_gain': gain((DEPTH, HEAD_DIM)),
        'mem_k_gain': gain((DEPTH, HEAD_DIM)),
        'ffn_w1': dense((DEPTH, D_MODEL, FFN_HIDDEN), D_MODEL),
        'ffn_w3': dense((DEPTH, D_MODEL, FFN_HIDDEN), D_MODEL),
        'ffn_w2': dense((DEPTH, FFN_HIDDEN, D_MODEL), FFN_HIDDEN),
    }


def reference(x, mem, norm_mix, norm_mem, norm_ffn, mem_in_gain, even_w_in, even_w_out, fox_f_bias,
              fox_q_gain, fox_k_gain, hgrn_lb_logits, hgrn_o_gain, odd_w_in, odd_w_out, nsa_q_gain,
              nsa_k_gain, cmp_pe_k, cmp_w1_k, cmp_w2_k, cmp_pe_v, cmp_w1_v, cmp_w2_v, mem_wq, mem_wkv,
              mem_wo, mem_q_gain, mem_k_gain, ffn_w1, ffn_w3, ffn_w2):
    lb_cum = jnp.cumsum(jax.nn.softmax(hgrn_lb_logits.astype(jnp.float32), axis=0), axis=0)
    hgrn_lb = lb_cum - lb_cum[0:1]
    for layer in range(DEPTH):
        h = rms_norm(x, norm_mix[layer])
        if layer % 2 == 0:
            e = layer // 2
            mix = even_mixer(h, even_w_in[e], even_w_out[e], fox_f_bias[e], fox_q_gain[e], fox_k_gain[e],
                             hgrn_lb[e], hgrn_o_gain[e])
        else:
            o = layer // 2
            mix = nsa_mixer(h, odd_w_in[o], odd_w_out[o], nsa_q_gain[o], nsa_k_gain[o], cmp_pe_k[o],
                            cmp_w1_k[o], cmp_w2_k[o], cmp_pe_v[o], cmp_w1_v[o], cmp_w2_v[o])
        x = x + mix.astype(x.dtype)
        h = rms_norm(x, norm_mem[layer])
        mem_n = rms_norm(mem, mem_in_gain[layer])
        x = x + memory_attention(h, mem_n, mem_wq[layer], mem_wkv[layer], mem_wo[layer],
                                 mem_q_gain[layer], mem_k_gain[layer]).astype(x.dtype)
        h = rms_norm(x, norm_ffn[layer])
        x = x + swiglu(h, ffn_w1[layer], ffn_w3[layer], ffn_w2[layer]).astype(x.dtype)
    return x
```

```cpp
#include <hip/hip_runtime.h>
#include <hip/hip_cooperative_groups.h>
#include <cstdio>
namespace cg = cooperative_groups;

#ifndef ONE_LAUNCH
#define ONE_LAUNCH 1
#endif

typedef unsigned short bf16_t;
typedef short bf16x8 __attribute__((ext_vector_type(8)));
typedef short s16x4 __attribute__((ext_vector_type(4)));
typedef float f32x4 __attribute__((ext_vector_type(4)));
typedef float f32x16 __attribute__((ext_vector_type(16)));
typedef unsigned u32x2 __attribute__((ext_vector_type(2)));
typedef unsigned u32x4 __attribute__((ext_vector_type(4)));
#define DI __device__ __forceinline__

constexpr int T_ = 4096, M_ = 8192, D_ = 2048, NTH = 512;
constexpr float EPS_ = 1e-6f, LOG2E = 1.4426950408889634f, ATTN_SCALE = 0.08838834764831845f;
#define NEG_INF (-__builtin_inff())

constexpr size_t al(size_t x) { return (x + 255) & ~(size_t)255; }
constexpr int N_EIN = 7424, N_OIN = 5376, N_F13 = 11264, FFN_ = 5632;
constexpr size_t SZ_EIN = (size_t)N_EIN * 2048 * 2, SZ_SQ = (size_t)2048 * 2048 * 2, SZ_OIN = (size_t)N_OIN * 2048 * 2;
constexpr size_t SZ_C1 = (size_t)256 * 4096 * 2, SZ_C2 = (size_t)256 * 256 * 2, SZ_MQ = (size_t)512 * 2048 * 2, SZ_MKV = (size_t)1024 * 2048 * 2;
constexpr size_t SZ_F13 = (size_t)N_F13 * 2048 * 2, SZ_F2 = (size_t)2048 * FFN_ * 2;
constexpr size_t W_EIN = 0;
constexpr size_t W_EOUT = W_EIN + 2 * SZ_EIN;
constexpr size_t W_OIN = W_EOUT + 2 * SZ_SQ;
constexpr size_t W_OOUT = W_OIN + 2 * SZ_OIN;
constexpr size_t W_C1 = W_OOUT + 2 * SZ_SQ;
constexpr size_t W_C2 = W_C1 + 4 * SZ_C1;
constexpr size_t W_MQ = W_C2 + 4 * SZ_C2;
constexpr size_t W_MKV = W_MQ + 4 * SZ_MQ;
constexpr size_t W_MO = W_MKV + 4 * SZ_MKV;
constexpr size_t W_F13 = W_MO + 4 * SZ_MQ;
constexpr size_t W_F2 = W_F13 + 4 * SZ_F13;
constexpr size_t W_END = W_F2 + 4 * SZ_F2;
constexpr size_t A_XRES = al(W_END);
constexpr size_t A_H = A_XRES + (size_t)M_ * D_ * 4;
constexpr size_t A_MEMN = A_H + (size_t)M_ * D_ * 2;
constexpr size_t A_MEMK = A_MEMN + (size_t)4 * 512 * 2048 * 2;
constexpr size_t A_MEMVT = A_MEMK + (size_t)4 * 2 * 4 * 256 * 128 * 2;
constexpr size_t A_BIAS1 = A_MEMVT + (size_t)4 * 2 * 4 * 256 * 128 * 2;
constexpr size_t A_QM = A_BIAS1 + 4096;
constexpr size_t A_MAO = A_QM + (size_t)M_ * 512 * 2;
constexpr size_t A_MIXO = A_MAO + (size_t)M_ * 512 * 2;
constexpr size_t A_SSP = A_MIXO + (size_t)M_ * D_ * 2;
constexpr size_t SZ_SSP = (size_t)M_ * 8 * 4;
constexpr size_t A_BAR = A_SSP + 3 * SZ_SSP;
constexpr size_t BAR_BYTES = 16384;
constexpr size_t A_SCR = A_BAR + BAR_BYTES;
constexpr size_t SZ16 = (size_t)M_ * 1024 * 2;
constexpr size_t E_FQ = A_SCR, E_FK = E_FQ + SZ16, E_FVT = E_FK + SZ16, E_HQ = E_FVT + SZ16, E_HF = E_HQ + SZ16  ,
                 E_HIT = E_HF + 2 * SZ16, E_HG = E_HIT + SZ16, E_QT = E_HG + SZ16, E_KT = E_QT + SZ16, E_QS = E_KT + SZ16, E_KUT = E_QS + SZ16,
                 E_U = E_KUT + SZ16  , E_FF = E_U + 4 * SZ16  , E_FC = E_FF + (size_t)M_ * 8 * 4  ,
                 E_DL = E_FC + (size_t)16 * T_ * 4  , E_END = E_DL + (size_t)16 * 64 * 128 * 4;
constexpr size_t E_ST = E_HF;
constexpr size_t SZ8 = (size_t)M_ * 512 * 2;
constexpr size_t O_NQ = A_SCR, O_KC = O_NQ + 2 * SZ16, O_VC = O_KC + SZ8 + 65536, O_KS = O_VC + SZ8 + 65536, O_KW = O_KS + SZ8, O_VST = O_KW + SZ8,
                 O_VWT = O_VST + SZ8, O_GT = O_VWT + SZ8  , O_HC = O_GT + (size_t)M_ * 48 * 4  ,
                 O_KCMP = O_HC + (size_t)2 * 2048 * 256 * 2, O_VCMPT = O_KCMP + (size_t)2048 * 128 * 2, O_SPL = O_VCMPT + (size_t)2048 * 128 * 2  ,
                 O_END = O_SPL + (size_t)16 * 2048 * 256 * 4;
constexpr size_t F_HID = A_SCR;
constexpr size_t F_END = F_HID + (size_t)M_ * FFN_ * 2;
constexpr size_t WS_NEED = (E_END > O_END ? (E_END > F_END ? E_END : F_END) : (O_END > F_END ? O_END : F_END));

struct Params {
  const float* in[31];
  float* out;
  unsigned char* ws;
  int ph_lo, ph_hi;
};

DI int launder(int x) { asm volatile("" : "+v"(x)); return x; }
#define TIDX launder((int)threadIdx.x)
DI float bf2f(bf16_t v) { return __uint_as_float(((unsigned)v) << 16); }
typedef __bf16 hwbf16x2g __attribute__((ext_vector_type(2)));
typedef float f32x2g __attribute__((ext_vector_type(2)));
DI unsigned pk2(float lo, float hi) { const f32x2g f = {lo, hi}; const hwbf16x2g r = __builtin_convertvector(f, hwbf16x2g); return __builtin_bit_cast(unsigned, r); }
DI bf16_t f2bf(float x) { return (bf16_t)(pk2(x, 0.f) & 0xffffu); }
DI int lane_now() { return TIDX & 63; }
DI float shx(float v, int mask) { return __int_as_float(__builtin_amdgcn_ds_bpermute((lane_now() ^ mask) << 2, __float_as_int(v))); }
DI unsigned shxu(unsigned v, int mask) { return (unsigned)__builtin_amdgcn_ds_bpermute((lane_now() ^ mask) << 2, (int)v); }
DI float shidx(float v, int src) { return __int_as_float(__builtin_amdgcn_ds_bpermute(src << 2, __float_as_int(v))); }
DI float wave_sum(float v) {
#pragma unroll
  for (int o = 1; o < 64; o <<= 1) v += shx(v, o);
  return v;
}
DI float fexp2(float x) { return __builtin_amdgcn_exp2f(x); }
DI float frcp(float x) { return __builtin_amdgcn_rcpf(x); }
DI float sigmoidf_(float x) { return frcp(1.f + __expf(-x)); }
DI f32x16 mfma32(bf16x8 a, bf16x8 b, f32x16 c) { return __builtin_amdgcn_mfma_f32_32x32x16_bf16(a, b, c, 0, 0, 0); }
DI f32x16 zero16() { f32x16 z; for (int i = 0; i < 16; ++i) z[i] = 0.f; return z; }

constexpr int BM = 256, BK = 64, HALF = 128, HT = HALF * BK, NXCD = 8, WGM = 8;
constexpr int GEMM_LDS = 8 * HT * 2;
DI int lds_byte(int r, int c) { int st = (r >> 4) * 2 + (c >> 5), rr = r & 15, cc = c & 31, ob = rr * 64 + cc * 2; return st * 1024 + (ob ^ (((ob >> 9) & 1) << 5)); }
DI void stage_rc(int b, int& R, int& C) { int st = b / 1024, sb = b % 1024, swz = sb ^ (((sb >> 9) & 1) << 5); R = (st >> 1) * 16 + swz / 64; C = (st & 1) * 32 + (swz % 64) / 2; }

#define LAS __attribute__((address_space(3)))
DI const char* uniform_ptr(const char* p) { const unsigned long long v = (unsigned long long)p; const unsigned lo = (unsigned)__builtin_amdgcn_readfirstlane((int)(unsigned)v), hi = (unsigned)__builtin_amdgcn_readfirstlane((int)(unsigned)(v >> 32)); return (const char*)(((unsigned long long)hi << 32) | lo); }
template <class Epi>
DI void gemm_run(const bf16_t* __restrict__ A, int lda, const bf16_t* __restrict__ Bt, int ldb, int M, int N, int K, const Epi& epi, int blk_off = 0) {
  extern __shared__ __attribute__((aligned(16))) char dyn_lds[];
  LAS unsigned char* lds = (LAS unsigned char*)dyn_lds;
  const int tid = TIDX, wid = __builtin_amdgcn_readfirstlane(tid >> 6), lane = tid & 63, wr = wid >> 2, wc = wid & 3, fr = lane & 15, fq = lane >> 4;
  const int nt = K / BK;
  unsigned voffA[2], voffB[2];
#pragma unroll
  for (int i = 0; i < 2; ++i) { int R, C; stage_rc(tid * 16 + i * 8192, R, C); voffA[i] = (unsigned)(R * lda + C) * 2u; voffB[i] = (unsigned)(R * ldb + C) * 2u; }
  const size_t kstep = (size_t)(BK * 2);
  const size_t hstepA = (size_t)HALF * lda * 2, hstepB = (size_t)HALF * ldb * 2;
  const unsigned ldsw = (unsigned)wid * 1024u;
  const int aoff = lds_byte(wr * 64 + fr, fq * 8), boff = lds_byte(wc * 32 + fr, fq * 8);
  constexpr int HTB = HT * 2;
#define G_SA(b, h) (((b) * 2 + (h)) * HTB)
#define G_SB(b, h) ((4 + (b) * 2 + (h)) * HTB)
#define G_STAGE(bufoff, gbase, voff) do { _Pragma("unroll") for (int _i = 0; _i < 2; ++_i) \
    __builtin_amdgcn_global_load_lds((const unsigned*)(uniform_ptr((const char*)(gbase)) + (voff)[_i]), (LAS unsigned*)(lds + (bufoff) + ldsw + _i * 8192), 16, 0, 0); } while (0)
#define G_LDA(dst, b, h) do { _Pragma("unroll") for (int m = 0; m < 4; ++m) _Pragma("unroll") for (int k = 0; k < 2; ++k) dst[m][k] = *(const LAS bf16x8*)(lds + G_SA(b, h) + aoff + m * 2048 + k * 1024); } while (0)
#define G_LDB(dst, b, h) do { _Pragma("unroll") for (int n = 0; n < 2; ++n) _Pragma("unroll") for (int k = 0; k < 2; ++k) dst[n][k] = *(const LAS bf16x8*)(lds + G_SB(b, h) + boff + n * 2048 + k * 1024); } while (0)
#define G_MMA(ai, bj, At, Bx) do { __builtin_amdgcn_s_setprio(1); _Pragma("unroll") for (int m = 0; m < 4; ++m) _Pragma("unroll") for (int n = 0; n < 2; ++n) _Pragma("unroll") for (int k = 0; k < 2; ++k) \
    acc[ai][bj][m][n] = __builtin_amdgcn_mfma_f32_16x16x32_bf16(Bx[n][k], At[m][k], acc[ai][bj][m][n], 0, 0, 0); __builtin_amdgcn_s_setprio(0); } while (0)
#define WAIT_V(n) asm volatile("s_waitcnt vmcnt(" #n ")" ::: "memory")
#define WAIT_L(n) asm volatile("s_waitcnt lgkmcnt(" #n ")" ::: "memory")
#define BAR __builtin_amdgcn_s_barrier()
#define SCHED __builtin_amdgcn_sched_barrier(0)
  const int nM = M / BM, nN = N / BM, nwg = nM * nN;
  for (int u = (int)((blockIdx.x + gridDim.x - blk_off) % gridDim.x); u < nwg; u += gridDim.x) {
    int wgid = u;
    { int q = nwg / NXCD, r = nwg % NXCD, xcd = wgid % NXCD, off = wgid / NXCD; wgid = (xcd < r ? xcd * (q + 1) : r * (q + 1) + (xcd - r) * q) + off; }
    int nig = WGM * nN, gid = wgid / nig, fm = gid * WGM, gsz = min(nM - fm, WGM);
    const int pm = __builtin_amdgcn_readfirstlane(fm + ((wgid % nig) % gsz)), pn = __builtin_amdgcn_readfirstlane((wgid % nig) / gsz), brow = pm * BM, bcol = pn * BM;
    f32x4 acc[2][2][4][2];
#pragma unroll
    for (int a = 0; a < 2; ++a)
#pragma unroll
      for (int b = 0; b < 2; ++b)
#pragma unroll
        for (int m = 0; m < 4; ++m)
#pragma unroll
          for (int n = 0; n < 2; ++n) acc[a][b][m][n] = (f32x4){0.f, 0.f, 0.f, 0.f};
    bf16x8 At[4][2], B0[2][2], B1[2][2];
    const char* cA = (const char*)A + (size_t)brow * lda * 2; const char* cB = (const char*)Bt + (size_t)bcol * ldb * 2;
    G_STAGE(G_SB(0, 0), cB, voffB); G_STAGE(G_SA(0, 0), cA, voffA); G_STAGE(G_SB(0, 1), cB + hstepB, voffB); G_STAGE(G_SA(0, 1), cA + hstepA, voffA);
    if (wr == 1) BAR;
    WAIT_V(4); BAR;
    G_STAGE(G_SB(1, 0), cB + kstep, voffB); G_STAGE(G_SA(1, 0), cA + kstep, voffA); G_STAGE(G_SB(1, 1), cB + hstepB + kstep, voffB);
    WAIT_V(6); BAR;
    for (int t = 0; t < nt - 2; t += 2) {
      const char* a1 = cA + (size_t)(t + 1) * kstep;
      const char* a2 = cA + (size_t)(t + 2) * kstep; const char* b2 = cB + (size_t)(t + 2) * kstep;
      const char* a3 = a2 + kstep; const char* b3 = b2 + kstep;
      G_LDB(B0, 0, 0); SCHED; G_LDA(At, 0, 0); G_STAGE(G_SA(1, 1), a1 + hstepA, voffA);
      WAIT_L(8); BAR; WAIT_L(0); G_MMA(0, 0, At, B0); BAR; SCHED;
      G_LDB(B1, 0, 1); G_STAGE(G_SB(0, 0), b2, voffB);
      BAR; WAIT_L(0); G_MMA(0, 1, At, B1); BAR;
      G_LDA(At, 0, 1); G_STAGE(G_SA(0, 0), a2, voffA);
      BAR; WAIT_L(0); G_MMA(1, 0, At, B0); BAR; SCHED;
      G_STAGE(G_SB(0, 1), b2 + hstepB, voffB);
      WAIT_V(6); BAR; G_MMA(1, 1, At, B1); BAR;
      G_LDB(B0, 1, 0); SCHED; G_LDA(At, 1, 0); G_STAGE(G_SA(0, 1), a2 + hstepA, voffA);
      WAIT_L(8); BAR; WAIT_L(0); G_MMA(0, 0, At, B0); BAR; SCHED;
      G_LDB(B1, 1, 1); G_STAGE(G_SB(1, 0), b3, voffB);
      BAR; WAIT_L(0); G_MMA(0, 1, At, B1); BAR;
      G_LDA(At, 1, 1); G_STAGE(G_SA(1, 0), a3, voffA);
      BAR; WAIT_L(0); G_MMA(1, 0, At, B0); BAR; SCHED;
      G_STAGE(G_SB(1, 1), b3 + hstepB, voffB);
      WAIT_V(6); BAR; G_MMA(1, 1, At, B1); BAR;
    }
    { G_LDB(B0, 0, 0); G_LDA(At, 0, 0); G_STAGE(G_SA(1, 1), cA + (size_t)(nt - 1) * kstep + hstepA, voffA);
      BAR; WAIT_L(0); G_MMA(0, 0, At, B0); BAR;
      G_LDB(B1, 0, 1); BAR; WAIT_L(0); G_MMA(0, 1, At, B1); BAR;
      G_LDA(At, 0, 1); WAIT_V(4); BAR; WAIT_L(0); G_MMA(1, 0, At, B0); G_MMA(1, 1, At, B1); BAR; }
    { G_LDB(B0, 1, 0); G_LDA(At, 1, 0); WAIT_V(2); BAR; WAIT_L(0); G_MMA(0, 0, At, B0); BAR;
      G_LDB(B1, 1, 1); WAIT_V(0); BAR; WAIT_L(0); G_MMA(0, 1, At, B1); BAR;
      G_LDA(At, 1, 1); BAR; WAIT_L(0); G_MMA(1, 0, At, B0); G_MMA(1, 1, At, B1); BAR; }
    if (wr == 0) BAR;
    float rowss[2][4];
    const int lane_e = TIDX & 63, fr_e = lane_e & 15, fq_e = lane_e >> 4;
#pragma unroll
    for (int ai = 0; ai < 2; ++ai)
#pragma unroll
      for (int m = 0; m < 4; ++m) {
        const int row = brow + ai * HALF + wr * 64 + m * 16 + fr_e;
        const float rsc = epi.rowscale(row);
        float ssq = 0.f;
#pragma unroll
        for (int bj = 0; bj < 2; ++bj)
          ssq += epi(row, bcol + bj * HALF + wc * 32, fq_e, acc[ai][bj][m][0] * rsc, acc[ai][bj][m][1] * rsc);
        rowss[ai][m] = ssq;
        __builtin_amdgcn_sched_barrier(0);
      }
    if constexpr (Epi::HAS_SS) {
      float* ssp = epi.ssp_ptr();
      if (ssp) {
        LAS float* red = (LAS float*)lds;
#pragma unroll
        for (int ai = 0; ai < 2; ++ai)
#pragma unroll
          for (int m = 0; m < 4; ++m) {
            float v = rowss[ai][m];
            v += shx(v, 16); v += shx(v, 32);
            if (fq_e == 0) red[(ai * HALF + wr * 64 + m * 16 + fr_e) * 4 + wc] = v;
          }
        __syncthreads();
        { const int t2 = TIDX; if (t2 < 256) { const LAS float* q = red + t2 * 4; ssp[(size_t)(brow + t2) * 8 + pn] = (q[0] + q[1]) + (q[2] + q[3]); } }
      }
    }
    __syncthreads();
  }
}

typedef __bf16 hwbf16x2e __attribute__((ext_vector_type(2)));
typedef float f32x2e __attribute__((ext_vector_type(2)));
DI unsigned pk2e(float lo, float hi) { const f32x2e f = {lo, hi}; const hwbf16x2e r = __builtin_convertvector(f, hwbf16x2e); return __builtin_bit_cast(unsigned, r); }
DI void st_bf16x4(bf16_t* p, f32x4 v) { u32x2 o; o.x = pk2e(v[0], v[1]); o.y = pk2e(v[2], v[3]); *(u32x2*)p = o; }
DI void st_tr4(bf16_t* p, size_t stride, f32x4 v) { p[0] = f2bf(v[0]); p[stride] = f2bf(v[1]); p[2 * stride] = f2bf(v[2]); p[3 * stride] = f2bf(v[3]); }

struct EpiEvenIn {
  static constexpr bool HAS_SS = false;
  const float* ssp_in;
  DI float rowscale(int row) const { const f32x4 a = *(const f32x4*)(ssp_in + (size_t)row * 8), b = *(const f32x4*)(ssp_in + (size_t)row * 8 + 4);
    return rsqrtf((((a[0] + a[1]) + (a[2] + a[3])) + ((b[0] + b[1]) + (b[2] + b[3]))) * (1.f / D_) + EPS_); }
  DI float* ssp_ptr() const { return nullptr; }
  unsigned char* ws;
  DI void one(int row, int c, f32x4 v) const {
    const int b = row >> 12, t = row & 4095;
    if (c < 3072) {
      const int seg = c >> 10, cc = c & 1023, h = cc >> 7, d = cc & 127;
      if (seg < 2) st_bf16x4((bf16_t*)(ws + (seg == 0 ? E_FQ : E_FK)) + ((size_t)(b * 8 + h) * T_ + t) * 128 + d, v);
      else st_tr4((bf16_t*)(ws + E_FVT) + (size_t)(b * 8 + h) * 128 * T_ + (size_t)(t >> 5) * 4096 + d * 32 + ((((t & 31) >> 2) ^ ((d >> 2) & 7)) << 2) + (t & 3), 32, v);
    } else if (c < 4096) { st_bf16x4((bf16_t*)(ws + E_HQ) + (size_t)row * 1024 + (c - 3072), v);
    } else if (c < 5120) { *(f32x4*)((float*)(ws + E_HF) + (size_t)row * 1024 + (c - 4096)) = v;
    } else if (c < 6144) { const int cc = c - 5120, h = cc >> 7, d = cc & 127; st_tr4((bf16_t*)(ws + E_HIT) + (size_t)(b * 8 + h) * 128 * T_ + (size_t)(t >> 5) * 4096 + d * 32 + (t & 31), 32, v);
    } else if (c < 7168) { st_bf16x4((bf16_t*)(ws + E_HG) + (size_t)row * 1024 + (c - 6144), v);
    } else if (c < 7176) { *(f32x4*)((float*)(ws + E_FF) + (size_t)row * 8 + (c - 7168)) = v; }
  }
  DI float operator()(int row, int colbase, int fq, f32x4 v0, f32x4 v1) const { one(row, colbase + 4 * fq, v0); one(row, colbase + 16 + 4 * fq, v1); return 0.f; }
};
struct EpiOddIn {
  static constexpr bool HAS_SS = false;
  const float* ssp_in;
  DI float rowscale(int row) const { const f32x4 a = *(const f32x4*)(ssp_in + (size_t)row * 8), b = *(const f32x4*)(ssp_in + (size_t)row * 8 + 4);
    return rsqrtf((((a[0] + a[1]) + (a[2] + a[3])) + ((b[0] + b[1]) + (b[2] + b[3]))) * (1.f / D_) + EPS_); }
  DI float* ssp_ptr() const { return nullptr; }
  unsigned char* ws;
  DI void one(int row, int c, f32x4 v) const {
    const int b = row >> 12, t = row & 4095;
    if (c < 2048) { const int h = c >> 7, d = c & 127; st_bf16x4((bf16_t*)(ws + O_NQ) + ((size_t)(b * 16 + h) * T_ + t) * 128 + d, v); }
    else if (c < 5120) {
      const int seg = (c - 2048) >> 9, cc = (c - 2048) & 511, g = cc >> 7, d = cc & 127;
      if (seg == 3 || seg == 5) st_tr4((bf16_t*)(ws + (seg == 3 ? O_VST : O_VWT)) + (size_t)(b * 4 + g) * 128 * T_ + (size_t)(t >> 5) * 4096 + d * 32 + ((((t & 31) >> 2) ^ ((d >> 2) & 7)) << 2) + (t & 3), 32, v);
      else { const size_t off = seg == 0 ? O_KC : seg == 1 ? O_VC : seg == 2 ? O_KS : O_KW;
        st_bf16x4((bf16_t*)(ws + off) + ((size_t)(b * 4 + g) * T_ + t) * 128 + d, v); }
    } else if (c < 5168) { *(f32x4*)((float*)(ws + O_GT) + (size_t)row * 48 + (c - 5120)) = v; }
  }
  DI float operator()(int row, int colbase, int fq, f32x4 v0, f32x4 v1) const { one(row, colbase + 4 * fq, v0); one(row, colbase + 16 + 4 * fq, v1); return 0.f; }
};
struct EpiResid {
  static constexpr bool HAS_SS = true;
  const float* src; float* dst; bf16_t* xb; float* ssp;
  DI float rowscale(int) const { return 1.f; }
  DI float* ssp_ptr() const { return ssp; }
  DI float operator()(int row, int colbase, int fq, f32x4 v0, f32x4 v1) const {
    const size_t o = (size_t)row * D_ + colbase + 4 * fq;
    const f32x4 a = *(const f32x4*)(src + o) + v0, b = *(const f32x4*)(src + o + 16) + v1;
    *(f32x4*)(dst + o) = a; *(f32x4*)(dst + o + 16) = b;
    if (xb) { st_bf16x4(xb + o, a); st_bf16x4(xb + o + 16, b); }
    return ((a[0] * a[0] + a[1] * a[1]) + (a[2] * a[2] + a[3] * a[3])) + ((b[0] * b[0] + b[1] * b[1]) + (b[2] * b[2] + b[3] * b[3]));
  }
};
struct EpiMemQ {
  static constexpr bool HAS_SS = false;
  const float* ssp_in;
  DI float rowscale(int row) const { const f32x4 a = *(const f32x4*)(ssp_in + (size_t)row * 8), b = *(const f32x4*)(ssp_in + (size_t)row * 8 + 4);
    return rsqrtf((((a[0] + a[1]) + (a[2] + a[3])) + ((b[0] + b[1]) + (b[2] + b[3]))) * (1.f / D_) + EPS_); }
  DI float* ssp_ptr() const { return nullptr; }
  bf16_t* qm;
  DI float operator()(int row, int colbase, int fq, f32x4 v0, f32x4 v1) const {
    const int b = row >> 12, t = row & 4095, c = colbase + 4 * fq, h = c >> 7, d = c & 127;
    bf16_t* p = qm + ((size_t)(b * 4 + h) * T_ + t) * 128 + d;
    st_bf16x4(p, v0); st_bf16x4(p + 16, v1); return 0.f;
  }
};
struct EpiMemKV {
  static constexpr bool HAS_SS = false;
  DI float rowscale(int) const { return 1.f; }
  DI float* ssp_ptr() const { return nullptr; }
  bf16_t* mk; bf16_t* mvt;
  DI void one(int row, int c0, f32x4 v) const {
    const int b = row >> 8, s = row & 255, l = c0 >> 10, c = c0 & 1023;
    const size_t lo = (size_t)l * 8 * 256 * 128;
    if (c < 512) { const int h = c >> 7, d = c & 127; st_bf16x4(mk + lo + ((size_t)(b * 4 + h) * 256 + s) * 128 + d, v); }
    else { const int cc = c - 512, h = cc >> 7, d = cc & 127;
      st_tr4(mvt + lo + (size_t)(b * 4 + h) * 128 * 256 + (size_t)(s >> 5) * 4096 + d * 32 + ((((s & 31) >> 2) ^ ((d >> 2) & 7)) << 2) + (s & 3), 32, v); }
  }
  DI float operator()(int row, int colbase, int fq, f32x4 v0, f32x4 v1) const { one(row, colbase + 4 * fq, v0); one(row, colbase + 16 + 4 * fq, v1); return 0.f; }
};
struct EpiSwiglu {
  static constexpr bool HAS_SS = false;
  const float* ssp_in;
  DI float rowscale(int row) const { const f32x4 a = *(const f32x4*)(ssp_in + (size_t)row * 8), b = *(const f32x4*)(ssp_in + (size_t)row * 8 + 4);
    return rsqrtf((((a[0] + a[1]) + (a[2] + a[3])) + ((b[0] + b[1]) + (b[2] + b[3]))) * (1.f / D_) + EPS_); }
  DI float* ssp_ptr() const { return nullptr; }
  bf16_t* hid;
  DI float operator()(int row, int colbase, int fq, f32x4 v0, f32x4 v1) const {
    f32x4 r;
#pragma unroll
    for (int e = 0; e < 4; ++e) r[e] = v0[e] * sigmoidf_(v0[e]) * v1[e];
    st_bf16x4(hid + (size_t)row * FFN_ + (colbase >> 1) + 4 * fq, r); return 0.f;
  }
};
DI float gelu_tanh(float x) { const float u = 0.7978845608028654f * (x + 0.044715f * x * x * x); const float e = __expf(2.f * u); const float th = 1.f - 2.f * frcp(e + 1.f); return 0.5f * x * (1.f + th); }
struct EpiF32 {
  static constexpr bool HAS_SS = false;
  DI float rowscale(int) const { return 1.f; }
  DI float* ssp_ptr() const { return nullptr; }
  float* dst; int ld;
  DI float operator()(int row, int colbase, int fq, f32x4 v0, f32x4 v1) const {
    float* q = dst + (size_t)row * ld + colbase + 4 * fq; *(f32x4*)q = v0; *(f32x4*)(q + 16) = v1; return 0.f;
  }
};
struct EpiCmp1 {
  static constexpr bool HAS_SS = false;
  DI float rowscale(int) const { return 1.f; }
  DI float* ssp_ptr() const { return nullptr; }
  bf16_t* hc; const float* bias;
  DI float operator()(int row, int colbase, int fq, f32x4 v0, f32x4 v1) const {
    const int c = colbase + 4 * fq;
    f32x4 b0 = *(const f32x4*)(bias + c), b1 = *(const f32x4*)(bias + c + 16), r0, r1;
#pragma unroll
    for (int e = 0; e < 4; ++e) { r0[e] = gelu_tanh(v0[e] + b0[e]); r1[e] = gelu_tanh(v1[e] + b1[e]); }
    st_bf16x4(hc + (size_t)row * 256 + c, r0); st_bf16x4(hc + (size_t)row * 256 + c + 16, r1); return 0.f;
  }
};
struct EpiCmp2 {
  static constexpr bool HAS_SS = false;
  DI float rowscale(int) const { return 1.f; }
  DI float* ssp_ptr() const { return nullptr; }
  bf16_t* dst; int isv;
  DI void one(int row, int c, f32x4 v) const {
    if (c >= 128) return;
    if (!isv) st_bf16x4(dst + (size_t)row * 128 + c, v);
    else st_tr4(dst + ((size_t)(row >> 8) * 128 + c) * 256 + (row & 255), 256, v);
  }
  DI float operator()(int row, int colbase, int fq, f32x4 v0, f32x4 v1) const { one(row, colbase + 4 * fq, v0); one(row, colbase + 16 + 4 * fq, v1); return 0.f; }
};

struct TDesc { const float* src; const float* src2; const float* rscale; bf16_t* dst; int K, Nsrc, map, k0, n0; };
constexpr int TR_LD = 260;
DI bool decode_tile(const Params& p, int gi, TDesc& d) {
#define TCLS(CNT, KK, NS, ND, MP, SRC, SRC2, RS, RSS, DB, DS) { const int ntn = (ND) / 256, per = ((KK) / 64) * ntn, tot = (CNT) * per; \
    if (gi < tot) { const int l = gi / per, tl = gi % per; d.src = (SRC) + (size_t)l * (KK) * (NS); d.src2 = (SRC2) ? (SRC2) + (size_t)l * (KK) * (NS) : nullptr; \
      d.rscale = (RS) ? (RS) + (size_t)l * (RSS) : nullptr; d.dst = (bf16_t*)(p.ws + (DB) + (size_t)l * (DS)); d.K = (KK); d.Nsrc = (NS); d.map = (MP); \
      d.k0 = (tl / ntn) * 64; d.n0 = (tl % ntn) * 256; return true; } gi -= tot; }
  const float* nul = nullptr;
  TCLS(4, 2048, 5632, N_F13, 2, p.in[28], p.in[29], p.in[4], 2048, W_F13, SZ_F13)
  TCLS(4, 5632, 2048, 2048, 0, p.in[30], nul, nul, 0, W_F2, SZ_F2)
  TCLS(2, 2048, 7176, N_EIN, 1, p.in[6], nul, p.in[2], 4096, W_EIN, SZ_EIN)
  TCLS(2, 2048, 5168, N_OIN, 0, p.in[13], nul, p.in[2] + 2048, 4096, W_OIN, SZ_OIN)
  TCLS(2, 2048, 2048, 2048, 0, p.in[7], nul, nul, 0, W_EOUT, SZ_SQ)
  TCLS(2, 2048, 2048, 2048, 0, p.in[14], nul, nul, 0, W_OOUT, SZ_SQ)
  TCLS(4, 2048, 1024, 1024, 0, p.in[24], nul, p.in[5], 2048, W_MKV, SZ_MKV)
  TCLS(4, 2048, 512, 512, 0, p.in[23], nul, p.in[3], 2048, W_MQ, SZ_MQ)
  TCLS(4, 512, 2048, 2048, 0, p.in[25], nul, nul, 0, W_MO, SZ_MQ)
  TCLS(2, 4096, 256, 256, 0, p.in[18], nul, nul, 0, W_C1, 2 * SZ_C1)
  TCLS(2, 4096, 256, 256, 0, p.in[21], nul, nul, 0, W_C1 + SZ_C1, 2 * SZ_C1)
  TCLS(2, 256, 128, 256, 0, p.in[19], nul, nul, 0, W_C2, 2 * SZ_C2)
  TCLS(2, 256, 128, 256, 0, p.in[22], nul, nul, 0, W_C2 + SZ_C2, 2 * SZ_C2)
#undef TCLS
  return false;
}
DI void tr_load(const TDesc& d, int tid, f32x4 (&v)[8]) {
  const int lane = tid & 63, w = tid >> 6, n = d.n0 + lane * 4;
  const float* s = d.src; int col;
  if (d.map == 0) col = n < d.Nsrc ? n : -1;
  else if (d.map == 1) col = n < 3072 ? n : (n < 7168 ? n + 8 : (n < 7176 ? n - 7168 + 3072 : -1));
  else { col = (n >> 5) * 16 + (n & 15); if (n & 16) s = d.src2; }
#pragma unroll
  for (int r = 0; r < 8; ++r) {
    const int k = d.k0 + w * 8 + r;
    v[r] = col >= 0 ? *(const f32x4*)(s + (size_t)k * d.Nsrc + col) : (f32x4){0.f, 0.f, 0.f, 0.f};
  }
  if (d.rscale) {
#pragma unroll
    for (int r = 0; r < 8; ++r) { const float g = d.rscale[d.k0 + w * 8 + r]; v[r] = v[r] * g; }
  }
}
DI void transpose_jobs(const Params& p) {
  extern __shared__ __attribute__((aligned(16))) char dyn_lds[];
  LAS float* lds = (LAS float*)dyn_lds;
  const int tid = TIDX, lane = tid & 63, w = tid >> 6;
  TDesc da, db; f32x4 va[8], vb[8];
  int gi = blockIdx.x;
  bool ha = decode_tile(p, gi, da); if (ha) tr_load(da, tid, va);
  gi += gridDim.x;
  bool hb = ha && decode_tile(p, gi, db); if (hb) tr_load(db, tid, vb);
#define TR_EMIT(V, D) do { \
    _Pragma("unroll") for (int r = 0; r < 8; ++r) *(LAS f32x4*)(lds + (w * 8 + r) * TR_LD + lane * 4) = V[r]; \
    __syncthreads(); \
    const TDesc cur_ = D; \
    gi += gridDim.x; \
    const bool hn_ = decode_tile(p, gi, D); if (hn_) tr_load(D, tid, V); \
    const int nl = tid & 255; \
    _Pragma("unroll") for (int q = 0; q < 4; ++q) { \
      const int kc = (tid >> 8) + 2 * q; const LAS float* c = lds + (kc * 8) * TR_LD + nl; u32x4 o; \
      o.x = pk2(c[0], c[TR_LD]); o.y = pk2(c[2 * TR_LD], c[3 * TR_LD]); o.z = pk2(c[4 * TR_LD], c[5 * TR_LD]); o.w = pk2(c[6 * TR_LD], c[7 * TR_LD]); \
      *(u32x4*)(cur_.dst + (size_t)(cur_.n0 + nl) * cur_.K + cur_.k0 + kc * 8) = o; } \
    __syncthreads(); \
    h_ = hn_; } while (0)
  while (ha) {
    bool h_;
    TR_EMIT(va, da); ha = h_;
    if (!hb) break;
    TR_EMIT(vb, db); hb = h_;
    if (!ha) { while (hb) { TR_EMIT(vb, db); hb = h_; } break; }
  }
#undef TR_EMIT
}

DI void rmsnorm_rows(const float* __restrict__ x, const float* __restrict__ gain, bf16_t* __restrict__ out, int rows) {
  const int lane = TIDX & 63, gw = blockIdx.x * 8 + (TIDX >> 6), nw = gridDim.x * 8;
  for (int r = gw; r < rows; r += nw) {
    const f32x4* xr = (const f32x4*)(x + (size_t)r * D_) + lane;
    f32x4 v[8]; float s = 0.f;
#pragma unroll
    for (int j = 0; j < 8; ++j) { v[j] = xr[64 * j]; s += v[j][0] * v[j][0] + v[j][1] * v[j][1] + v[j][2] * v[j][2] + v[j][3] * v[j][3]; }
    const float rs = rsqrtf(wave_sum(s) * (1.f / D_) + EPS_);
#pragma unroll
    for (int j = 0; j < 8; ++j) {
      const f32x4 g = gain ? *((const f32x4*)gain + lane + 64 * j) : (f32x4){1.f, 1.f, 1.f, 1.f};
      f32x4 o; for (int e = 0; e < 4; ++e) o[e] = v[j][e] * rs * g[e];
      st_bf16x4(out + (size_t)r * D_ + (lane + 64 * j) * 4, o);
    }
  }
}

DI void xprep_rows(const float* __restrict__ x, bf16_t* __restrict__ xb, float* __restrict__ ssp, int rows) {
  const int tid = TIDX, lane = tid & 63, gw = blockIdx.x * 8 + (tid >> 6), nw = gridDim.x * 8;
  for (int r = gw; r < rows; r += nw) {
    const f32x4* xr = (const f32x4*)(x + (size_t)r * D_) + lane;
    float s = 0.f;
#pragma unroll
    for (int j = 0; j < 8; ++j) { const f32x4 v = xr[64 * j]; s += v[0] * v[0] + v[1] * v[1] + v[2] * v[2] + v[3] * v[3]; st_bf16x4(xb + (size_t)r * D_ + (lane + 64 * j) * 4, v); }
    s = wave_sum(s);
    if (lane < 8) ssp[(size_t)r * 8 + lane] = lane == 0 ? s : 0.f;
  }
}

DI void headnorm_rows(bf16_t* buf, int rows, const float* __restrict__ gain, int item0, int nitems_total) {
  const int lane = TIDX & 63, gw = blockIdx.x * 8 + (TIDX >> 6), nw = gridDim.x * 8;
  const int sub = lane >> 4, l16 = lane & 15;
  (void)item0; (void)nitems_total;
  for (int it = gw; it < rows / 4; it += nw) {
    bf16_t* rp = buf + (size_t)(it * 4 + sub) * 128 + l16 * 8;
    bf16x8 raw = *(const bf16x8*)rp;
    float f[8], s = 0.f;
#pragma unroll
    for (int e = 0; e < 8; ++e) { f[e] = bf2f((bf16_t)raw[e]); s += f[e] * f[e]; }
    s += shx(s, 1); s += shx(s, 2); s += shx(s, 4); s += shx(s, 8);
    const float rs = rsqrtf(s * (1.f / 128.f) + EPS_);
    u32x4 o;
    o.x = pk2(f[0] * rs * gain[l16 * 8 + 0], f[1] * rs * gain[l16 * 8 + 1]); o.y = pk2(f[2] * rs * gain[l16 * 8 + 2], f[3] * rs * gain[l16 * 8 + 3]);
    o.z = pk2(f[4] * rs * gain[l16 * 8 + 4], f[5] * rs * gain[l16 * 8 + 5]); o.w = pk2(f[6] * rs * gain[l16 * 8 + 6], f[7] * rs * gain[l16 * 8 + 7]);
    *(u32x4*)rp = o;
  }
}

struct AttnState { f32x16 o[4]; float m, l; };
DI void attn_init(AttnState& s) { for (int i = 0; i < 4; ++i) s.o[i] = zero16(); s.m = NEG_INF; s.l = 0.f; }
DI int crow(int i, int g) { return (i & 3) + 8 * (i >> 2) + 4 * g; }

DI void load_q_raw(bf16x8 (&qf)[8], const bf16_t* qrow, int g) {
#pragma unroll
  for (int ks = 0; ks < 8; ++ks) qf[ks] = *(const bf16x8*)(qrow + ks * 16 + g * 8);
}
DI void load_q_norm(bf16x8 (&qf)[8], const bf16_t* qrow, int g, const float* __restrict__ gain, float scale) {
  float ss = 0.f;
#pragma unroll
  for (int ks = 0; ks < 8; ++ks) { qf[ks] = *(const bf16x8*)(qrow + ks * 16 + g * 8);
#pragma unroll
    for (int e = 0; e < 8; ++e) { const float f = bf2f((bf16_t)qf[ks][e]); ss += f * f; } }
  ss += shx(ss, 32);
  const float rs = rsqrtf(ss * (1.f / 128.f) + EPS_) * scale;
#pragma unroll
  for (int ks = 0; ks < 8; ++ks) {
    const f32x4 g0 = *(const f32x4*)(gain + ks * 16 + g * 8), g1 = *(const f32x4*)(gain + ks * 16 + g * 8 + 4);
    u32x4 o;
    o.x = pk2(bf2f((bf16_t)qf[ks][0]) * rs * g0[0], bf2f((bf16_t)qf[ks][1]) * rs * g0[1]);
    o.y = pk2(bf2f((bf16_t)qf[ks][2]) * rs * g0[2], bf2f((bf16_t)qf[ks][3]) * rs * g0[3]);
    o.z = pk2(bf2f((bf16_t)qf[ks][4]) * rs * g1[0], bf2f((bf16_t)qf[ks][5]) * rs * g1[1]);
    o.w = pk2(bf2f((bf16_t)qf[ks][6]) * rs * g1[2], bf2f((bf16_t)qf[ks][7]) * rs * g1[3]);
    qf[ks] = __builtin_bit_cast(bf16x8, o);
  }
}
DI f32x16 score_tile(const bf16x8 (&qf)[8], const bf16_t* __restrict__ Kp  , unsigned koff  ) {
  f32x16 acc = zero16();
  const char* kr = (const char*)Kp;
#pragma unroll
  for (int ks = 0; ks < 8; ++ks) { const bf16x8 a = *(const bf16x8*)(kr + (size_t)(koff + ks * 32)); acc = mfma32(a, qf[ks], acc); }
  return acc;
}
typedef __bf16 hwbf16x2 __attribute__((ext_vector_type(2)));
typedef float f32x2 __attribute__((ext_vector_type(2)));
DI unsigned pk2h(float lo, float hi) { const f32x2 f = {lo, hi}; const hwbf16x2 r = __builtin_convertvector(f, hwbf16x2); return __builtin_bit_cast(unsigned, r); }
DI bf16x8 pack8(const float* p) { u32x4 o; o.x = pk2h(p[0], p[1]); o.y = pk2h(p[2], p[3]); o.z = pk2h(p[4], p[5]); o.w = pk2h(p[6], p[7]); return __builtin_bit_cast(bf16x8, o); }
DI void pv_tile(f32x16 (&o)[4], const bf16x8 (&pf)[2], const bf16_t* __restrict__ VTp  , size_t ldv, unsigned voff  ) {
#pragma unroll
  for (int vt = 0; vt < 4; ++vt) {
    const char* vr = (const char*)(VTp + (size_t)(vt * 32) * ldv);
#pragma unroll
    for (int s = 0; s < 2; ++s) {
      const s16x4 lo = *(const s16x4*)(vr + (size_t)(voff + 32 * s)), hi = *(const s16x4*)(vr + (size_t)(voff + 32 * s + 16));
      const bf16x8 a = __builtin_shufflevector(lo, hi, 0, 1, 2, 3, 4, 5, 6, 7);
      o[vt] = mfma32(a, pf[s], o[vt]);
    }
  }
}
DI void softmax_step(AttnState& st, float (&sc)[16], const bf16_t* __restrict__ VTp, size_t ldv, unsigned voff) {
  float mx = st.m;
#pragma unroll
  for (int i = 0; i < 16; ++i) mx = fmaxf(mx, sc[i]);
  mx = fmaxf(mx, shx(mx, 32));
  const float ms = (mx == NEG_INF) ? 0.f : mx;
  const float alpha = fexp2(st.m - ms);
  st.m = mx;
  float ps = 0.f;
#pragma unroll
  for (int i = 0; i < 16; ++i) { sc[i] = fexp2(sc[i] - ms); ps += sc[i]; }
  st.l = st.l * alpha + ps;
#pragma unroll
  for (int vt = 0; vt < 4; ++vt)
#pragma unroll
    for (int i = 0; i < 16; ++i) st.o[vt][i] *= alpha;
  bf16x8 pf[2]; pf[0] = pack8(sc); pf[1] = pack8(sc + 8);
  pv_tile(st.o, pf, VTp, ldv, voff);
}
DI float attn_inv_l(const AttnState& st) { const float l = st.l + shx(st.l, 32); return l > 0.f ? frcp(l) : 0.f; }
DI void store_o(const f32x16 (&o)[4], float scale, bf16_t* orow, int g) {
#pragma unroll
  for (int vt = 0; vt < 4; ++vt)
#pragma unroll
    for (int q = 0; q < 4; ++q) {
      f32x4 v; for (int e = 0; e < 4; ++e) v[e] = o[vt][q * 4 + e] * scale;
      st_bf16x4(orow + vt * 32 + q * 8 + 4 * g, v);
    }
}

constexpr int AT_STAGE = 16384;
#define AT_WAIT_V(n) asm volatile("s_waitcnt vmcnt(" #n ")" ::: "memory")
#define AT_WAIT_L0() asm volatile("s_waitcnt lgkmcnt(0)" ::: "memory")
#define AT_BAR() __builtin_amdgcn_s_barrier()
struct LaneKV {
  unsigned ksrc, vsrc, ldsw;
  unsigned kx, xh, vrow, vo[4];
};
DI void lanekv_init(LaneKV& L, int tid, int wid) {
  const int lane = tid & 63, lr = lane & 31, g = lane >> 5, r = tid >> 4, pos = tid & 15;
  L.ksrc = (unsigned)(r * 256 + ((pos ^ (r & 15)) << 4)); L.vsrc = (unsigned)tid * 16u; L.ldsw = (unsigned)wid * 1024u;
  L.kx = (unsigned)(lr * 256 + ((g ^ (lr & 1)) << 4)); L.xh = (unsigned)((lr & 15) >> 1); L.vrow = (unsigned)lr * 64u;
  const int y = (lr >> 2) & 7;
#pragma unroll
  for (int q = 0; q < 4; ++q) L.vo[q] = (unsigned)(((g + 2 * q) ^ y) << 3);
}
DI void kv_issue(LAS unsigned char* st, const bf16_t* Kt, const bf16_t* Vt, const LaneKV& L) {
  __builtin_amdgcn_global_load_lds((const unsigned*)((const char*)Kt + L.ksrc), (LAS unsigned*)(st + L.ldsw), 16, 0, 0);
  __builtin_amdgcn_global_load_lds((const unsigned*)((const char*)Vt + L.vsrc), (LAS unsigned*)(st + 8192 + L.ldsw), 16, 0, 0);
}
DI f32x16 score_tile_lds(const bf16x8 (&qf)[8], const LAS unsigned char* st, const LaneKV& L) {
  f32x16 acc = zero16();
#pragma unroll
  for (int ks = 0; ks < 8; ++ks) { const bf16x8 a = *(const LAS bf16x8*)(st + L.kx + (((unsigned)ks ^ L.xh) << 5)); acc = mfma32(a, qf[ks], acc); }
  return acc;
}
DI void pv_tile_lds(f32x16 (&o)[4], const bf16x8 (&pf)[2], const LAS unsigned char* stv, const LaneKV& L) {
#pragma unroll
  for (int vt = 0; vt < 4; ++vt) {
#pragma unroll
    for (int s2 = 0; s2 < 2; ++s2) {
      const s16x4 lo = *(const LAS s16x4*)(stv + vt * 2048 + L.vrow + L.vo[2 * s2]), hi = *(const LAS s16x4*)(stv + vt * 2048 + L.vrow + L.vo[2 * s2 + 1]);
      const bf16x8 a = __builtin_shufflevector(lo, hi, 0, 1, 2, 3, 4, 5, 6, 7);
      o[vt] = mfma32(a, pf[s2], o[vt]);
    }
  }
}
DI void softmax_step_lds(AttnState& st, float (&sc)[16], const LAS unsigned char* stv, const LaneKV& L) {
  float mx = st.m;
#pragma unroll
  for (int i = 0; i < 16; ++i) mx = fmaxf(mx, sc[i]);
  mx = fmaxf(mx, shx(mx, 32));
  const float ms = (mx == NEG_INF) ? 0.f : mx;
  if (__builtin_amdgcn_ballot_w64(mx > st.m) != 0ull) {
    const float alpha = fexp2(st.m - ms);
    st.l *= alpha;
#pragma unroll
    for (int vt = 0; vt < 4; ++vt)
#pragma unroll
      for (int i = 0; i < 16; ++i) st.o[vt][i] *= alpha;
  }
  st.m = mx;
  float ps = 0.f;
#pragma unroll
  for (int i = 0; i < 16; ++i) { sc[i] = fexp2(sc[i] - ms); ps += sc[i]; }
  st.l += ps;
  bf16x8 pf[2]; pf[0] = pack8(sc); pf[1] = pack8(sc + 8);
  pv_tile_lds(st.o, pf, stv, L);
}

DI void softmax_step2_lds(AttnState& st, float (&sa)[16], float (&sb)[16], const LAS unsigned char* stva, const LAS unsigned char* stvb, const LaneKV& L) {
  float mx = st.m;
#pragma unroll
  for (int i = 0; i < 16; ++i) mx = fmaxf(mx, fmaxf(sa[i], sb[i]));
  mx = fmaxf(mx, shx(mx, 32));
  const float ms = (mx == NEG_INF) ? 0.f : mx;
  if (__builtin_amdgcn_ballot_w64(mx > st.m) != 0ull) {
    const float alpha = fexp2(st.m - ms);
    st.l *= alpha;
#pragma unroll
    for (int vt = 0; vt < 4; ++vt)
#pragma unroll
      for (int i = 0; i < 16; ++i) st.o[vt][i] *= alpha;
  }
  st.m = mx;
  float ps = 0.f;
#pragma unroll
  for (int i = 0; i < 16; ++i) { sa[i] = fexp2(sa[i] - ms); sb[i] = fexp2(sb[i] - ms); ps += sa[i] + sb[i]; }
  st.l += ps;
  bf16x8 pfa[2], pfb[2]; pfa[0] = pack8(sa); pfa[1] = pack8(sa + 8); pfb[0] = pack8(sb); pfb[1] = pack8(sb + 8);
  __builtin_amdgcn_sched_barrier(0);
  pv_tile_lds(st.o, pfa, stva, L);
  __builtin_amdgcn_sched_barrier(0);
  pv_tile_lds(st.o, pfb, stvb, L);
  __builtin_amdgcn_sched_barrier(0);
}

DI void memattn_block(const Params& p, int layer, int bh, int tile4) {
  extern __shared__ __attribute__((aligned(16))) char dyn_lds[];
  LAS unsigned char* ldsb = (LAS unsigned char*)dyn_lds;
  const int tid = TIDX, wid = __builtin_amdgcn_readfirstlane(tid >> 6), lane = tid & 63, lr = lane & 31, g = lane >> 5;
  const int tile = tile4 * 4 + (wid & 3);
  const int tq = tile * 32 + lr, b = bh >> 2, h = bh & 3;
  const bf16_t* Kb = (const bf16_t*)(p.ws + A_MEMK) + ((size_t)layer * 8 + bh) * 256 * 128;
  const bf16_t* VT = (const bf16_t*)(p.ws + A_MEMVT) + ((size_t)layer * 8 + bh) * 128 * 256;
  LaneKV L; lanekv_init(L, tid, wid);
#pragma unroll
  for (int kt = 0; kt < 8; ++kt) kv_issue(ldsb + kt * AT_STAGE, Kb + (size_t)kt * 4096, VT + (size_t)kt * 4096, L);
  bf16x8 qf[8];
  if (wid < 4) {
    const size_t mrow = (size_t)b * T_ + tq;
    const float* qp = (const float*)(p.ws + A_SCR) + mrow * 512 + h * 128 + g * 8;
    const float* sp8 = (const float*)(p.ws + A_SSP) + SZ_SSP / 4 + mrow * 8;
    const f32x4 s0 = *(const f32x4*)sp8, s1 = *(const f32x4*)(sp8 + 4);
    const float rr = rsqrtf((((s0[0] + s0[1]) + (s0[2] + s0[3])) + ((s1[0] + s1[1]) + (s1[2] + s1[3]))) * (1.f / D_) + EPS_);
    f32x4 qa[8], qb[8]; float ss = 0.f;
#pragma unroll
    for (int ks = 0; ks < 8; ++ks) {
      f32x4 a = *(const f32x4*)(qp + ks * 16), c = *(const f32x4*)(qp + ks * 16 + 4);
#pragma unroll
      for (int sp = 1; sp < 4; ++sp) { a += *(const f32x4*)(qp + (size_t)sp * M_ * 512 + ks * 16); c += *(const f32x4*)(qp + (size_t)sp * M_ * 512 + ks * 16 + 4); }
      a = a * rr; c = c * rr; qa[ks] = a; qb[ks] = c;
      ss += (a[0] * a[0] + a[1] * a[1]) + (a[2] * a[2] + a[3] * a[3]) + (c[0] * c[0] + c[1] * c[1]) + (c[2] * c[2] + c[3] * c[3]);
    }
    ss += shx(ss, 32);
    const float rs = rsqrtf(ss * (1.f / 128.f) + EPS_) * (ATTN_SCALE * LOG2E);
    const float* gain = p.in[26] + layer * 128 + g * 8;
#pragma unroll
    for (int ks = 0; ks < 8; ++ks) {
      const f32x4 g0 = *(const f32x4*)(gain + ks * 16), g1 = *(const f32x4*)(gain + ks * 16 + 4);
      float v[8];
#pragma unroll
      for (int i = 0; i < 4; ++i) { v[i] = qa[ks][i] * rs * g0[i]; v[4 + i] = qb[ks][i] * rs * g1[i]; }
      qf[ks] = pack8(v);
    }
  }
  AT_WAIT_V(0);
  AT_BAR();
  if (wid < 4) {
    AttnState st; attn_init(st);
#pragma unroll 1
    for (int kt = 0; kt < 8; ++kt) {
      const LAS unsigned char* sg = ldsb + kt * AT_STAGE;
      f32x16 acc = score_tile_lds(qf, sg, L);
      float sc[16];
#pragma unroll
      for (int i = 0; i < 16; ++i) sc[i] = acc[i];
      softmax_step_lds(st, sc, sg + 8192, L);
    }
    const float inv = attn_inv_l(st);
    store_o(st.o, inv, (bf16_t*)(p.ws + A_MAO) + (size_t)(b * T_ + tq) * 512 + h * 128, g);
  }
  AT_WAIT_L0();
  __syncthreads();
}

DI void fox_block(const Params& p, int e, int bh, int j) {
  extern __shared__ __attribute__((aligned(16))) char dyn_lds[];
  LAS unsigned char* lds = (LAS unsigned char*)dyn_lds;
  LAS float* c2l = (LAS float*)(lds + 4 * AT_STAGE);
  const int tid = TIDX, wid = __builtin_amdgcn_readfirstlane(tid >> 6), lane = tid & 63, lr = lane & 31, g = lane >> 5;
  const int kidx = wid < 4 ? wid : 11 - wid, tile = j + 16 * kidx, nsteps = (j + 114) >> 1;
  const int tq = tile * 32 + lr, b = bh >> 3, h = bh & 7;
  const bf16_t* Q = (const bf16_t*)(p.ws + E_FQ) + (size_t)bh * T_ * 128;
  const bf16_t* Kb = (const bf16_t*)(p.ws + E_FK) + (size_t)bh * T_ * 128;
  const bf16_t* VT = (const bf16_t*)(p.ws + E_FVT) + (size_t)bh * 128 * T_;
  const float* c2 = (const float*)(p.ws + E_FC) + (size_t)bh * T_;
  LaneKV L; lanekv_init(L, tid, wid);
  kv_issue(lds, Kb, VT, L);
  kv_issue(lds + AT_STAGE, Kb + 4096, VT + 4096, L);
  { const int nc = nsteps * 64 < T_ ? nsteps * 64 : T_; for (int i = tid; i < nc; i += NTH) c2l[i] = c2[i]; }
  bf16x8 qf[8];
  load_q_norm(qf, Q + (size_t)tq * 128, g, p.in[9] + e * 128, ATTN_SCALE * LOG2E);
  AttnState st; attn_init(st);
  AT_WAIT_L0();
#pragma unroll 1
  for (int i = 0; i < nsteps; ++i) {
    AT_WAIT_V(0);
    AT_BAR();
    if (i + 1 < nsteps) {
      LAS unsigned char* nx = lds + ((i + 1) & 1) * 2 * AT_STAGE;
      kv_issue(nx, Kb + (size_t)(2 * i + 2) * 4096, VT + (size_t)(2 * i + 2) * 4096, L);
      kv_issue(nx + AT_STAGE, Kb + (size_t)(2 * i + 3) * 4096, VT + (size_t)(2 * i + 3) * 4096, L);
    }
    const int ka = 2 * i, kb = ka + 1;
    const LAS unsigned char* sg = lds + (i & 1) * 2 * AT_STAGE;
    if (kb <= tile) {
      f32x16 acca = score_tile_lds(qf, sg, L); __builtin_amdgcn_sched_barrier(0); f32x16 accb = score_tile_lds(qf, sg + AT_STAGE, L); __builtin_amdgcn_sched_barrier(0);
      float sa[16], sb[16];
#pragma unroll
      for (int q = 0; q < 4; ++q) {
        const f32x4 ca = *(const LAS f32x4*)(c2l + ka * 32 + 8 * q + 4 * g), cb = *(const LAS f32x4*)(c2l + kb * 32 + 8 * q + 4 * g);
#pragma unroll
        for (int e2 = 0; e2 < 4; ++e2) { sa[q * 4 + e2] = acca[q * 4 + e2] - ca[e2]; sb[q * 4 + e2] = accb[q * 4 + e2] - cb[e2]; }
      }
      if (kb == tile) {
#pragma unroll
        for (int q = 0; q < 16; ++q) sb[q] = (crow(q, g) <= lr) ? sb[q] : NEG_INF;
      }
      softmax_step2_lds(st, sa, sb, sg + 8192, sg + AT_STAGE + 8192, L);
    } else if (ka <= tile) {
      f32x16 acc = score_tile_lds(qf, sg, L);
      float sc[16];
#pragma unroll
      for (int q = 0; q < 4; ++q) {
        const f32x4 cs = *(const LAS f32x4*)(c2l + ka * 32 + 8 * q + 4 * g);
#pragma unroll
        for (int e2 = 0; e2 < 4; ++e2) sc[q * 4 + e2] = acc[q * 4 + e2] - cs[e2];
      }
#pragma unroll
      for (int q = 0; q < 16; ++q) sc[q] = (crow(q, g) <= lr) ? sc[q] : NEG_INF;
      softmax_step_lds(st, sc, sg + 8192, L);
    }
  }
  const float inv = attn_inv_l(st);
  store_o(st.o, inv, (bf16_t*)(p.ws + A_MIXO) + (size_t)(b * T_ + tq) * D_ + h * 128, g);
  AT_WAIT_L0();
  __syncthreads();
}

DI void fox_task(const Params& p, int e, int bh, int tile) {
  const int lane = TIDX & 63, lr = lane & 31, g = lane >> 5;
  const unsigned koff = (unsigned)(lr * 128 + g * 8) * 2u, voffT = (unsigned)(lr * 32 + 4 * g) * 2u, voff256 = (unsigned)(lr * 256 + 4 * g) * 2u; (void)koff; (void)voffT; (void)voff256;
  const int t0 = tile * 32, tq = t0 + lr, b = bh >> 3, h = bh & 7;
  const bf16_t* Q = (const bf16_t*)(p.ws + E_FQ) + (size_t)bh * T_ * 128;
  const bf16_t* Kb = (const bf16_t*)(p.ws + E_FK) + (size_t)bh * T_ * 128;
  const bf16_t* VT = (const bf16_t*)(p.ws + E_FVT) + (size_t)bh * 128 * T_;
  const float* c2 = (const float*)(p.ws + E_FC) + (size_t)bh * T_;
  bf16x8 qf[8];
  load_q_norm(qf, Q + (size_t)tq * 128, g, p.in[9] + e * 128, ATTN_SCALE * LOG2E);
  const float ct = c2[tq];
  AttnState st; attn_init(st);
  for (int kt = 0; kt <= tile; ++kt) {
    const int key0 = kt * 32;
    f32x16 acc = score_tile(qf, Kb + (size_t)key0 * 128, koff);
    float sc[16];
#pragma unroll
    for (int q = 0; q < 4; ++q) {
      const f32x4 cs = *(const f32x4*)(c2 + key0 + 8 * q + 4 * g);
#pragma unroll
      for (int e2 = 0; e2 < 4; ++e2) {
        const int i = q * 4 + e2; const int key = key0 + crow(i, g);
        const float s = acc[i] + (ct - cs[e2]);
        sc[i] = (key <= tq) ? s : NEG_INF;
      }
    }
    softmax_step(st, sc, VT + (size_t)key0 * 128, 32, voffT);
  }
  const float inv = attn_inv_l(st);
  store_o(st.o, inv, (bf16_t*)(p.ws + A_MIXO) + (size_t)(b * T_ + tq) * D_ + h * 128, g);
}

DI void hgrn_prep(const Params& p, int e) {
  const float* HF = (const float*)(p.ws + E_HF);
  const bf16_t* HQ = (const bf16_t*)(p.ws + E_HQ);
  bf16_t* QT = (bf16_t*)(p.ws + E_QT); bf16_t* KT = (bf16_t*)(p.ws + E_KT); bf16_t* QS = (bf16_t*)(p.ws + E_QS); bf16_t* KUT = (bf16_t*)(p.ws + E_KUT);
  float* DL = (float*)(p.ws + E_DL);
  const float* lg = p.in[11];
  for (int idx = blockIdx.x * NTH + TIDX; idx < 16 * 64 * 128; idx += gridDim.x * NTH) {
    const int k = idx & 127, c = (idx >> 7) & 63, bh = idx >> 13, b = bh >> 3, h = bh & 7, col = h * 128 + k;
    const float lb = (e == 0) ? 0.f : 1.f / (1.f + __expf(lg[col] - lg[1024 + col]));
    const size_t m0 = (size_t)b * T_ + c * 64;
    float bsum = 0.f, bmid = 0.f;
#pragma unroll 1
    for (int t16 = 0; t16 < 4; ++t16) {
      float zc[16];
#pragma unroll
      for (int tt = 0; tt < 16; ++tt) zc[tt] = HF[(m0 + t16 * 16 + tt) * 1024 + col];
#pragma unroll
      for (int tt = 0; tt < 16; ++tt) {
        const float z = zc[tt];
        const float a = __expf(-fabsf(z)), ri = __builtin_amdgcn_rcpf(1.f + a);
        const float sg = z >= 0.f ? ri : a * ri;
        bsum += (e == 0) ? (fminf(z, 0.f) - __logf(1.f + a)) : __logf(lb + (1.f - lb) * sg);
      }
      if (t16 == 1) bmid = bsum;
    }
    const float blast = bsum;
    DL[((size_t)bh * 64 + c) * 128 + k] = __expf(blast);
    const float emid = __expf(bmid), elast = __expf(blast - bmid);
    bsum = 0.f;
    const size_t hb = ((size_t)bh * T_ + c * 64) * 128 + k;
    bf16_t* kut = KUT + (((size_t)bh * 64 + c) * 128 + k) * 64;
#pragma unroll 1
    for (int t8 = 0; t8 < 8; ++t8) {
      float ku[8], zc[8], qc[8];
#pragma unroll
      for (int tt = 0; tt < 8; ++tt) { zc[tt] = HF[(m0 + t8 * 8 + tt) * 1024 + col]; qc[tt] = bf2f(HQ[(m0 + t8 * 8 + tt) * 1024 + col]); }
#pragma unroll
      for (int tt = 0; tt < 8; ++tt) {
        const int t = t8 * 8 + tt;
        const float z = zc[tt];
        const float a = __expf(-fabsf(z)), ri = __builtin_amdgcn_rcpf(1.f + a);
        const float sg = z >= 0.f ? ri : a * ri, sgn = z >= 0.f ? a * ri : ri;
        bsum += (e == 0) ? (fminf(z, 0.f) - __logf(1.f + a)) : __logf(lb + (1.f - lb) * sg);
        const float kh = (1.f - lb) * sgn;
        const float qv = qc[tt]; const float qh = qv * __builtin_amdgcn_rcpf(1.f + __expf(-qv));
        const float ed = __expf(bsum - bmid), edi = __builtin_amdgcn_rcpf(ed);
        QT[hb + (size_t)t * 128] = f2bf(qh * ed);
        KT[hb + (size_t)t * 128] = f2bf(kh * edi);
        QS[hb + (size_t)t * 128] = f2bf(qh * ed * emid);
        ku[tt] = kh * edi * elast;
      }
      *(bf16x8*)(kut + t8 * 8) = pack8(ku);
    }
  }
}
DI void fox_cumsum(const Params& p, int e) {
  extern __shared__ __attribute__((aligned(16))) char dyn_lds[];
  LAS float* wsum = (LAS float*)dyn_lds;
  const int tid = TIDX, lane = tid & 63, w = tid >> 6;
  for (int bh = blockIdx.x; bh < 16; bh += gridDim.x) {
    const int b = bh >> 3, h = bh & 7;
    const float* FF = (const float*)(p.ws + E_FF) + (size_t)b * T_ * 8 + h;
    float* FC = (float*)(p.ws + E_FC) + (size_t)bh * T_;
    const float bias = p.in[8][e * 8 + h];
    float v[8], s = 0.f;
#pragma unroll
    for (int i = 0; i < 8; ++i) { const float x = FF[(size_t)(tid * 8 + i) * 8] + bias; s += fminf(x, 0.f) - log1pf(__expf(-fabsf(x))); v[i] = s; }
    float incl = s;
#pragma unroll
    for (int o = 1; o < 64; o <<= 1) { const float u = shidx(incl, lane - o); if (lane >= o) incl += u; }
    if (lane == 63) wsum[w] = incl;
    __syncthreads();
    float base = incl - s;
    for (int q = 0; q < w; ++q) base += wsum[q];
#pragma unroll
    for (int i = 0; i < 8; ++i) FC[tid * 8 + i] = (base + v[i]) * LOG2E;
    __syncthreads();
  }
}
DI void hgrn_u_task(const Params& p, int bh, int c, int vt) {
  const int lane = TIDX & 63, lr = lane & 31, g = lane >> 5;
  const bf16_t* VT = (const bf16_t*)(p.ws + E_HIT) + (size_t)bh * 128 * T_ + (size_t)(c * 2) * 4096 + (vt * 32 + lr) * 32 + g * 8;
  const bf16_t* KUT = (const bf16_t*)(p.ws + E_KUT) + (((size_t)bh * 64 + c) * 128 + lr) * 64 + g * 8;
  f32x16 acc[4];
#pragma unroll
  for (int kt = 0; kt < 4; ++kt) acc[kt] = zero16();
#pragma unroll
  for (int ts = 0; ts < 4; ++ts) {
    const bf16x8 a = *(const bf16x8*)(VT + (ts >> 1) * 4096 + (ts & 1) * 16);
#pragma unroll
    for (int kt = 0; kt < 4; ++kt) { const bf16x8 bb = *(const bf16x8*)(KUT + (size_t)kt * 32 * 64 + ts * 16); acc[kt] = mfma32(a, bb, acc[kt]); }
  }
  float* U = (float*)(p.ws + E_U) + ((size_t)bh * 64 + c) * 128 * 128;
#pragma unroll
  for (int kt = 0; kt < 4; ++kt)
#pragma unroll
    for (int i = 0; i < 16; ++i) U[(size_t)(vt * 32 + crow(i, g)) * 128 + kt * 32 + lr] = acc[kt][i];
}
DI void hgrn_scan(const Params& p) {
  const float* U = (const float*)(p.ws + E_U); const float* DL = (const float*)(p.ws + E_DL); bf16_t* ST = (bf16_t*)(p.ws + E_ST);
  for (int idx = blockIdx.x * NTH + TIDX; idx < 16 * 128 * 128; idx += gridDim.x * NTH) {
    const int k = idx & 127, v = (idx >> 7) & 127, bh = idx >> 14;
    float S = 0.f;
#pragma unroll 8
    for (int c = 0; c < 64; ++c) {
      const size_t o = (((size_t)bh * 64 + c) * 128 + v) * 128 + k;
      ST[o] = f2bf(S);
      S = DL[((size_t)bh * 64 + c) * 128 + k] * S + U[o];
    }
  }
}
DI void hgrn_out_task(const Params& p, int e, int bh, int c, int tt) {
  const int lane = TIDX & 63, lr = lane & 31, g = lane >> 5, b = bh >> 3, h = bh & 7;
  const unsigned koff = (unsigned)(lr * 128 + g * 8) * 2u, voffT = (unsigned)(lr * 32 + 4 * g) * 2u, voff256 = (unsigned)(lr * 256 + 4 * g) * 2u; (void)koff; (void)voffT; (void)voff256;
  const size_t rowbase = (size_t)bh * T_ + c * 64;
  const bf16_t* QT = (const bf16_t*)(p.ws + E_QT) + rowbase * 128;
  const bf16_t* KT = (const bf16_t*)(p.ws + E_KT) + rowbase * 128;
  const bf16_t* QS = (const bf16_t*)(p.ws + E_QS) + rowbase * 128;
  const bf16_t* VT = (const bf16_t*)(p.ws + E_HIT) + (size_t)bh * 128 * T_ + (size_t)(c * 2) * 4096;
  const bf16_t* ST = (const bf16_t*)(p.ws + E_ST) + ((size_t)bh * 64 + c) * 128 * 128;
  f32x16 o[4];
#pragma unroll
  for (int i = 0; i < 4; ++i) o[i] = zero16();
  bf16x8 qf[8];
  load_q_raw(qf, QT + (size_t)(tt * 32 + lr) * 128, g);
  for (int st = 0; st <= tt; ++st) {
    f32x16 acc = score_tile(qf, KT + (size_t)st * 32 * 128, koff);
    float a[16];
#pragma unroll
    for (int i = 0; i < 16; ++i) a[i] = (st < tt || crow(i, g) <= lr) ? acc[i] : 0.f;
    bf16x8 pf[2]; pf[0] = pack8(a); pf[1] = pack8(a + 8);
    pv_tile(o, pf, VT + (size_t)st * 4096, 32, voffT);
  }
  load_q_raw(qf, QS + (size_t)(tt * 32 + lr) * 128, g);
#pragma unroll
  for (int vt = 0; vt < 4; ++vt) {
    const bf16_t* sr = ST + (size_t)(vt * 32 + lr) * 128 + g * 8;
#pragma unroll
    for (int ks = 0; ks < 8; ++ks) { const bf16x8 a = *(const bf16x8*)(sr + ks * 16); o[vt] = mfma32(a, qf[ks], o[vt]); }
  }
  float ss = 0.f;
#pragma unroll
  for (int vt = 0; vt < 4; ++vt)
#pragma unroll
    for (int i = 0; i < 16; ++i) ss += o[vt][i] * o[vt][i];
  ss += shx(ss, 32);
  const float rs = rsqrtf(ss * (1.f / 128.f) + EPS_);
  const size_t m = (size_t)b * T_ + c * 64 + tt * 32 + lr;
  const bf16_t* hg = (const bf16_t*)(p.ws + E_HG) + m * 1024 + h * 128;
  const float* og = p.in[12] + e * 128;
  bf16_t* orow = (bf16_t*)(p.ws + A_MIXO) + m * D_ + 1024 + h * 128;
#pragma unroll
  for (int vt = 0; vt < 4; ++vt)
#pragma unroll
    for (int q = 0; q < 4; ++q) {
      const int d0 = vt * 32 + q * 8 + 4 * g;
      const s16x4 gv = *(const s16x4*)(hg + d0); const f32x4 gn = *(const f32x4*)(og + d0);
      f32x4 v;
#pragma unroll
      for (int e2 = 0; e2 < 4; ++e2) { const float gg = bf2f((bf16_t)gv[e2]); v[e2] = o[vt][q * 4 + e2] * rs * gn[e2] * (gg * frcp(1.f + __expf(-gg))); }
      st_bf16x4(orow + d0, v);
    }
}

constexpr int PS_LD = 260;
constexpr int NSA_PS_OFF = 65536, NSA_ML_OFF = NSA_PS_OFF + 2 * 32 * PS_LD * 4, NSA_SEL_OFF = NSA_ML_OFF + 8 * 32 * 2 * 4, NSA_LDS = NSA_SEL_OFF + 2 * 32 * 8;
DI void stash_set(LAS unsigned* stw, const f32x16 (&o)[4], float f) {
#pragma unroll
  for (int vt = 0; vt < 4; ++vt)
#pragma unroll
    for (int i = 0; i < 8; ++i) stw[(vt * 8 + i) * 64] = pk2(o[vt][2 * i] * f, o[vt][2 * i + 1] * f);
}
DI void stash_add(LAS unsigned* stw, const f32x16 (&o)[4], float f) {
#pragma unroll
  for (int vt = 0; vt < 4; ++vt)
#pragma unroll
    for (int i = 0; i < 8; ++i) { const unsigned w = stw[(vt * 8 + i) * 64];
      stw[(vt * 8 + i) * 64] = pk2(__uint_as_float(w << 16) + o[vt][2 * i] * f, __uint_as_float(w & 0xffff0000u) + o[vt][2 * i + 1] * f); }
}
struct NsaCtx { int b, gk, tile64, o_idx; };
#define NSA_LANE_CTX() \
  const int tidx = TIDX; \
  const int wave = __builtin_amdgcn_readfirstlane(tidx >> 6), lane = tidx & 63, lr = lane & 31, g = lane >> 5; \
  const int sub = wave >> 2, j = wave & 3, h = c.gk * 4 + j; \
  const int t0 = c.tile64 * 64 + sub * 32, tq = t0 + lr; \
  const unsigned koff = (unsigned)(lr * 128 + g * 8) * 2u, voffT = (unsigned)(lr * 32 + 4 * g) * 2u, voff256 = (unsigned)(lr * 256 + 4 * g) * 2u; \
  const size_t kvh = (size_t)(c.b * 4 + c.gk); \
  const float slope2 = fexp2(-0.5f * (float)(h + 1)) * LOG2E; \
  const int thr = __builtin_amdgcn_readfirstlane((int)(200.f / slope2) + 1);     \
  LAS unsigned char* ldsb = (LAS unsigned char*)dyn_lds; \
  LAS float* psum = (LAS float*)(ldsb + NSA_PS_OFF); LAS float* ml = (LAS float*)(ldsb + NSA_ML_OFF); \
  LAS unsigned long long* sel = (LAS unsigned long long*)(ldsb + NSA_SEL_OFF); \
  LAS unsigned* stw = (LAS unsigned*)ldsb + wave * 32 * 64 + lane; \
  const bf16_t* NQ = (const bf16_t*)(p.ws + O_NQ); const float* qgain = p.in[15] + c.o_idx * 128; \
  (void)koff; (void)voffT; (void)voff256; (void)kvh; (void)slope2; (void)thr; (void)psum; (void)ml; (void)sel; (void)stw; (void)NQ; (void)qgain; (void)sub; (void)j; (void)h; (void)tq; (void)t0

DI void nsa_cmp1(const Params& p, const NsaCtx c) {
  extern __shared__ __attribute__((aligned(16))) char dyn_lds[];
  NSA_LANE_CTX();
  const bf16_t* KCMP = (const bf16_t*)(p.ws + O_KCMP) + kvh * 256 * 128;
  const bf16_t* VCMPT = (const bf16_t*)(p.ws + O_VCMPT) + kvh * 128 * 256;
  const float ftq = (float)tq;
  const int ntile_c = (t0 >> 4) / 32 + 1;
  bf16x8 qf[8];
  load_q_norm(qf, NQ + ((size_t)(c.b * 16 + h) * T_ + tq) * 128, g, qgain, ATTN_SCALE * LOG2E);
  AttnState st; attn_init(st);
#pragma unroll 1
  for (int kt = 0; kt < ntile_c; ++kt) {
    if (t0 - (16 * (32 * kt + 31) + 16) > thr + 32) continue;
    f32x16 acc = score_tile(qf, KCMP + (size_t)kt * 32 * 128, koff);
    float sc[16];
#pragma unroll
    for (int i = 0; i < 16; ++i) {
      const int n = kt * 32 + crow(i, g);
      const float s = acc[i] - slope2 * (ftq - ((float)(16 * n) + 15.5f));
      sc[i] = (16 * n + 31 <= tq) ? s : NEG_INF;
    }
    softmax_step(st, sc, VCMPT + (size_t)kt * 4096, 32, voffT);
  }
  const float inv = attn_inv_l(st);
  const float g_cmp = sigmoidf_(((const float*)(p.ws + O_GT))[((size_t)c.b * T_ + tq) * 48 + h * 3]);
  stash_set(stw, st.o, inv * g_cmp);
  if (g == 0) { ml[(wave * 32 + lr) * 2] = (st.m == NEG_INF) ? 0.f : st.m; ml[(wave * 32 + lr) * 2 + 1] = inv; }
}
DI void nsa_cmp2(const Params& p, const NsaCtx c) {
  extern __shared__ __attribute__((aligned(16))) char dyn_lds[];
  NSA_LANE_CTX();
  const bf16_t* KCMP = (const bf16_t*)(p.ws + O_KCMP) + kvh * 256 * 128;
  const float ftq = (float)tq;
  const int ntile_c = (t0 >> 4) / 32 + 1;
#pragma unroll 1
  for (int kk = 0; kk < 2; ++kk) {
    const int kt = j + 4 * kk;
    float ps[16];
#pragma unroll
    for (int i = 0; i < 16; ++i) ps[i] = 0.f;
    if (kt < ntile_c) {
#pragma unroll 1
      for (int jj = 0; jj < 4; ++jj) {
        const int hh = c.gk * 4 + jj;
        bf16x8 q2[8];
        load_q_norm(q2, NQ + ((size_t)(c.b * 16 + hh) * T_ + tq) * 128, g, qgain, ATTN_SCALE * LOG2E);
        const float sl2 = fexp2(-0.5f * (float)(hh + 1)) * LOG2E;
        if (t0 - (16 * (32 * kt + 31) + 16) > __builtin_amdgcn_readfirstlane((int)(200.f / sl2) + 1) + 32) continue;
        const float mm = ml[((sub * 4 + jj) * 32 + lr) * 2], iv = ml[((sub * 4 + jj) * 32 + lr) * 2 + 1];
        f32x16 acc = score_tile(q2, KCMP + (size_t)kt * 32 * 128, koff);
#pragma unroll
        for (int i = 0; i < 16; ++i) {
          const int n = kt * 32 + crow(i, g);
          const float s = acc[i] - sl2 * (ftq - ((float)(16 * n) + 15.5f));
          const float pr = (16 * n + 31 <= tq) ? fexp2(s - mm) * iv : 0.f;
          ps[i] += pr;
        }
      }
    }
#pragma unroll
    for (int q = 0; q < 4; ++q) {
      f32x4 v; for (int e2 = 0; e2 < 4; ++e2) v[e2] = ps[q * 4 + e2];
      *(LAS f32x4*)(psum + (sub * 32 + lr) * PS_LD + kt * 32 + q * 8 + 4 * g) = v;
    }
  }
}
DI void nsa_topk(const Params& p, const NsaCtx c) {
  extern __shared__ __attribute__((aligned(16))) char dyn_lds[];
  NSA_LANE_CTX();
#pragma unroll 1
  for (int rr = 0; rr < 8; ++rr) {
    const int row = j * 8 + rr, t = c.tile64 * 64 + sub * 32 + row;
    const LAS float* pr = psum + (sub * 32 + row) * PS_LD;
    float imp = 0.f;
#pragma unroll
    for (int d = -1; d <= 3; ++d) { const int n = 4 * lane + d; if (n >= 0 && n <= 254) imp += pr[n]; }
    if (64 * lane > t) imp = NEG_INF;
    if (lane == (t >> 6) || lane == 0) imp = __builtin_inff();
    LAS float* sbw = ml + wave * 64;
    sbw[lane] = imp;
    int rank = 0;
#pragma unroll
    for (int m4 = 0; m4 < 16; ++m4) {
      const f32x4 v4 = *(const LAS f32x4*)(sbw + m4 * 4);
#pragma unroll
      for (int e2 = 0; e2 < 4; ++e2) { const int mm = m4 * 4 + e2; rank += (v4[e2] > imp || (v4[e2] == imp && mm < lane)) ? 1 : 0; }
    }
    const unsigned long long msk = __ballot(rank < 16);
    if (lane == 0) sel[sub * 32 + row] = msk;
  }
}
DI void nsa_winslc(const Params& p, const NsaCtx c) {
  extern __shared__ __attribute__((aligned(16))) char dyn_lds[];
  NSA_LANE_CTX();
  LAS unsigned char* stg = ldsb + NSA_PS_OFF;
  LAS int* tl = (LAS int*)(ldsb + NSA_PS_OFF + 3 * AT_STAGE);
  const bf16_t* KW = (const bf16_t*)(p.ws + O_KW) + kvh * T_ * 128;
  const bf16_t* VWT = (const bf16_t*)(p.ws + O_VWT) + kvh * 128 * T_;
  const bf16_t* KS = (const bf16_t*)(p.ws + O_KS) + kvh * T_ * 128;
  const bf16_t* VST = (const bf16_t*)(p.ws + O_VST) + kvh * 128 * T_;
  const unsigned long long mymask = sel[sub * 32 + lr];
  LaneKV L; lanekv_init(L, tidx, wave);
  bf16x8 qf[8];
  load_q_norm(qf, NQ + ((size_t)(c.b * 16 + h) * T_ + tq) * 128, g, qgain, ATTN_SCALE * LOG2E);
  const size_t m = (size_t)c.b * T_ + tq;
  const float* gt = (const float*)(p.ws + O_GT) + m * 48 + h * 3;
  AttnState st;
  {
    const int hi = c.tile64 * 2 + 1, lo = c.tile64 * 2 - 16 > 0 ? c.tile64 * 2 - 16 : 0, nsteps = hi - lo + 1;
    const int myhi = t0 >> 5, mylo = myhi - 16;
    attn_init(st);
    kv_issue(stg, KW + (size_t)lo * 4096, VWT + (size_t)lo * 4096, L);
    kv_issue(stg + AT_STAGE, KW + (size_t)(lo + 1) * 4096, VWT + (size_t)(lo + 1) * 4096, L);
#pragma unroll 1
    for (int i = 0; i < nsteps; ++i) {
      const int kt = lo + i;
      if (i + 1 < nsteps) AT_WAIT_V(2); else AT_WAIT_V(0);
      AT_BAR();
      if (i + 2 < nsteps) kv_issue(stg + ((i + 2) % 3) * AT_STAGE, KW + (size_t)(kt + 2) * 4096, VWT + (size_t)(kt + 2) * 4096, L);
      if (kt >= mylo && kt <= myhi && t0 - (kt * 32 + 31) <= thr) {
        const LAS unsigned char* sg = stg + (i % 3) * AT_STAGE;
        f32x16 acc = score_tile_lds(qf, sg, L);
        float sc[16];
        const int key0 = kt * 32, d0 = tq - key0 - 4 * g;
        const float fb = slope2 * (float)d0;
#pragma unroll
        for (int q = 0; q < 16; ++q) sc[q] = fmaf(slope2, (float)((q & 3) + 8 * (q >> 2)), acc[q]) - fb;
        if (kt == mylo || kt == myhi) {
#pragma unroll
          for (int q = 0; q < 16; ++q) { const int dist = d0 - ((q & 3) + 8 * (q >> 2)); sc[q] = (dist >= 0 && dist < 512) ? sc[q] : NEG_INF; }
        }
        softmax_step_lds(st, sc, sg + 8192, L);
      }
    }
    stash_add(stw, st.o, attn_inv_l(st) * sigmoidf_(gt[2]));
  }
  unsigned long long uni;
  {
    unsigned lo32 = (unsigned)mymask, hi32 = (unsigned)(mymask >> 32);
#pragma unroll
    for (int o = 1; o < 32; o <<= 1) { lo32 |= shxu(lo32, o); hi32 |= shxu(hi32, o); }
    uni = ((unsigned long long)(unsigned)__builtin_amdgcn_readfirstlane((int)hi32) << 32) | (unsigned)__builtin_amdgcn_readfirstlane((int)lo32);
    const int mbw = t0 >> 6;
    uni &= (mbw >= 63) ? ~0ull : ((1ull << (mbw + 1)) - 1ull);
    if (lane == 0) { tl[160 + wave * 2] = (int)(unsigned)uni; tl[160 + wave * 2 + 1] = (int)(unsigned)(uni >> 32); }
  }
  AT_WAIT_L0();
  AT_BAR();
  {
    unsigned long long ub = 0ull;
#pragma unroll
    for (int w2 = 0; w2 < 8; w2 += 4) ub |= ((unsigned long long)(unsigned)tl[160 + w2 * 2 + 1] << 32) | (unsigned)tl[160 + w2 * 2];
    int n = 0;
    if (wave == 0 && lane == 0) {
      const int thrg = (int)(200.f / (exp2f(-0.5f * (float)(c.gk * 4 + 4)) * LOG2E)) + 1;
      for (int mb = 0; mb <= c.tile64; ++mb) if (((ub >> mb) & 1ull) && c.tile64 * 64 - (mb * 64 + 63) <= thrg) { tl[n++] = mb * 2; tl[n++] = mb * 2 + 1; }
      tl[159] = n;
    }
  }
  AT_WAIT_L0();
  AT_BAR();
  {
    const int nsteps = __builtin_amdgcn_readfirstlane(tl[159]);
    attn_init(st);
    if (nsteps > 0) { const int k0 = __builtin_amdgcn_readfirstlane(tl[0]); kv_issue(stg, KS + (size_t)k0 * 4096, VST + (size_t)k0 * 4096, L); }
    if (nsteps > 1) { const int k1 = __builtin_amdgcn_readfirstlane(tl[1]); kv_issue(stg + AT_STAGE, KS + (size_t)k1 * 4096, VST + (size_t)k1 * 4096, L); }
#pragma unroll 1
    for (int i = 0; i < nsteps; ++i) {
      const int kt = __builtin_amdgcn_readfirstlane(tl[i]);
      if (i + 1 < nsteps) AT_WAIT_V(2); else AT_WAIT_V(0);
      AT_BAR();
      if (i + 2 < nsteps) { const int k2 = __builtin_amdgcn_readfirstlane(tl[i + 2]); kv_issue(stg + ((i + 2) % 3) * AT_STAGE, KS + (size_t)k2 * 4096, VST + (size_t)k2 * 4096, L); }
      const int mb = kt >> 1, key0 = kt * 32;
      if (((uni >> mb) & 1ull) && key0 <= t0 + 31 && t0 - (key0 + 31) <= thr) {
        const bool mine = (mymask >> mb) & 1ull;
        const LAS unsigned char* sg = stg + (i % 3) * AT_STAGE;
        f32x16 acc = score_tile_lds(qf, sg, L);
        float sc[16];
        const int d0 = tq - key0 - 4 * g;
        const float fb = mine ? slope2 * (float)d0 : __builtin_inff();
#pragma unroll
        for (int q = 0; q < 16; ++q) sc[q] = fmaf(slope2, (float)((q & 3) + 8 * (q >> 2)), acc[q]) - fb;
        if (key0 >= t0) {
#pragma unroll
          for (int q = 0; q < 16; ++q) sc[q] = (d0 - ((q & 3) + 8 * (q >> 2)) >= 0) ? sc[q] : NEG_INF;
        }
        softmax_step_lds(st, sc, sg + 8192, L);
      }
    }
  }
  const float f = attn_inv_l(st) * sigmoidf_(gt[1]);
  bf16_t* orow = (bf16_t*)(p.ws + A_MIXO) + m * D_ + h * 128;
#pragma unroll
  for (int vt = 0; vt < 4; ++vt)
#pragma unroll
    for (int q = 0; q < 4; ++q) {
      const unsigned w0 = stw[(vt * 8 + q * 2) * 64], w1 = stw[(vt * 8 + q * 2 + 1) * 64];
      f32x4 v; v[0] = __uint_as_float(w0 << 16) + st.o[vt][q * 4] * f; v[1] = __uint_as_float(w0 & 0xffff0000u) + st.o[vt][q * 4 + 1] * f;
      v[2] = __uint_as_float(w1 << 16) + st.o[vt][q * 4 + 2] * f; v[3] = __uint_as_float(w1 & 0xffff0000u) + st.o[vt][q * 4 + 3] * f;
      st_bf16x4(orow + vt * 32 + q * 8 + 4 * g, v);
    }
  AT_WAIT_L0();
}
DI void nsa_task(const Params& p, int o_idx, int b, int gk, int tile64) {
  const NsaCtx c{b, gk, tile64, o_idx};
  nsa_cmp1(p, c);
  __syncthreads();
  nsa_cmp2(p, c);
  __syncthreads();
  nsa_topk(p, c);
  __syncthreads();
  nsa_winslc(p, c);
  __syncthreads();
}

DI void cmp2_task(const Params& p, int e, int kv, int rt) {
  const int lane = TIDX & 63, lr = lane & 31, g = lane >> 5;
  const int row = rt * 32 + lr;
  const float* SPL = (const float*)(p.ws + O_SPL) + (size_t)kv * 8 * 2048 * 256 + (size_t)row * 256 + g * 8;
  const float* bias = (const float*)(p.ws + A_BIAS1) + (e * 2 + kv) * 256 + g * 8;
  const bf16_t* W2 = (const bf16_t*)(p.ws + W_C2 + (size_t)(e * 2 + kv) * SZ_C2) + (size_t)lr * 256 + g * 8;
  f32x16 acc[4];
#pragma unroll
  for (int i = 0; i < 4; ++i) acc[i] = zero16();
#pragma unroll 2
  for (int ks = 0; ks < 16; ++ks) {
    f32x4 a0 = *(const f32x4*)(bias + ks * 16), a1 = *(const f32x4*)(bias + ks * 16 + 4);
#pragma unroll
    for (int sp = 0; sp < 8; ++sp) { const float* q = SPL + (size_t)sp * 2048 * 256 + ks * 16; a0 += *(const f32x4*)q; a1 += *(const f32x4*)(q + 4); }
    float hv[8];
#pragma unroll
    for (int i = 0; i < 4; ++i) { hv[i] = gelu_tanh(a0[i]); hv[4 + i] = gelu_tanh(a1[i]); }
    const bf16x8 hb = pack8(hv);
#pragma unroll
    for (int dt = 0; dt < 4; ++dt) { const bf16x8 w = *(const bf16x8*)(W2 + (size_t)dt * 32 * 256 + ks * 16); acc[dt] = mfma32(w, hb, acc[dt]); }
  }
  if (kv == 0) {
    float ss = 0.f;
#pragma unroll
    for (int dt = 0; dt < 4; ++dt)
#pragma unroll
      for (int i = 0; i < 16; ++i) ss += acc[dt][i] * acc[dt][i];
    ss += shx(ss, 32);
    const float rs = rsqrtf(ss * (1.f / 128.f) + EPS_);
    const float* gn = p.in[16] + (e * 3 + 0) * 128;
    bf16_t* orow = (bf16_t*)(p.ws + O_KCMP) + (size_t)row * 128;
#pragma unroll
    for (int dt = 0; dt < 4; ++dt)
#pragma unroll
      for (int q = 0; q < 4; ++q) {
        const int d0 = dt * 32 + q * 8 + 4 * g;
        const f32x4 gg = *(const f32x4*)(gn + d0);
        f32x4 v; for (int e2 = 0; e2 < 4; ++e2) v[e2] = acc[dt][q * 4 + e2] * rs * gg[e2];
        st_bf16x4(orow + d0, v);
      }
  } else {
    bf16_t* ob = (bf16_t*)(p.ws + O_VCMPT) + (size_t)(row >> 8) * 128 * 256 + (size_t)((row & 255) >> 5) * 4096 + (row & 31);
#pragma unroll
    for (int dt = 0; dt < 4; ++dt)
#pragma unroll
      for (int i = 0; i < 16; ++i) ob[(size_t)(dt * 32 + crow(i, g)) * 32] = f2bf(acc[dt][i]);
  }
}

DI void cmp_bias_jobs(const Params& p) {
  extern __shared__ __attribute__((aligned(16))) char dyn_lds[];
  float* red = (float*)dyn_lds;
  const int tid = TIDX, part = tid >> 5, cl = tid & 31;
  for (int it = blockIdx.x; it < 32; it += gridDim.x) {
    const int job = it >> 3, cg8 = it & 7, l = job >> 1, kv = job & 1;
    const float* pe = p.in[kv ? 20 : 17] + (size_t)l * 4096;
    const float* w1 = p.in[kv ? 21 : 18] + (size_t)l * 4096 * 256;
    const int c = cg8 * 32 + cl;
    float s = 0.f;
#pragma unroll 8
    for (int k = part * 256; k < part * 256 + 256; ++k) s += pe[k] * w1[(size_t)k * 256 + c];
    red[part * 32 + cl] = s;
    __syncthreads();
    if (tid < 32) { float a = 0.f; for (int q = 0; q < 16; ++q) a += red[q * 32 + tid]; ((float*)(p.ws + A_BIAS1))[job * 256 + cg8 * 32 + tid] = a; }
    __syncthreads();
  }
}

#define XB_TMO      128
#define XB_XCNT(j)  (256  + 64 * (j))
#define XB_XSUB(j)  (1280 + 64 * (j))
#define XB_XGEN(j)  (2304 + 64 * (j))
#define XB_TOP      3328
#define XB_TOPGEN   3392
#define XCD_BAR_WORDS 3456
#define XB_SPIN_CAP (1u << 18)
DI unsigned xb_ld(unsigned* q)              { return __hip_atomic_load(q, __ATOMIC_RELAXED, __HIP_MEMORY_SCOPE_AGENT); }
DI unsigned xb_add(unsigned* q, unsigned v) { return __hip_atomic_fetch_add(q, v, __ATOMIC_RELAXED, __HIP_MEMORY_SCOPE_AGENT); }
DI unsigned xb_xcc_id() { return (unsigned)__builtin_amdgcn_s_getreg((3 << 11) | 20) & 0xFu; }
#define XB_SPIN(cond, bar) do { unsigned _sp = 0; while (cond) { __builtin_amdgcn_s_sleep(1); \
    if ((++_sp & 255u) == 0u) { if (xb_ld(&(bar)[XB_TMO])) break; if (_sp > XB_SPIN_CAP) { atomicAdd(&(bar)[XB_TMO], 1u); break; } } } } while (0)
struct XcdBarrier { unsigned* bar; unsigned x; volatile LAS unsigned* st; };
DI XcdBarrier xcd_barrier_post(unsigned* bar, volatile LAS unsigned* st) {
  XcdBarrier b; b.bar = bar; b.x = xb_xcc_id(); b.st = st;
  if (threadIdx.x == 0) (void)xb_add(&bar[XB_XCNT(b.x)], 1u);
  return b;
}
DI void xcd_barrier_complete(unsigned* bar, unsigned x, unsigned& nloc, unsigned& nx) {
  const unsigned G = gridDim.x * gridDim.y * gridDim.z;
  unsigned sum, cnt, mine, sp = 0u;
  for (;;) {
    sum = 0u; cnt = 0u; mine = 0u;
#pragma unroll
    for (unsigned j = 0; j < 16; ++j) { const unsigned c = xb_ld(&bar[XB_XCNT(j)]); sum += c; cnt += (c > 0u) ? 1u : 0u; mine = (j == x) ? c : mine; }
    if (sum == G) break;
    __builtin_amdgcn_s_sleep(1);
    if ((++sp & 255u) == 0u) { if (xb_ld(&bar[XB_TMO])) break; if (sp > XB_SPIN_CAP) { atomicAdd(&bar[XB_TMO], 1u); break; } }
  }
  nloc = mine > 0u ? mine : 1u; nx = cnt > 0u ? cnt : 1u;
}
DI void xcd_barrier(const XcdBarrier& b) {
  asm volatile("s_waitcnt vmcnt(0)" ::: "memory");
  __syncthreads();
  if (threadIdx.x == 0) {
    unsigned* bar = b.bar;
    __builtin_amdgcn_s_waitcnt(0);
    unsigned nloc = b.st[0], nx = b.st[1];
    if (nloc == 0u) { xcd_barrier_complete(bar, b.x, nloc, nx); b.st[0] = nloc; b.st[1] = nx; }
    const unsigned old = xb_add(&bar[XB_XSUB(b.x)], 1u);
    const unsigned gen = old / nloc;
    if (old + 1u == (gen + 1u) * nloc) {
      __builtin_amdgcn_fence(__ATOMIC_RELEASE, "agent");
      asm volatile("s_waitcnt vmcnt(0)" ::: "memory");
      const unsigned og = xb_add(&bar[XB_TOP], 1u);
      const unsigned tg = og / nx;
      if (og + 1u == (tg + 1u) * nx) xb_add(&bar[XB_TOPGEN], 1u);
      else XB_SPIN(xb_ld(&bar[XB_TOPGEN]) == tg, bar);
      __builtin_amdgcn_fence(__ATOMIC_ACQUIRE, "agent");
      xb_add(&bar[XB_XGEN(b.x)], 1u);
      asm volatile("s_waitcnt vmcnt(0)" ::: "memory");
    } else {
      XB_SPIN(xb_ld(&bar[XB_XGEN(b.x)]) == gen, bar);
      __builtin_amdgcn_fence(__ATOMIC_ACQUIRE, "agent");
      asm volatile("s_waitcnt vmcnt(0)" ::: "memory");
    }
  }
  __syncthreads();
}

#ifndef ONLY_KEY
#define ONLY_KEY (-1)
#endif
#define KEYOK(k) (ONLY_KEY < 0 || ONLY_KEY == (k))
constexpr int PH_PRE = 1, PH_PER_LAYER = 11, PH_TOTAL = PH_PRE + 4 * PH_PER_LAYER;

DI void run_phase(const Params& p0, int ph) {
  Params p = p0;
  { unsigned long long w_ = (unsigned long long)p0.ws; asm volatile("" : "+s"(w_)); p.ws = (unsigned char*)(__attribute__((address_space(1))) unsigned char*)w_; }
  unsigned char* ws = p.ws;
  if (ph == 0) {
    if (!KEYOK(0)) return;
    transpose_jobs(p);
    rmsnorm_rows(p.in[1], nullptr, (bf16_t*)(ws + A_MEMN), 512);
    xprep_rows(p.in[0], (bf16_t*)(ws + A_H), (float*)(ws + A_SSP), M_);
    cmp_bias_jobs(p);
    return;
  }
  const int layer = (ph - PH_PRE) / PH_PER_LAYER, sidx = (ph - PH_PRE) % PH_PER_LAYER;
  const int step = sidx < 6 ? sidx + 1 : (sidx < 9 ? sidx + 2 : sidx + 3);
  float* sspA = (float*)(ws + A_SSP); float* sspB = sspA + (size_t)M_ * 8; float* sspC = sspB + (size_t)M_ * 8;
  const bool even = (layer & 1) == 0; const int e = layer >> 1;
  const float* xin = layer == 0 ? p.in[0] : (const float*)(ws + A_XRES);
  float* xres = (float*)(ws + A_XRES);
  bf16_t* H = (bf16_t*)(ws + A_H);
  switch (step) {
    case 1:
      if (even) { if (KEYOK(4)) { EpiEvenIn epi{sspA, ws}; gemm_run(H, D_, (const bf16_t*)(ws + W_EIN + e * SZ_EIN), D_, M_, N_EIN, D_, epi); }
        if (layer == 0) { if (KEYOK(1)) { EpiMemKV epi{(bf16_t*)(ws + A_MEMK), (bf16_t*)(ws + A_MEMVT)};
          gemm_run((const bf16_t*)(ws + A_MEMN), D_, (const bf16_t*)(ws + W_MKV), D_, 512, 4096, D_, epi, 160); } } }
      else { if (KEYOK(18)) { EpiOddIn epi{sspA, ws}; gemm_run(H, D_, (const bf16_t*)(ws + W_OIN + e * SZ_OIN), D_, M_, N_OIN, D_, epi); } }
      break;
    case 2:
      if (even) {
        if (KEYOK(5)) {
        headnorm_rows((bf16_t*)(ws + E_FK), 16 * T_, p.in[10] + e * 128, 0, 0);
        if (layer == 0) for (int l = 0; l < 4; ++l) headnorm_rows((bf16_t*)(ws + A_MEMK) + (size_t)l * 8 * 256 * 128, 8 * 256, p.in[27] + l * 128, 0, 0);
        fox_cumsum(p, e);
        hgrn_prep(p, e);
        }
      } else {
        if (KEYOK(19)) {
        headnorm_rows((bf16_t*)(ws + O_KS), 8 * T_, p.in[16] + (e * 3 + 1) * 128, 0, 0);
        headnorm_rows((bf16_t*)(ws + O_KW), 8 * T_, p.in[16] + (e * 3 + 2) * 128, 0, 0);
#pragma unroll 1
        for (int c = 0; c < 16; ++c) {
          const int kv = c >> 3, sp = c & 7;
          EpiF32 epi{(float*)(ws + O_SPL) + (size_t)c * 2048 * 256, 256};
          gemm_run((const bf16_t*)(ws + (kv ? O_VC : O_KC)) + sp * 512, 2048, (const bf16_t*)(ws + W_C1 + (e * 2 + kv) * SZ_C1) + sp * 512, 4096, 2048, 256, 512, epi, c * 8);
        }
        }
      }
      break;
    case 3:
      if (even) {
        if (KEYOK(6)) {
          for (int bt = blockIdx.x; bt < 256; bt += gridDim.x) fox_block(p, e, bt >> 4, bt & 15);
        }
        if (KEYOK(7)) {
          const int wave = TIDX >> 6;
          for (int ti = wave * gridDim.x + blockIdx.x; ti < 4096; ti += 8 * gridDim.x) hgrn_u_task(p, ti >> 8, (ti >> 2) & 63, ti & 3);
        }
      } else {
        if (KEYOK(20)) { const int wave = TIDX >> 6; for (int ti = wave * gridDim.x + blockIdx.x; ti < 128; ti += 8 * gridDim.x) cmp2_task(p, e, ti >> 6, ti & 63); }
      }
      break;
    case 4:
      if (even) { if (KEYOK(8)) hgrn_scan(p); }
      break;
    case 5:
      if (even) {
        if (KEYOK(9)) { const int wave = TIDX >> 6; for (int ti = wave * gridDim.x + blockIdx.x; ti < 2048; ti += 8 * gridDim.x) hgrn_out_task(p, e, ti >> 7, (ti >> 1) & 63, ti & 1); }
      } else {
        if (KEYOK(22)) {
          extern __shared__ __attribute__((aligned(16))) char dyn_lds[];
          volatile LAS unsigned* qs = (volatile LAS unsigned*)((LAS unsigned char*)dyn_lds + NSA_LDS) + 2;
          unsigned* ctr = (unsigned*)(ws + A_BAR) + 3600 + 64 * e;
          for (;;) {
            if (threadIdx.x == 0) qs[0] = __hip_atomic_fetch_add(ctr, 1u, __ATOMIC_RELAXED, __HIP_MEMORY_SCOPE_AGENT);
            __syncthreads();
            const int q = __builtin_amdgcn_readfirstlane((int)qs[0]);
            __syncthreads();
            if (q >= 512) break;
            const int bg = q & 7;
            nsa_task(p, e, bg >> 2, bg & 3, 63 - (q >> 3));
          }
        }
      }
      break;
    case 6: if (KEYOK(10)) {
      EpiResid epi{xin, xres, H, sspB};
      gemm_run((const bf16_t*)(ws + A_MIXO), D_, (const bf16_t*)(ws + (even ? W_EOUT : W_OOUT) + e * SZ_SQ), D_, M_, D_, D_, epi);
    } break;
    case 8: if (KEYOK(11)) {
#pragma unroll 1
      for (int sp = 0; sp < 4; ++sp) {
        EpiF32 epi{(float*)(ws + A_SCR) + (size_t)sp * M_ * 512, 512};
        gemm_run(H + sp * 512, D_, (const bf16_t*)(ws + W_MQ + layer * SZ_MQ) + sp * 512, D_, M_, 512, 512, epi, sp * 64);
      }
    } break;
    case 9:
      if (KEYOK(12)) { for (int bt = blockIdx.x; bt < 256; bt += gridDim.x) memattn_block(p, layer, bt >> 5, bt & 31); }
      break;
    case 10: if (KEYOK(10)) { EpiResid epi{xres, xres, H, sspC}; gemm_run((const bf16_t*)(ws + A_MAO), 512, (const bf16_t*)(ws + W_MO + layer * SZ_MQ), 512, M_, D_, 512, epi); } break;
    case 12: if (KEYOK(13)) { EpiSwiglu epi{sspC, (bf16_t*)(ws + F_HID)}; gemm_run(H, D_, (const bf16_t*)(ws + W_F13 + layer * SZ_F13), D_, M_, N_F13, D_, epi); } break;
    default: if (KEYOK(10)) { EpiResid epi{xres, layer == 3 ? p.out : xres, layer == 3 ? nullptr : H, layer == 3 ? nullptr : sspA}; gemm_run((const bf16_t*)(ws + F_HID), FFN_, (const bf16_t*)(ws + W_F2 + layer * SZ_F2), FFN_, M_, D_, FFN_, epi); } break;
  }
}

__global__ void __launch_bounds__(NTH) fwd_megakernel(Params p) {
#if ONE_LAUNCH
  cg::grid_group grid = cg::this_grid();
  extern __shared__ __attribute__((aligned(16))) char dyn_lds[];
  volatile LAS unsigned* xst = (volatile LAS unsigned*)((LAS unsigned char*)dyn_lds + NSA_LDS);
  if (threadIdx.x == 0) { xst[0] = 0u; xst[1] = 0u; xst[2] = 0u; xst[3] = 0u; }
  __syncthreads();
  const XcdBarrier xb = xcd_barrier_post((unsigned*)(p.ws + A_BAR), xst);
  for (int ph = p.ph_lo; ph < p.ph_hi; ++ph) {
    if (ph >= PH_PRE && (((ph - PH_PRE) / PH_PER_LAYER) & 1) == 1 && (ph - PH_PRE) % PH_PER_LAYER == 3) continue;
    run_phase(p, ph);
    if (ph + 1 < p.ph_hi) { if (ph == 0) grid.sync(); else xcd_barrier(xb); }
  }
#else
  for (int ph = p.ph_lo; ph < p.ph_hi; ++ph) run_phase(p, ph);
#endif
}

extern "C" void kernel_launch(void* const* d_in, const int* in_sizes, int n_in, void* d_out, int out_size, void* d_ws, size_t ws_size, hipStream_t stream) {
  static int grid_blocks = 0;
  constexpr size_t kDynLds = NSA_LDS + 16;
  if (grid_blocks == 0) {
    if (n_in != 31 || ws_size < WS_NEED) { fprintf(stderr, "kernel_launch: need 31 inputs and %zu workspace bytes; got %d, %zu\n", (size_t)WS_NEED, n_in, ws_size); grid_blocks = -1; return; }
    int dev = 0, cus = 0, per_cu = 0;
    hipGetDevice(&dev);
    hipDeviceGetAttribute(&cus, hipDeviceAttributeMultiprocessorCount, dev);
    hipFuncSetAttribute((const void*)fwd_megakernel, hipFuncAttributeMaxDynamicSharedMemorySize, (int)kDynLds);
    hipOccupancyMaxActiveBlocksPerMultiprocessor(&per_cu, (const void*)fwd_megakernel, NTH, kDynLds);
    if (per_cu < 1) per_cu = 1;
    grid_blocks = cus * per_cu;
    if (grid_blocks > 256) grid_blocks = 256;
  }
  if (grid_blocks < 0) return;
  hipMemsetAsync((unsigned char*)d_ws + A_BAR, 0, BAR_BYTES, stream);
  Params p{};
  for (int i = 0; i < 31; ++i) p.in[i] = (const float*)d_in[i];
  p.out = (float*)d_out; p.ws = (unsigned char*)d_ws;
#if ONE_LAUNCH
  p.ph_lo = 0; p.ph_hi = PH_TOTAL;
  void* args[] = {&p};
  hipError_t e = hipLaunchCooperativeKernel((const void*)fwd_megakernel, dim3(grid_blocks), dim3(NTH), args, kDynLds, stream);
  if (e != hipSuccess) fprintf(stderr, "cooperative launch failed: %s (grid %d)\n", hipGetErrorString(e), grid_blocks);
#else
  for (int ph = 0; ph < PH_TOTAL; ++ph) {
    p.ph_lo = ph; p.ph_hi = ph + 1;
    hipLaunchKernelGGL(fwd_megakernel, dim3(grid_blocks), dim3(NTH), kDynLds, stream, p);
  }
#endif
}
```

```cpp
#include <hip/hip_runtime.h>
#include <hip/hip_cooperative_groups.h>
#include <cstdio>
namespace cg = cooperative_groups;

#ifndef ONE_LAUNCH
#define ONE_LAUNCH 1
#endif

typedef unsigned short bf16_t;
typedef short bf16x8 __attribute__((ext_vector_type(8)));
typedef short s16x4 __attribute__((ext_vector_type(4)));
typedef float f32x4 __attribute__((ext_vector_type(4)));
typedef float f32x16 __attribute__((ext_vector_type(16)));
typedef unsigned u32x2 __attribute__((ext_vector_type(2)));
typedef unsigned u32x4 __attribute__((ext_vector_type(4)));
#define DI __device__ __forceinline__

constexpr int T_ = 4096, M_ = 8192, D_ = 2048, NTH = 512;
constexpr float EPS_ = 1e-6f, LOG2E = 1.4426950408889634f, ATTN_SCALE = 0.08838834764831845f;
#define NEG_INF (-__builtin_inff())

constexpr size_t al(size_t x) { return (x + 255) & ~(size_t)255; }
constexpr int N_EIN = 7424, N_OIN = 5376, N_F13 = 11264, FFN_ = 5632;
constexpr size_t SZ_EIN = (size_t)N_EIN * 2048 * 2, SZ_SQ = (size_t)2048 * 2048 * 2, SZ_OIN = (size_t)N_OIN * 2048 * 2;
constexpr size_t SZ_C1 = (size_t)256 * 4096 * 2, SZ_C2 = (size_t)256 * 256 * 2, SZ_MQ = (size_t)512 * 2048 * 2, SZ_MKV = (size_t)1024 * 2048 * 2;
constexpr size_t SZ_F13 = (size_t)N_F13 * 2048 * 2, SZ_F2 = (size_t)2048 * FFN_ * 2;
constexpr size_t W_EIN = 0;
constexpr size_t W_EOUT = W_EIN + 2 * SZ_EIN;
constexpr size_t W_OIN = W_EOUT + 2 * SZ_SQ;
constexpr size_t W_OOUT = W_OIN + 2 * SZ_OIN;
constexpr size_t W_C1 = W_OOUT + 2 * SZ_SQ;
constexpr size_t W_C2 = W_C1 + 4 * SZ_C1;
constexpr size_t W_MQ = W_C2 + 4 * SZ_C2;
constexpr size_t W_MKV = W_MQ + 4 * SZ_MQ;
constexpr size_t W_MO = W_MKV + 4 * SZ_MKV;
constexpr size_t W_F13 = W_MO + 4 * SZ_MQ;
constexpr size_t W_F2 = W_F13 + 4 * SZ_F13;
constexpr size_t W_END = W_F2 + 4 * SZ_F2;
constexpr size_t A_XRES = al(W_END);
constexpr size_t A_H = A_XRES + (size_t)M_ * D_ * 4;
constexpr size_t A_MEMN = A_H + (size_t)M_ * D_ * 2;
constexpr size_t A_MEMK = A_MEMN + (size_t)4 * 512 * 2048 * 2;
constexpr size_t A_MEMVT = A_MEMK + (size_t)4 * 2 * 4 * 256 * 128 * 2;
constexpr size_t A_BIAS1 = A_MEMVT + (size_t)4 * 2 * 4 * 256 * 128 * 2;
constexpr size_t A_QM = A_BIAS1 + 4096;
constexpr size_t A_MAO = A_QM + (size_t)M_ * 512 * 2;
constexpr size_t A_MIXO = A_MAO + (size_t)M_ * 512 * 2;
constexpr size_t A_SSP = A_MIXO + (size_t)M_ * D_ * 2;
constexpr size_t SZ_SSP = (size_t)M_ * 8 * 4;
constexpr size_t A_BAR = A_SSP + 3 * SZ_SSP;
constexpr size_t BAR_BYTES = 16384;
constexpr size_t A_SCR = A_BAR + BAR_BYTES;
constexpr size_t SZ16 = (size_t)M_ * 1024 * 2;
constexpr size_t E_FQ = A_SCR, E_FK = E_FQ + SZ16, E_FVT = E_FK + SZ16, E_HQ = E_FVT + SZ16, E_HF = E_HQ + SZ16  ,
                 E_HIT = E_HF + 2 * SZ16, E_HG = E_HIT + SZ16, E_QT = E_HG + SZ16, E_KT = E_QT + SZ16, E_QS = E_KT + SZ16, E_KUT = E_QS + SZ16,
                 E_U = E_KUT + SZ16  , E_FF = E_U + 4 * SZ16  , E_FC = E_FF + (size_t)M_ * 8 * 4  ,
                 E_DL = E_FC + (size_t)16 * T_ * 4  , E_END = E_DL + (size_t)16 * 64 * 128 * 4;
constexpr size_t E_ST = E_HF;
constexpr size_t SZ8 = (size_t)M_ * 512 * 2;
constexpr size_t O_NQ = A_SCR, O_KC = O_NQ + 2 * SZ16, O_VC = O_KC + SZ8 + 65536, O_KS = O_VC + SZ8 + 65536, O_KW = O_KS + SZ8, O_VST = O_KW + SZ8,
                 O_VWT = O_VST + SZ8, O_GT = O_VWT + SZ8  , O_HC = O_GT + (size_t)M_ * 48 * 4  ,
                 O_KCMP = O_HC + (size_t)2 * 2048 * 256 * 2, O_VCMPT = O_KCMP + (size_t)2048 * 128 * 2, O_SPL = O_VCMPT + (size_t)2048 * 128 * 2  ,
                 O_END = O_SPL + (size_t)16 * 2048 * 256 * 4;
constexpr size_t F_HID = A_SCR;
constexpr size_t F_END = F_HID + (size_t)M_ * FFN_ * 2;
constexpr size_t WS_NEED = (E_END > O_END ? (E_END > F_END ? E_END : F_END) : (O_END > F_END ? O_END : F_END));

struct Params {
  const float* in[31];
  float* out;
  unsigned char* ws;
  int ph_lo, ph_hi;
};

DI int launder(int x) { asm volatile("" : "+v"(x)); return x; }
#define TIDX launder((int)threadIdx.x)
DI float bf2f(bf16_t v) { return __uint_as_float(((unsigned)v) << 16); }
typedef __bf16 hwbf16x2g __attribute__((ext_vector_type(2)));
typedef float f32x2g __attribute__((ext_vector_type(2)));
DI unsigned pk2(float lo, float hi) { const f32x2g f = {lo, hi}; const hwbf16x2g r = __builtin_convertvector(f, hwbf16x2g); return __builtin_bit_cast(unsigned, r); }
DI bf16_t f2bf(float x) { return (bf16_t)(pk2(x, 0.f) & 0xffffu); }
DI int lane_now() { return TIDX & 63; }
DI float shx(float v, int mask) { return __int_as_float(__builtin_amdgcn_ds_bpermute((lane_now() ^ mask) << 2, __float_as_int(v))); }
DI unsigned shxu(unsigned v, int mask) { return (unsigned)__builtin_amdgcn_ds_bpermute((lane_now() ^ mask) << 2, (int)v); }
DI float xhalf_max(float v) { const auto r = __builtin_amdgcn_permlane32_swap(__float_as_uint(v), __float_as_uint(v), false, false); return fmaxf(__uint_as_float(r[0]), __uint_as_float(r[1])); }
DI float xhalf_sum(float v) { const auto r = __builtin_amdgcn_permlane32_swap(__float_as_uint(v), __float_as_uint(v), false, false); return __uint_as_float(r[0]) + __uint_as_float(r[1]); }
DI float shidx(float v, int src) { return __int_as_float(__builtin_amdgcn_ds_bpermute(src << 2, __float_as_int(v))); }
DI float wave_sum(float v) {
#pragma unroll
  for (int o = 1; o < 64; o <<= 1) v += shx(v, o);
  return v;
}
DI float fexp2(float x) { return __builtin_amdgcn_exp2f(x); }
DI float frcp(float x) { return __builtin_amdgcn_rcpf(x); }
DI float sigmoidf_(float x) { return frcp(1.f + __expf(-x)); }
DI f32x16 mfma32(bf16x8 a, bf16x8 b, f32x16 c) { return __builtin_amdgcn_mfma_f32_32x32x16_bf16(a, b, c, 0, 0, 0); }
DI f32x16 zero16() { f32x16 z; for (int i = 0; i < 16; ++i) z[i] = 0.f; return z; }

constexpr int BM = 256, BK = 64, HALF = 128, HT = HALF * BK, NXCD = 8, WGM = 8;
constexpr int GEMM_LDS = 8 * HT * 2;
DI int lds_byte(int r, int c) { int st = (r >> 4) * 2 + (c >> 5), rr = r & 15, cc = c & 31, ob = rr * 64 + cc * 2; return st * 1024 + (ob ^ (((ob >> 9) & 1) << 5)); }
DI void stage_rc(int b, int& R, int& C) { int st = b / 1024, sb = b % 1024, swz = sb ^ (((sb >> 9) & 1) << 5); R = (st >> 1) * 16 + swz / 64; C = (st & 1) * 32 + (swz % 64) / 2; }

#define LAS __attribute__((address_space(3)))
DI const char* uniform_ptr(const char* p) { const unsigned long long v = (unsigned long long)p; const unsigned lo = (unsigned)__builtin_amdgcn_readfirstlane((int)(unsigned)v), hi = (unsigned)__builtin_amdgcn_readfirstlane((int)(unsigned)(v >> 32)); return (const char*)(((unsigned long long)hi << 32) | lo); }
template <class Epi>
DI void gemm_run(const bf16_t* __restrict__ A, int lda, const bf16_t* __restrict__ Bt, int ldb, int M, int N, int K, const Epi& epi, int blk_off = 0) {
  extern __shared__ __attribute__((aligned(16))) char dyn_lds[];
  LAS unsigned char* lds = (LAS unsigned char*)dyn_lds;
  const int tid = TIDX, wid = __builtin_amdgcn_readfirstlane(tid >> 6), lane = tid & 63, wr = wid >> 2, wc = wid & 3, fr = lane & 15, fq = lane >> 4;
  const int nt = K / BK;
  unsigned voffA[2], voffB[2];
#pragma unroll
  for (int i = 0; i < 2; ++i) { int R, C; stage_rc(tid * 16 + i * 8192, R, C); voffA[i] = (unsigned)(R * lda + C) * 2u; voffB[i] = (unsigned)(R * ldb + C) * 2u; }
  const size_t kstep = (size_t)(BK * 2);
  const size_t hstepA = (size_t)HALF * lda * 2, hstepB = (size_t)HALF * ldb * 2;
  const unsigned ldsw = (unsigned)wid * 1024u;
  const int aoff = lds_byte(wr * 64 + fr, fq * 8), boff = lds_byte(wc * 32 + fr, fq * 8);
  constexpr int HTB = HT * 2;
#define G_SA(b, h) (((b) * 2 + (h)) * HTB)
#define G_SB(b, h) ((4 + (b) * 2 + (h)) * HTB)
#define G_STAGE(bufoff, gbase, voff) do { _Pragma("unroll") for (int _i = 0; _i < 2; ++_i) \
    __builtin_amdgcn_global_load_lds((const unsigned*)(uniform_ptr((const char*)(gbase)) + (voff)[_i]), (LAS unsigned*)(lds + (bufoff) + ldsw + _i * 8192), 16, 0, 0); } while (0)
#define G_LDA(dst, b, h) do { _Pragma("unroll") for (int m = 0; m < 4; ++m) _Pragma("unroll") for (int k = 0; k < 2; ++k) dst[m][k] = *(const LAS bf16x8*)(lds + G_SA(b, h) + aoff + m * 2048 + k * 1024); } while (0)
#define G_LDB(dst, b, h) do { _Pragma("unroll") for (int n = 0; n < 2; ++n) _Pragma("unroll") for (int k = 0; k < 2; ++k) dst[n][k] = *(const LAS bf16x8*)(lds + G_SB(b, h) + boff + n * 2048 + k * 1024); } while (0)
#define G_MMA(ai, bj, At, Bx) do { __builtin_amdgcn_s_setprio(1); _Pragma("unroll") for (int m = 0; m < 4; ++m) _Pragma("unroll") for (int n = 0; n < 2; ++n) _Pragma("unroll") for (int k = 0; k < 2; ++k) \
    acc[ai][bj][m][n] = __builtin_amdgcn_mfma_f32_16x16x32_bf16(Bx[n][k], At[m][k], acc[ai][bj][m][n], 0, 0, 0); __builtin_amdgcn_s_setprio(0); } while (0)
#define WAIT_V(n) asm volatile("s_waitcnt vmcnt(" #n ")" ::: "memory")
#define WAIT_L(n) asm volatile("s_waitcnt lgkmcnt(" #n ")" ::: "memory")
#define BAR __builtin_amdgcn_s_barrier()
#define SCHED __builtin_amdgcn_sched_barrier(0)
  const int nM = M / BM, nN = N / BM, nwg = nM * nN;
  for (int u = (int)((blockIdx.x + gridDim.x - blk_off) % gridDim.x); u < nwg; u += gridDim.x) {
    int wgid = u;
    { int q = nwg / NXCD, r = nwg % NXCD, xcd = wgid % NXCD, off = wgid / NXCD; wgid = (xcd < r ? xcd * (q + 1) : r * (q + 1) + (xcd - r) * q) + off; }
    int nig = WGM * nN, gid = wgid / nig, fm = gid * WGM, gsz = min(nM - fm, WGM);
    const int pm = __builtin_amdgcn_readfirstlane(fm + ((wgid % nig) % gsz)), pn = __builtin_amdgcn_readfirstlane((wgid % nig) / gsz), brow = pm * BM, bcol = pn * BM;
    f32x4 acc[2][2][4][2];
#pragma unroll
    for (int a = 0; a < 2; ++a)
#pragma unroll
      for (int b = 0; b < 2; ++b)
#pragma unroll
        for (int m = 0; m < 4; ++m)
#pragma unroll
          for (int n = 0; n < 2; ++n) acc[a][b][m][n] = (f32x4){0.f, 0.f, 0.f, 0.f};
    bf16x8 At[4][2], B0[2][2], B1[2][2];
    const char* cA = (const char*)A + (size_t)brow * lda * 2; const char* cB = (const char*)Bt + (size_t)bcol * ldb * 2;
    G_STAGE(G_SB(0, 0), cB, voffB); G_STAGE(G_SA(0, 0), cA, voffA); G_STAGE(G_SB(0, 1), cB + hstepB, voffB); G_STAGE(G_SA(0, 1), cA + hstepA, voffA);
    if (wr == 1) BAR;
    WAIT_V(4); BAR;
    G_STAGE(G_SB(1, 0), cB + kstep, voffB); G_STAGE(G_SA(1, 0), cA + kstep, voffA); G_STAGE(G_SB(1, 1), cB + hstepB + kstep, voffB);
    WAIT_V(6); BAR;
    for (int t = 0; t < nt - 2; t += 2) {
      const char* a1 = cA + (size_t)(t + 1) * kstep;
      const char* a2 = cA + (size_t)(t + 2) * kstep; const char* b2 = cB + (size_t)(t + 2) * kstep;
      const char* a3 = a2 + kstep; const char* b3 = b2 + kstep;
      G_LDB(B0, 0, 0); SCHED; G_LDA(At, 0, 0); G_STAGE(G_SA(1, 1), a1 + hstepA, voffA);
      WAIT_L(8); BAR; WAIT_L(0); G_MMA(0, 0, At, B0); BAR; SCHED;
      G_LDB(B1, 0, 1); G_STAGE(G_SB(0, 0), b2, voffB);
      BAR; WAIT_L(0); G_MMA(0, 1, At, B1); BAR;
      G_LDA(At, 0, 1); G_STAGE(G_SA(0, 0), a2, voffA);
      BAR; WAIT_L(0); G_MMA(1, 0, At, B0); BAR; SCHED;
      G_STAGE(G_SB(0, 1), b2 + hstepB, voffB);
      WAIT_V(6); BAR; G_MMA(1, 1, At, B1); BAR;
      G_LDB(B0, 1, 0); SCHED; G_LDA(At, 1, 0); G_STAGE(G_SA(0, 1), a2 + hstepA, voffA);
      WAIT_L(8); BAR; WAIT_L(0); G_MMA(0, 0, At, B0); BAR; SCHED;
      G_LDB(B1, 1, 1); G_STAGE(G_SB(1, 0), b3, voffB);
      BAR; WAIT_L(0); G_MMA(0, 1, At, B1); BAR;
      G_LDA(At, 1, 1); G_STAGE(G_SA(1, 0), a3, voffA);
      BAR; WAIT_L(0); G_MMA(1, 0, At, B0); BAR; SCHED;
      G_STAGE(G_SB(1, 1), b3 + hstepB, voffB);
      WAIT_V(6); BAR; G_MMA(1, 1, At, B1); BAR;
    }
    { G_LDB(B0, 0, 0); G_LDA(At, 0, 0); G_STAGE(G_SA(1, 1), cA + (size_t)(nt - 1) * kstep + hstepA, voffA);
      BAR; WAIT_L(0); G_MMA(0, 0, At, B0); BAR;
      G_LDB(B1, 0, 1); BAR; WAIT_L(0); G_MMA(0, 1, At, B1); BAR;
      G_LDA(At, 0, 1); WAIT_V(4); BAR; WAIT_L(0); G_MMA(1, 0, At, B0); G_MMA(1, 1, At, B1); BAR; }
    { G_LDB(B0, 1, 0); G_LDA(At, 1, 0); WAIT_V(2); BAR; WAIT_L(0); G_MMA(0, 0, At, B0); BAR;
      G_LDB(B1, 1, 1); WAIT_V(0); BAR; WAIT_L(0); G_MMA(0, 1, At, B1); BAR;
      G_LDA(At, 1, 1); BAR; WAIT_L(0); G_MMA(1, 0, At, B0); G_MMA(1, 1, At, B1); BAR; }
    if (wr == 0) BAR;
    float rowss[2][4];
    const int lane_e = TIDX & 63, fr_e = lane_e & 15, fq_e = lane_e >> 4;
#pragma unroll
    for (int ai = 0; ai < 2; ++ai)
#pragma unroll
      for (int m = 0; m < 4; ++m) {
        const int row = brow + ai * HALF + wr * 64 + m * 16 + fr_e;
        const float rsc = epi.rowscale(row);
        float ssq = 0.f;
#pragma unroll
        for (int bj = 0; bj < 2; ++bj)
          ssq += epi(row, bcol + bj * HALF + wc * 32, fq_e, acc[ai][bj][m][0] * rsc, acc[ai][bj][m][1] * rsc);
        rowss[ai][m] = ssq;
        __builtin_amdgcn_sched_barrier(0);
      }
    if constexpr (Epi::HAS_SS) {
      float* ssp = epi.ssp_ptr();
      if (ssp) {
        LAS float* red = (LAS float*)lds;
#pragma unroll
        for (int ai = 0; ai < 2; ++ai)
#pragma unroll
          for (int m = 0; m < 4; ++m) {
            float v = rowss[ai][m];
            v += shx(v, 16); v += shx(v, 32);
            if (fq_e == 0) red[(ai * HALF + wr * 64 + m * 16 + fr_e) * 4 + wc] = v;
          }
        __syncthreads();
        { const int t2 = TIDX; if (t2 < 256) { const LAS float* q = red + t2 * 4; ssp[(size_t)(brow + t2) * 8 + pn] = (q[0] + q[1]) + (q[2] + q[3]); } }
      }
    }
    __syncthreads();
  }
}

typedef __bf16 hwbf16x2e __attribute__((ext_vector_type(2)));
typedef float f32x2e __attribute__((ext_vector_type(2)));
DI unsigned pk2e(float lo, float hi) { const f32x2e f = {lo, hi}; const hwbf16x2e r = __builtin_convertvector(f, hwbf16x2e); return __builtin_bit_cast(unsigned, r); }
DI void st_bf16x4(bf16_t* p, f32x4 v) { u32x2 o; o.x = pk2e(v[0], v[1]); o.y = pk2e(v[2], v[3]); *(u32x2*)p = o; }
DI void st_tr4(bf16_t* p, size_t stride, f32x4 v) { p[0] = f2bf(v[0]); p[stride] = f2bf(v[1]); p[2 * stride] = f2bf(v[2]); p[3 * stride] = f2bf(v[3]); }

struct EpiEvenIn {
  static constexpr bool HAS_SS = false;
  const float* ssp_in;
  DI float rowscale(int row) const { const f32x4 a = *(const f32x4*)(ssp_in + (size_t)row * 8), b = *(const f32x4*)(ssp_in + (size_t)row * 8 + 4);
    return rsqrtf((((a[0] + a[1]) + (a[2] + a[3])) + ((b[0] + b[1]) + (b[2] + b[3]))) * (1.f / D_) + EPS_); }
  DI float* ssp_ptr() const { return nullptr; }
  unsigned char* ws;
  DI void one(int row, int c, f32x4 v) const {
    const int b = row >> 12, t = row & 4095;
    if (c < 3072) {
      const int seg = c >> 10, cc = c & 1023, h = cc >> 7, d = cc & 127;
      if (seg < 2) st_bf16x4((bf16_t*)(ws + (seg == 0 ? E_FQ : E_FK)) + ((size_t)(b * 8 + h) * T_ + t) * 128 + d, v);
      else st_tr4((bf16_t*)(ws + E_FVT) + (size_t)(b * 8 + h) * 128 * T_ + (size_t)(t >> 5) * 4096 + d * 32 + ((((t & 31) >> 2) ^ ((d >> 2) & 7)) << 2) + (t & 3), 32, v);
    } else if (c < 4096) { st_bf16x4((bf16_t*)(ws + E_HQ) + (size_t)row * 1024 + (c - 3072), v);
    } else if (c < 5120) { *(f32x4*)((float*)(ws + E_HF) + (size_t)row * 1024 + (c - 4096)) = v;
    } else if (c < 6144) { const int cc = c - 5120, h = cc >> 7, d = cc & 127; st_tr4((bf16_t*)(ws + E_HIT) + (size_t)(b * 8 + h) * 128 * T_ + (size_t)(t >> 5) * 4096 + d * 32 + (t & 31), 32, v);
    } else if (c < 7168) { st_bf16x4((bf16_t*)(ws + E_HG) + (size_t)row * 1024 + (c - 6144), v);
    } else if (c < 7176) { *(f32x4*)((float*)(ws + E_FF) + (size_t)row * 8 + (c - 7168)) = v; }
  }
  DI float operator()(int row, int colbase, int fq, f32x4 v0, f32x4 v1) const { one(row, colbase + 4 * fq, v0); one(row, colbase + 16 + 4 * fq, v1); return 0.f; }
};
struct EpiOddIn {
  static constexpr bool HAS_SS = false;
  const float* ssp_in;
  DI float rowscale(int row) const { const f32x4 a = *(const f32x4*)(ssp_in + (size_t)row * 8), b = *(const f32x4*)(ssp_in + (size_t)row * 8 + 4);
    return rsqrtf((((a[0] + a[1]) + (a[2] + a[3])) + ((b[0] + b[1]) + (b[2] + b[3]))) * (1.f / D_) + EPS_); }
  DI float* ssp_ptr() const { return nullptr; }
  unsigned char* ws;
  DI void one(int row, int c, f32x4 v) const {
    const int b = row >> 12, t = row & 4095;
    if (c < 2048) { const int h = c >> 7, d = c & 127; st_bf16x4((bf16_t*)(ws + O_NQ) + ((size_t)(b * 16 + h) * T_ + t) * 128 + d, v); }
    else if (c < 5120) {
      const int seg = (c - 2048) >> 9, cc = (c - 2048) & 511, g = cc >> 7, d = cc & 127;
      if (seg == 3 || seg == 5) st_tr4((bf16_t*)(ws + (seg == 3 ? O_VST : O_VWT)) + (size_t)(b * 4 + g) * 128 * T_ + (size_t)(t >> 5) * 4096 + d * 32 + ((((t & 31) >> 2) ^ ((d >> 2) & 7)) << 2) + (t & 3), 32, v);
      else { const size_t off = seg == 0 ? O_KC : seg == 1 ? O_VC : seg == 2 ? O_KS : O_KW;
        st_bf16x4((bf16_t*)(ws + off) + ((size_t)(b * 4 + g) * T_ + t) * 128 + d, v); }
    } else if (c < 5168) { *(f32x4*)((float*)(ws + O_GT) + (size_t)row * 48 + (c - 5120)) = v; }
  }
  DI float operator()(int row, int colbase, int fq, f32x4 v0, f32x4 v1) const { one(row, colbase + 4 * fq, v0); one(row, colbase + 16 + 4 * fq, v1); return 0.f; }
};
struct EpiResid {
  static constexpr bool HAS_SS = true;
  const float* src; float* dst; bf16_t* xb; float* ssp;
  DI float rowscale(int) const { return 1.f; }
  DI float* ssp_ptr() const { return ssp; }
  DI float operator()(int row, int colbase, int fq, f32x4 v0, f32x4 v1) const {
    const size_t o = (size_t)row * D_ + colbase + 4 * fq;
    const f32x4 a = *(const f32x4*)(src + o) + v0, b = *(const f32x4*)(src + o + 16) + v1;
    *(f32x4*)(dst + o) = a; *(f32x4*)(dst + o + 16) = b;
    if (xb) { st_bf16x4(xb + o, a); st_bf16x4(xb + o + 16, b); }
    return ((a[0] * a[0] + a[1] * a[1]) + (a[2] * a[2] + a[3] * a[3])) + ((b[0] * b[0] + b[1] * b[1]) + (b[2] * b[2] + b[3] * b[3]));
  }
};
struct EpiMemQ {
  static constexpr bool HAS_SS = false;
  const float* ssp_in;
  DI float rowscale(int row) const { const f32x4 a = *(const f32x4*)(ssp_in + (size_t)row * 8), b = *(const f32x4*)(ssp_in + (size_t)row * 8 + 4);
    return rsqrtf((((a[0] + a[1]) + (a[2] + a[3])) + ((b[0] + b[1]) + (b[2] + b[3]))) * (1.f / D_) + EPS_); }
  DI float* ssp_ptr() const { return nullptr; }
  bf16_t* qm;
  DI float operator()(int row, int colbase, int fq, f32x4 v0, f32x4 v1) const {
    const int b = row >> 12, t = row & 4095, c = colbase + 4 * fq, h = c >> 7, d = c & 127;
    bf16_t* p = qm + ((size_t)(b * 4 + h) * T_ + t) * 128 + d;
    st_bf16x4(p, v0); st_bf16x4(p + 16, v1); return 0.f;
  }
};
struct EpiMemKV {
  static constexpr bool HAS_SS = false;
  DI float rowscale(int) const { return 1.f; }
  DI float* ssp_ptr() const { return nullptr; }
  bf16_t* mk; bf16_t* mvt;
  DI void one(int row, int c0, f32x4 v) const {
    const int b = row >> 8, s = row & 255, l = c0 >> 10, c = c0 & 1023;
    const size_t lo = (size_t)l * 8 * 256 * 128;
    if (c < 512) { const int h = c >> 7, d = c & 127; st_bf16x4(mk + lo + ((size_t)(b * 4 + h) * 256 + s) * 128 + d, v); }
    else { const int cc = c - 512, h = cc >> 7, d = cc & 127;
      st_tr4(mvt + lo + (size_t)(b * 4 + h) * 128 * 256 + (size_t)(s >> 5) * 4096 + d * 32 + ((((s & 31) >> 2) ^ ((d >> 2) & 7)) << 2) + (s & 3), 32, v); }
  }
  DI float operator()(int row, int colbase, int fq, f32x4 v0, f32x4 v1) const { one(row, colbase + 4 * fq, v0); one(row, colbase + 16 + 4 * fq, v1); return 0.f; }
};
struct EpiSwiglu {
  static constexpr bool HAS_SS = false;
  const float* ssp_in;
  DI float rowscale(int row) const { const f32x4 a = *(const f32x4*)(ssp_in + (size_t)row * 8), b = *(const f32x4*)(ssp_in + (size_t)row * 8 + 4);
    return rsqrtf((((a[0] + a[1]) + (a[2] + a[3])) + ((b[0] + b[1]) + (b[2] + b[3]))) * (1.f / D_) + EPS_); }
  DI float* ssp_ptr() const { return nullptr; }
  bf16_t* hid;
  DI float operator()(int row, int colbase, int fq, f32x4 v0, f32x4 v1) const {
    f32x4 r;
#pragma unroll
    for (int e = 0; e < 4; ++e) r[e] = v0[e] * sigmoidf_(v0[e]) * v1[e];
    st_bf16x4(hid + (size_t)row * FFN_ + (colbase >> 1) + 4 * fq, r); return 0.f;
  }
};
DI float gelu_tanh(float x) { const float u = 0.7978845608028654f * (x + 0.044715f * x * x * x); const float e = __expf(2.f * u); const float th = 1.f - 2.f * frcp(e + 1.f); return 0.5f * x * (1.f + th); }
struct EpiF32 {
  static constexpr bool HAS_SS = false;
  DI float rowscale(int) const { return 1.f; }
  DI float* ssp_ptr() const { return nullptr; }
  float* dst; int ld;
  DI float operator()(int row, int colbase, int fq, f32x4 v0, f32x4 v1) const {
    float* q = dst + (size_t)row * ld + colbase + 4 * fq; *(f32x4*)q = v0; *(f32x4*)(q + 16) = v1; return 0.f;
  }
};
struct EpiCmp1 {
  static constexpr bool HAS_SS = false;
  DI float rowscale(int) const { return 1.f; }
  DI float* ssp_ptr() const { return nullptr; }
  bf16_t* hc; const float* bias;
  DI float operator()(int row, int colbase, int fq, f32x4 v0, f32x4 v1) const {
    const int c = colbase + 4 * fq;
    f32x4 b0 = *(const f32x4*)(bias + c), b1 = *(const f32x4*)(bias + c + 16), r0, r1;
#pragma unroll
    for (int e = 0; e < 4; ++e) { r0[e] = gelu_tanh(v0[e] + b0[e]); r1[e] = gelu_tanh(v1[e] + b1[e]); }
    st_bf16x4(hc + (size_t)row * 256 + c, r0); st_bf16x4(hc + (size_t)row * 256 + c + 16, r1); return 0.f;
  }
};
struct EpiCmp2 {
  static constexpr bool HAS_SS = false;
  DI float rowscale(int) const { return 1.f; }
  DI float* ssp_ptr() const { return nullptr; }
  bf16_t* dst; int isv;
  DI void one(int row, int c, f32x4 v) const {
    if (c >= 128) return;
    if (!isv) st_bf16x4(dst + (size_t)row * 128 + c, v);
    else st_tr4(dst + ((size_t)(row >> 8) * 128 + c) * 256 + (row & 255), 256, v);
  }
  DI float operator()(int row, int colbase, int fq, f32x4 v0, f32x4 v1) const { one(row, colbase + 4 * fq, v0); one(row, colbase + 16 + 4 * fq, v1); return 0.f; }
};

struct TDesc { const float* src; const float* src2; const float* rscale; bf16_t* dst; int K, Nsrc, map, k0, n0; };
constexpr int TR_LD = 260;
DI bool decode_tile(const Params& p, int gi, TDesc& d) {
#define TCLS(CNT, KK, NS, ND, MP, SRC, SRC2, RS, RSS, DB, DS) { const int ntn = (ND) / 256, per = ((KK) / 64) * ntn, tot = (CNT) * per; \
    if (gi < tot) { const int l = gi / per, tl = gi % per; d.src = (SRC) + (size_t)l * (KK) * (NS); d.src2 = (SRC2) ? (SRC2) + (size_t)l * (KK) * (NS) : nullptr; \
      d.rscale = (RS) ? (RS) + (size_t)l * (RSS) : nullptr; d.dst = (bf16_t*)(p.ws + (DB) + (size_t)l * (DS)); d.K = (KK); d.Nsrc = (NS); d.map = (MP); \
      d.k0 = (tl / ntn) * 64; d.n0 = (tl % ntn) * 256; return true; } gi -= tot; }
  const float* nul = nullptr;
  TCLS(4, 2048, 5632, N_F13, 2, p.in[28], p.in[29], p.in[4], 2048, W_F13, SZ_F13)
  TCLS(4, 5632, 2048, 2048, 0, p.in[30], nul, nul, 0, W_F2, SZ_F2)
  TCLS(2, 2048, 7176, N_EIN, 1, p.in[6], nul, p.in[2], 4096, W_EIN, SZ_EIN)
  TCLS(2, 2048, 5168, N_OIN, 0, p.in[13], nul, p.in[2] + 2048, 4096, W_OIN, SZ_OIN)
  TCLS(2, 2048, 2048, 2048, 0, p.in[7], nul, nul, 0, W_EOUT, SZ_SQ)
  TCLS(2, 2048, 2048, 2048, 0, p.in[14], nul, nul, 0, W_OOUT, SZ_SQ)
  TCLS(4, 2048, 1024, 1024, 0, p.in[24], nul, p.in[5], 2048, W_MKV, SZ_MKV)
  TCLS(4, 2048, 512, 512, 0, p.in[23], nul, p.in[3], 2048, W_MQ, SZ_MQ)
  TCLS(4, 512, 2048, 2048, 0, p.in[25], nul, nul, 0, W_MO, SZ_MQ)
  TCLS(2, 4096, 256, 256, 0, p.in[18], nul, nul, 0, W_C1, 2 * SZ_C1)
  TCLS(2, 4096, 256, 256, 0, p.in[21], nul, nul, 0, W_C1 + SZ_C1, 2 * SZ_C1)
  TCLS(2, 256, 128, 256, 0, p.in[19], nul, nul, 0, W_C2, 2 * SZ_C2)
  TCLS(2, 256, 128, 256, 0, p.in[22], nul, nul, 0, W_C2 + SZ_C2, 2 * SZ_C2)
#undef TCLS
  return false;
}
DI void tr_load(const TDesc& d, int tid, f32x4 (&v)[8]) {
  const int lane = tid & 63, w = tid >> 6, n = d.n0 + lane * 4;
  const float* s = d.src; int col;
  if (d.map == 0) col = n < d.Nsrc ? n : -1;
  else if (d.map == 1) col = n < 3072 ? n : (n < 7168 ? n + 8 : (n < 7176 ? n - 7168 + 3072 : -1));
  else { col = (n >> 5) * 16 + (n & 15); if (n & 16) s = d.src2; }
#pragma unroll
  for (int r = 0; r < 8; ++r) {
    const int k = d.k0 + w * 8 + r;
    v[r] = col >= 0 ? *(const f32x4*)(s + (size_t)k * d.Nsrc + col) : (f32x4){0.f, 0.f, 0.f, 0.f};
  }
  if (d.rscale) {
#pragma unroll
    for (int r = 0; r < 8; ++r) { const float g = d.rscale[d.k0 + w * 8 + r]; v[r] = v[r] * g; }
  }
}
DI void transpose_jobs(const Params& p) {
  extern __shared__ __attribute__((aligned(16))) char dyn_lds[];
  LAS float* lds = (LAS float*)dyn_lds;
  const int tid = TIDX, lane = tid & 63, w = tid >> 6;
  TDesc da, db; f32x4 va[8], vb[8];
  int gi = blockIdx.x;
  bool ha = decode_tile(p, gi, da); if (ha) tr_load(da, tid, va);
  gi += gridDim.x;
  bool hb = ha && decode_tile(p, gi, db); if (hb) tr_load(db, tid, vb);
#define TR_EMIT(V, D) do { \
    _Pragma("unroll") for (int r = 0; r < 8; ++r) *(LAS f32x4*)(lds + (w * 8 + r) * TR_LD + lane * 4) = V[r]; \
    __syncthreads(); \
    const TDesc cur_ = D; \
    gi += gridDim.x; \
    const bool hn_ = decode_tile(p, gi, D); if (hn_) tr_load(D, tid, V); \
    const int nl = tid & 255; \
    _Pragma("unroll") for (int q = 0; q < 4; ++q) { \
      const int kc = (tid >> 8) + 2 * q; const LAS float* c = lds + (kc * 8) * TR_LD + nl; u32x4 o; \
      o.x = pk2(c[0], c[TR_LD]); o.y = pk2(c[2 * TR_LD], c[3 * TR_LD]); o.z = pk2(c[4 * TR_LD], c[5 * TR_LD]); o.w = pk2(c[6 * TR_LD], c[7 * TR_LD]); \
      *(u32x4*)(cur_.dst + (size_t)(cur_.n0 + nl) * cur_.K + cur_.k0 + kc * 8) = o; } \
    __syncthreads(); \
    h_ = hn_; } while (0)
  while (ha) {
    bool h_;
    TR_EMIT(va, da); ha = h_;
    if (!hb) break;
    TR_EMIT(vb, db); hb = h_;
    if (!ha) { while (hb) { TR_EMIT(vb, db); hb = h_; } break; }
  }
#undef TR_EMIT
}

DI void rmsnorm_rows(const float* __restrict__ x, const float* __restrict__ gain, bf16_t* __restrict__ out, int rows) {
  const int lane = TIDX & 63, gw = blockIdx.x * 8 + (TIDX >> 6), nw = gridDim.x * 8;
  for (int r = gw; r < rows; r += nw) {
    const f32x4* xr = (const f32x4*)(x + (size_t)r * D_) + lane;
    f32x4 v[8]; float s = 0.f;
#pragma unroll
    for (int j = 0; j < 8; ++j) { v[j] = xr[64 * j]; s += v[j][0] * v[j][0] + v[j][1] * v[j][1] + v[j][2] * v[j][2] + v[j][3] * v[j][3]; }
    const float rs = rsqrtf(wave_sum(s) * (1.f / D_) + EPS_);
#pragma unroll
    for (int j = 0; j < 8; ++j) {
      const f32x4 g = gain ? *((const f32x4*)gain + lane + 64 * j) : (f32x4){1.f, 1.f, 1.f, 1.f};
      f32x4 o; for (int e = 0; e < 4; ++e) o[e] = v[j][e] * rs * g[e];
      st_bf16x4(out + (size_t)r * D_ + (lane + 64 * j) * 4, o);
    }
  }
}

DI void xprep_rows(const float* __restrict__ x, bf16_t* __restrict__ xb, float* __restrict__ ssp, int rows) {
  const int tid = TIDX, lane = tid & 63, gw = blockIdx.x * 8 + (tid >> 6), nw = gridDim.x * 8;
  for (int r = gw; r < rows; r += nw) {
    const f32x4* xr = (const f32x4*)(x + (size_t)r * D_) + lane;
    float s = 0.f;
#pragma unroll
    for (int j = 0; j < 8; ++j) { const f32x4 v = xr[64 * j]; s += v[0] * v[0] + v[1] * v[1] + v[2] * v[2] + v[3] * v[3]; st_bf16x4(xb + (size_t)r * D_ + (lane + 64 * j) * 4, v); }
    s = wave_sum(s);
    if (lane < 8) ssp[(size_t)r * 8 + lane] = lane == 0 ? s : 0.f;
  }
}

DI void headnorm_rows(bf16_t* buf, int rows, const float* __restrict__ gain, int item0, int nitems_total) {
  const int lane = TIDX & 63, gw = blockIdx.x * 8 + (TIDX >> 6), nw = gridDim.x * 8;
  const int sub = lane >> 4, l16 = lane & 15;
  (void)item0; (void)nitems_total;
  for (int it = gw; it < rows / 4; it += nw) {
    bf16_t* rp = buf + (size_t)(it * 4 + sub) * 128 + l16 * 8;
    bf16x8 raw = *(const bf16x8*)rp;
    float f[8], s = 0.f;
#pragma unroll
    for (int e = 0; e < 8; ++e) { f[e] = bf2f((bf16_t)raw[e]); s += f[e] * f[e]; }
    s += shx(s, 1); s += shx(s, 2); s += shx(s, 4); s += shx(s, 8);
    const float rs = rsqrtf(s * (1.f / 128.f) + EPS_);
    u32x4 o;
    o.x = pk2(f[0] * rs * gain[l16 * 8 + 0], f[1] * rs * gain[l16 * 8 + 1]); o.y = pk2(f[2] * rs * gain[l16 * 8 + 2], f[3] * rs * gain[l16 * 8 + 3]);
    o.z = pk2(f[4] * rs * gain[l16 * 8 + 4], f[5] * rs * gain[l16 * 8 + 5]); o.w = pk2(f[6] * rs * gain[l16 * 8 + 6], f[7] * rs * gain[l16 * 8 + 7]);
    *(u32x4*)rp = o;
  }
}

struct AttnState { f32x16 o[4]; float m, l; };
DI void attn_init(AttnState& s) { for (int i = 0; i < 4; ++i) s.o[i] = zero16(); s.m = NEG_INF; s.l = 0.f; }
DI int crow(int i, int g) { return (i & 3) + 8 * (i >> 2) + 4 * g; }

DI void load_q_raw(bf16x8 (&qf)[8], const bf16_t* qrow, int g) {
#pragma unroll
  for (int ks = 0; ks < 8; ++ks) qf[ks] = *(const bf16x8*)(qrow + ks * 16 + g * 8);
}
DI void load_q_norm(bf16x8 (&qf)[8], const bf16_t* qrow, int g, const float* __restrict__ gain, float scale) {
  float ss = 0.f;
#pragma unroll
  for (int ks = 0; ks < 8; ++ks) { qf[ks] = *(const bf16x8*)(qrow + ks * 16 + g * 8);
#pragma unroll
    for (int e = 0; e < 8; ++e) { const float f = bf2f((bf16_t)qf[ks][e]); ss += f * f; } }
  ss = xhalf_sum(ss);
  const float rs = rsqrtf(ss * (1.f / 128.f) + EPS_) * scale;
#pragma unroll
  for (int ks = 0; ks < 8; ++ks) {
    const f32x4 g0 = *(const f32x4*)(gain + ks * 16 + g * 8), g1 = *(const f32x4*)(gain + ks * 16 + g * 8 + 4);
    u32x4 o;
    o.x = pk2(bf2f((bf16_t)qf[ks][0]) * rs * g0[0], bf2f((bf16_t)qf[ks][1]) * rs * g0[1]);
    o.y = pk2(bf2f((bf16_t)qf[ks][2]) * rs * g0[2], bf2f((bf16_t)qf[ks][3]) * rs * g0[3]);
    o.z = pk2(bf2f((bf16_t)qf[ks][4]) * rs * g1[0], bf2f((bf16_t)qf[ks][5]) * rs * g1[1]);
    o.w = pk2(bf2f((bf16_t)qf[ks][6]) * rs * g1[2], bf2f((bf16_t)qf[ks][7]) * rs * g1[3]);
    qf[ks] = __builtin_bit_cast(bf16x8, o);
  }
}
DI f32x16 score_tile(const bf16x8 (&qf)[8], const bf16_t* __restrict__ Kp  , unsigned koff  ) {
  f32x16 acc = zero16();
  const char* kr = (const char*)Kp;
#pragma unroll
  for (int ks = 0; ks < 8; ++ks) { const bf16x8 a = *(const bf16x8*)(kr + (size_t)(koff + ks * 32)); acc = mfma32(a, qf[ks], acc); }
  return acc;
}
typedef __bf16 hwbf16x2 __attribute__((ext_vector_type(2)));
typedef float f32x2 __attribute__((ext_vector_type(2)));
DI unsigned pk2h(float lo, float hi) { const f32x2 f = {lo, hi}; const hwbf16x2 r = __builtin_convertvector(f, hwbf16x2); return __builtin_bit_cast(unsigned, r); }
DI bf16x8 pack8(const float* p) { u32x4 o; o.x = pk2h(p[0], p[1]); o.y = pk2h(p[2], p[3]); o.z = pk2h(p[4], p[5]); o.w = pk2h(p[6], p[7]); return __builtin_bit_cast(bf16x8, o); }
DI void pv_tile(f32x16 (&o)[4], const bf16x8 (&pf)[2], const bf16_t* __restrict__ VTp  , size_t ldv, unsigned voff  ) {
#pragma unroll
  for (int vt = 0; vt < 4; ++vt) {
    const char* vr = (const char*)(VTp + (size_t)(vt * 32) * ldv);
#pragma unroll
    for (int s = 0; s < 2; ++s) {
      const s16x4 lo = *(const s16x4*)(vr + (size_t)(voff + 32 * s)), hi = *(const s16x4*)(vr + (size_t)(voff + 32 * s + 16));
      const bf16x8 a = __builtin_shufflevector(lo, hi, 0, 1, 2, 3, 4, 5, 6, 7);
      o[vt] = mfma32(a, pf[s], o[vt]);
    }
  }
}
DI void softmax_step(AttnState& st, float (&sc)[16], const bf16_t* __restrict__ VTp, size_t ldv, unsigned voff) {
  float mx = st.m;
#pragma unroll
  for (int i = 0; i < 16; ++i) mx = fmaxf(mx, sc[i]);
  mx = xhalf_max(mx);
  const float ms = (mx == NEG_INF) ? 0.f : mx;
  const float alpha = fexp2(st.m - ms);
  st.m = mx;
  float ps = 0.f;
#pragma unroll
  for (int i = 0; i < 16; ++i) { sc[i] = fexp2(sc[i] - ms); ps += sc[i]; }
  st.l = st.l * alpha + ps;
#pragma unroll
  for (int vt = 0; vt < 4; ++vt)
#pragma unroll
    for (int i = 0; i < 16; ++i) st.o[vt][i] *= alpha;
  bf16x8 pf[2]; pf[0] = pack8(sc); pf[1] = pack8(sc + 8);
  pv_tile(st.o, pf, VTp, ldv, voff);
}
DI float attn_inv_l(const AttnState& st) { const float l = xhalf_sum(st.l); return l > 0.f ? frcp(l) : 0.f; }
DI void store_o(const f32x16 (&o)[4], float scale, bf16_t* orow, int g) {
#pragma unroll
  for (int vt = 0; vt < 4; ++vt)
#pragma unroll
    for (int q = 0; q < 4; ++q) {
      f32x4 v; for (int e = 0; e < 4; ++e) v[e] = o[vt][q * 4 + e] * scale;
      st_bf16x4(orow + vt * 32 + q * 8 + 4 * g, v);
    }
}

constexpr int AT_STAGE = 16384;
#define AT_WAIT_V(n) asm volatile("s_waitcnt vmcnt(" #n ")" ::: "memory")
#define AT_WAIT_L0() asm volatile("s_waitcnt lgkmcnt(0)" ::: "memory")
#define AT_BAR() __builtin_amdgcn_s_barrier()
struct LaneKV {
  unsigned ksrc, vsrc, ldsw;
  unsigned kx, xh, vrow, vo[4];
};
DI void lanekv_init(LaneKV& L, int tid, int wid) {
  const int lane = tid & 63, lr = lane & 31, g = lane >> 5, r = tid >> 4, pos = tid & 15;
  L.ksrc = (unsigned)(r * 256 + ((pos ^ (r & 15)) << 4)); L.vsrc = (unsigned)tid * 16u; L.ldsw = (unsigned)wid * 1024u;
  L.kx = (unsigned)(lr * 256 + ((g ^ (lr & 1)) << 4)); L.xh = (unsigned)((lr & 15) >> 1); L.vrow = (unsigned)lr * 64u;
  const int y = (lr >> 2) & 7;
#pragma unroll
  for (int q = 0; q < 4; ++q) L.vo[q] = (unsigned)(((g + 2 * q) ^ y) << 3);
}
DI void kv_issue(LAS unsigned char* st, const bf16_t* Kt, const bf16_t* Vt, const LaneKV& L) {
  __builtin_amdgcn_global_load_lds((const unsigned*)((const char*)Kt + L.ksrc), (LAS unsigned*)(st + L.ldsw), 16, 0, 0);
  __builtin_amdgcn_global_load_lds((const unsigned*)((const char*)Vt + L.vsrc), (LAS unsigned*)(st + 8192 + L.ldsw), 16, 0, 0);
}
DI f32x16 score_tile_lds(const bf16x8 (&qf)[8], const LAS unsigned char* st, const LaneKV& L) {
  f32x16 acc = zero16();
#pragma unroll
  for (int ks = 0; ks < 8; ++ks) { const bf16x8 a = *(const LAS bf16x8*)(st + L.kx + (((unsigned)ks ^ L.xh) << 5)); acc = mfma32(a, qf[ks], acc); }
  return acc;
}
DI void pv_tile_lds(f32x16 (&o)[4], const bf16x8 (&pf)[2], const LAS unsigned char* stv, const LaneKV& L) {
#pragma unroll
  for (int vt = 0; vt < 4; ++vt) {
#pragma unroll
    for (int s2 = 0; s2 < 2; ++s2) {
      const s16x4 lo = *(const LAS s16x4*)(stv + vt * 2048 + L.vrow + L.vo[2 * s2]), hi = *(const LAS s16x4*)(stv + vt * 2048 + L.vrow + L.vo[2 * s2 + 1]);
      const bf16x8 a = __builtin_shufflevector(lo, hi, 0, 1, 2, 3, 4, 5, 6, 7);
      o[vt] = mfma32(a, pf[s2], o[vt]);
    }
  }
}
DI void softmax_step_lds(AttnState& st, float (&sc)[16], const LAS unsigned char* stv, const LaneKV& L) {
  float mx = st.m;
#pragma unroll
  for (int i = 0; i < 16; ++i) mx = fmaxf(mx, sc[i]);
  mx = xhalf_max(mx);
  const float ms = (mx == NEG_INF) ? 0.f : mx;
  if (__builtin_amdgcn_ballot_w64(mx > st.m) != 0ull) {
    const float alpha = fexp2(st.m - ms);
    st.l *= alpha;
#pragma unroll
    for (int vt = 0; vt < 4; ++vt)
#pragma unroll
      for (int i = 0; i < 16; ++i) st.o[vt][i] *= alpha;
  }
  st.m = mx;
  float ps = 0.f;
#pragma unroll
  for (int i = 0; i < 16; ++i) { sc[i] = fexp2(sc[i] - ms); ps += sc[i]; }
  st.l += ps;
  bf16x8 pf[2]; pf[0] = pack8(sc); pf[1] = pack8(sc + 8);
  pv_tile_lds(st.o, pf, stv, L);
}

DI void softmax_step2_lds(AttnState& st, float (&sa)[16], float (&sb)[16], const LAS unsigned char* stva, const LAS unsigned char* stvb, const LaneKV& L) {
  float mx = st.m;
#pragma unroll
  for (int i = 0; i < 16; ++i) mx = fmaxf(mx, fmaxf(sa[i], sb[i]));
  mx = xhalf_max(mx);
  const float ms = (mx == NEG_INF) ? 0.f : mx;
  if (__builtin_amdgcn_ballot_w64(mx > st.m) != 0ull) {
    const float alpha = fexp2(st.m - ms);
    st.l *= alpha;
#pragma unroll
    for (int vt = 0; vt < 4; ++vt)
#pragma unroll
      for (int i = 0; i < 16; ++i) st.o[vt][i] *= alpha;
  }
  st.m = mx;
  float ps = 0.f;
#pragma unroll
  for (int i = 0; i < 16; ++i) { sa[i] = fexp2(sa[i] - ms); sb[i] = fexp2(sb[i] - ms); ps += sa[i] + sb[i]; }
  st.l += ps;
  bf16x8 pfa[2], pfb[2]; pfa[0] = pack8(sa); pfa[1] = pack8(sa + 8); pfb[0] = pack8(sb); pfb[1] = pack8(sb + 8);
  __builtin_amdgcn_sched_barrier(0);
  pv_tile_lds(st.o, pfa, stva, L);
  __builtin_amdgcn_sched_barrier(0);
  pv_tile_lds(st.o, pfb, stvb, L);
  __builtin_amdgcn_sched_barrier(0);
}

DI void memattn_block(const Params& p, int layer, int bh, int tile4) {
  extern __shared__ __attribute__((aligned(16))) char dyn_lds[];
  LAS unsigned char* ldsb = (LAS unsigned char*)dyn_lds;
  const int tid = TIDX, wid = __builtin_amdgcn_readfirstlane(tid >> 6), lane = tid & 63, lr = lane & 31, g = lane >> 5;
  const int tile = tile4 * 4 + (wid & 3);
  const int tq = tile * 32 + lr, b = bh >> 2, h = bh & 3;
  const bf16_t* Kb = (const bf16_t*)(p.ws + A_MEMK) + ((size_t)layer * 8 + bh) * 256 * 128;
  const bf16_t* VT = (const bf16_t*)(p.ws + A_MEMVT) + ((size_t)layer * 8 + bh) * 128 * 256;
  LaneKV L; lanekv_init(L, tid, wid);
#pragma unroll
  for (int kt = 0; kt < 8; ++kt) kv_issue(ldsb + kt * AT_STAGE, Kb + (size_t)kt * 4096, VT + (size_t)kt * 4096, L);
  bf16x8 qf[8];
  if (wid < 4) {
    const size_t mrow = (size_t)b * T_ + tq;
    const float* qp = (const float*)(p.ws + A_SCR) + mrow * 512 + h * 128 + g * 8;
    const float* sp8 = (const float*)(p.ws + A_SSP) + SZ_SSP / 4 + mrow * 8;
    const f32x4 s0 = *(const f32x4*)sp8, s1 = *(const f32x4*)(sp8 + 4);
    const float rr = rsqrtf((((s0[0] + s0[1]) + (s0[2] + s0[3])) + ((s1[0] + s1[1]) + (s1[2] + s1[3]))) * (1.f / D_) + EPS_);
    f32x4 qa[8], qb[8]; float ss = 0.f;
#pragma unroll
    for (int ks = 0; ks < 8; ++ks) {
      f32x4 a = *(const f32x4*)(qp + ks * 16), c = *(const f32x4*)(qp + ks * 16 + 4);
#pragma unroll
      for (int sp = 1; sp < 4; ++sp) { a += *(const f32x4*)(qp + (size_t)sp * M_ * 512 + ks * 16); c += *(const f32x4*)(qp + (size_t)sp * M_ * 512 + ks * 16 + 4); }
      a = a * rr; c = c * rr; qa[ks] = a; qb[ks] = c;
      ss += (a[0] * a[0] + a[1] * a[1]) + (a[2] * a[2] + a[3] * a[3]) + (c[0] * c[0] + c[1] * c[1]) + (c[2] * c[2] + c[3] * c[3]);
    }
    ss = xhalf_sum(ss);
    const float rs = rsqrtf(ss * (1.f / 128.f) + EPS_) * (ATTN_SCALE * LOG2E);
    const float* gain = p.in[26] + layer * 128 + g * 8;
#pragma unroll
    for (int ks = 0; ks < 8; ++ks) {
      const f32x4 g0 = *(const f32x4*)(gain + ks * 16), g1 = *(const f32x4*)(gain + ks * 16 + 4);
      float v[8];
#pragma unroll
      for (int i = 0; i < 4; ++i) { v[i] = qa[ks][i] * rs * g0[i]; v[4 + i] = qb[ks][i] * rs * g1[i]; }
      qf[ks] = pack8(v);
    }
  }
  AT_WAIT_V(0);
  AT_BAR();
  if (wid < 4) {
    AttnState st; attn_init(st);
#pragma unroll 1
    for (int kt = 0; kt < 8; ++kt) {
      const LAS unsigned char* sg = ldsb + kt * AT_STAGE;
      f32x16 acc = score_tile_lds(qf, sg, L);
      float sc[16];
#pragma unroll
      for (int i = 0; i < 16; ++i) sc[i] = acc[i];
      softmax_step_lds(st, sc, sg + 8192, L);
    }
    const float inv = attn_inv_l(st);
    store_o(st.o, inv, (bf16_t*)(p.ws + A_MAO) + (size_t)(b * T_ + tq) * 512 + h * 128, g);
  }
  AT_WAIT_L0();
  __syncthreads();
}

DI void fox_block(const Params& p, int e, int bh, int j) {
  extern __shared__ __attribute__((aligned(16))) char dyn_lds[];
  LAS unsigned char* lds = (LAS unsigned char*)dyn_lds;
  LAS float* c2l = (LAS float*)(lds + 4 * AT_STAGE);
  const int tid = TIDX, wid = __builtin_amdgcn_readfirstlane(tid >> 6), lane = tid & 63, lr = lane & 31, g = lane >> 5;
  const int kidx = wid < 4 ? wid : 11 - wid, tile = j + 16 * kidx, nsteps = (j + 114) >> 1;
  const int tq = tile * 32 + lr, b = bh >> 3, h = bh & 7;
  const bf16_t* Q = (const bf16_t*)(p.ws + E_FQ) + (size_t)bh * T_ * 128;
  const bf16_t* Kb = (const bf16_t*)(p.ws + E_FK) + (size_t)bh * T_ * 128;
  const bf16_t* VT = (const bf16_t*)(p.ws + E_FVT) + (size_t)bh * 128 * T_;
  const float* c2 = (const float*)(p.ws + E_FC) + (size_t)bh * T_;
  LaneKV L; lanekv_init(L, tid, wid);
  kv_issue(lds, Kb, VT, L);
  kv_issue(lds + AT_STAGE, Kb + 4096, VT + 4096, L);
  { const int nc = nsteps * 64 < T_ ? nsteps * 64 : T_; for (int i = tid; i < nc; i += NTH) c2l[i] = c2[i]; }
  bf16x8 qf[8];
  load_q_norm(qf, Q + (size_t)tq * 128, g, p.in[9] + e * 128, ATTN_SCALE * LOG2E);
  AttnState st; attn_init(st);
  AT_WAIT_L0();
#pragma unroll 1
  for (int i = 0; i < nsteps; ++i) {
    AT_WAIT_V(0);
    AT_BAR();
    if (i + 1 < nsteps) {
      LAS unsigned char* nx = lds + ((i + 1) & 1) * 2 * AT_STAGE;
      kv_issue(nx, Kb + (size_t)(2 * i + 2) * 4096, VT + (size_t)(2 * i + 2) * 4096, L);
      kv_issue(nx + AT_STAGE, Kb + (size_t)(2 * i + 3) * 4096, VT + (size_t)(2 * i + 3) * 4096, L);
    }
    const int ka = 2 * i, kb = ka + 1;
    const LAS unsigned char* sg = lds + (i & 1) * 2 * AT_STAGE;
    if (kb <= tile) {
      f32x16 acca = score_tile_lds(qf, sg, L); __builtin_amdgcn_sched_barrier(0); f32x16 accb = score_tile_lds(qf, sg + AT_STAGE, L); __builtin_amdgcn_sched_barrier(0);
      float sa[16], sb[16];
#pragma unroll
      for (int q = 0; q < 4; ++q) {
        const f32x4 ca = *(const LAS f32x4*)(c2l + ka * 32 + 8 * q + 4 * g), cb = *(const LAS f32x4*)(c2l + kb * 32 + 8 * q + 4 * g);
#pragma unroll
        for (int e2 = 0; e2 < 4; ++e2) { sa[q * 4 + e2] = acca[q * 4 + e2] - ca[e2]; sb[q * 4 + e2] = accb[q * 4 + e2] - cb[e2]; }
      }
      if (kb == tile) {
#pragma unroll
        for (int q = 0; q < 16; ++q) sb[q] = (crow(q, g) <= lr) ? sb[q] : NEG_INF;
      }
      softmax_step2_lds(st, sa, sb, sg + 8192, sg + AT_STAGE + 8192, L);
    } else if (ka <= tile) {
      f32x16 acc = score_tile_lds(qf, sg, L);
      float sc[16];
#pragma unroll
      for (int q = 0; q < 4; ++q) {
        const f32x4 cs = *(const LAS f32x4*)(c2l + ka * 32 + 8 * q + 4 * g);
#pragma unroll
        for (int e2 = 0; e2 < 4; ++e2) sc[q * 4 + e2] = acc[q * 4 + e2] - cs[e2];
      }
#pragma unroll
      for (int q = 0; q < 16; ++q) sc[q] = (crow(q, g) <= lr) ? sc[q] : NEG_INF;
      softmax_step_lds(st, sc, sg + 8192, L);
    }
  }
  const float inv = attn_inv_l(st);
  store_o(st.o, inv, (bf16_t*)(p.ws + A_MIXO) + (size_t)(b * T_ + tq) * D_ + h * 128, g);
  AT_WAIT_L0();
  __syncthreads();
}

DI void fox_task(const Params& p, int e, int bh, int tile) {
  const int lane = TIDX & 63, lr = lane & 31, g = lane >> 5;
  const unsigned koff = (unsigned)(lr * 128 + g * 8) * 2u, voffT = (unsigned)(lr * 32 + 4 * g) * 2u, voff256 = (unsigned)(lr * 256 + 4 * g) * 2u; (void)koff; (void)voffT; (void)voff256;
  const int t0 = tile * 32, tq = t0 + lr, b = bh >> 3, h = bh & 7;
  const bf16_t* Q = (const bf16_t*)(p.ws + E_FQ) + (size_t)bh * T_ * 128;
  const bf16_t* Kb = (const bf16_t*)(p.ws + E_FK) + (size_t)bh * T_ * 128;
  const bf16_t* VT = (const bf16_t*)(p.ws + E_FVT) + (size_t)bh * 128 * T_;
  const float* c2 = (const float*)(p.ws + E_FC) + (size_t)bh * T_;
  bf16x8 qf[8];
  load_q_norm(qf, Q + (size_t)tq * 128, g, p.in[9] + e * 128, ATTN_SCALE * LOG2E);
  const float ct = c2[tq];
  AttnState st; attn_init(st);
  for (int kt = 0; kt <= tile; ++kt) {
    const int key0 = kt * 32;
    f32x16 acc = score_tile(qf, Kb + (size_t)key0 * 128, koff);
    float sc[16];
#pragma unroll
    for (int q = 0; q < 4; ++q) {
      const f32x4 cs = *(const f32x4*)(c2 + key0 + 8 * q + 4 * g);
#pragma unroll
      for (int e2 = 0; e2 < 4; ++e2) {
        const int i = q * 4 + e2; const int key = key0 + crow(i, g);
        const float s = acc[i] + (ct - cs[e2]);
        sc[i] = (key <= tq) ? s : NEG_INF;
      }
    }
    softmax_step(st, sc, VT + (size_t)key0 * 128, 32, voffT);
  }
  const float inv = attn_inv_l(st);
  store_o(st.o, inv, (bf16_t*)(p.ws + A_MIXO) + (size_t)(b * T_ + tq) * D_ + h * 128, g);
}

DI void hgrn_prep(const Params& p, int e) {
  const float* HF = (const float*)(p.ws + E_HF);
  const bf16_t* HQ = (const bf16_t*)(p.ws + E_HQ);
  bf16_t* QT = (bf16_t*)(p.ws + E_QT); bf16_t* KT = (bf16_t*)(p.ws + E_KT); bf16_t* QS = (bf16_t*)(p.ws + E_QS); bf16_t* KUT = (bf16_t*)(p.ws + E_KUT);
  float* DL = (float*)(p.ws + E_DL);
  const float* lg = p.in[11];
  for (int idx = blockIdx.x * NTH + TIDX; idx < 16 * 64 * 128; idx += gridDim.x * NTH) {
    const int k = idx & 127, c = (idx >> 7) & 63, bh = idx >> 13, b = bh >> 3, h = bh & 7, col = h * 128 + k;
    const float lb = (e == 0) ? 0.f : 1.f / (1.f + __expf(lg[col] - lg[1024 + col]));
    const size_t m0 = (size_t)b * T_ + c * 64;
    float bsum = 0.f, bmid = 0.f;
#pragma unroll 1
    for (int t16 = 0; t16 < 4; ++t16) {
      float zc[16];
#pragma unroll
      for (int tt = 0; tt < 16; ++tt) zc[tt] = HF[(m0 + t16 * 16 + tt) * 1024 + col];
#pragma unroll
      for (int tt = 0; tt < 16; ++tt) {
        const float z = zc[tt];
        const float a = __expf(-fabsf(z)), ri = __builtin_amdgcn_rcpf(1.f + a);
        const float sg = z >= 0.f ? ri : a * ri;
        bsum += (e == 0) ? (fminf(z, 0.f) - __logf(1.f + a)) : __logf(lb + (1.f - lb) * sg);
      }
      if (t16 == 1) bmid = bsum;
    }
    const float blast = bsum;
    DL[((size_t)bh * 64 + c) * 128 + k] = __expf(blast);
    const float emid = __expf(bmid), elast = __expf(blast - bmid);
    bsum = 0.f;
    const size_t hb = ((size_t)bh * T_ + c * 64) * 128 + k;
    bf16_t* kut = KUT + (((size_t)bh * 64 + c) * 128 + k) * 64;
#pragma unroll 1
    for (int t8 = 0; t8 < 8; ++t8) {
      float ku[8], zc[8], qc[8];
#pragma unroll
      for (int tt = 0; tt < 8; ++tt) { zc[tt] = HF[(m0 + t8 * 8 + tt) * 1024 + col]; qc[tt] = bf2f(HQ[(m0 + t8 * 8 + tt) * 1024 + col]); }
#pragma unroll
      for (int tt = 0; tt < 8; ++tt) {
        const int t = t8 * 8 + tt;
        const float z = zc[tt];
        const float a = __expf(-fabsf(z)), ri = __builtin_amdgcn_rcpf(1.f + a);
        const float sg = z >= 0.f ? ri : a * ri, sgn = z >= 0.f ? a * ri : ri;
        bsum += (e == 0) ? (fminf(z, 0.f) - __logf(1.f + a)) : __logf(lb + (1.f - lb) * sg);
        const float kh = (1.f - lb) * sgn;
        const float qv = qc[tt]; const float qh = qv * __builtin_amdgcn_rcpf(1.f + __expf(-qv));
        const float ed = __expf(bsum - bmid), edi = __builtin_amdgcn_rcpf(ed);
        QT[hb + (size_t)t * 128] = f2bf(qh * ed);
        KT[hb + (size_t)t * 128] = f2bf(kh * edi);
        QS[hb + (size_t)t * 128] = f2bf(qh * ed * emid);
        ku[tt] = kh * edi * elast;
      }
      *(bf16x8*)(kut + t8 * 8) = pack8(ku);
    }
  }
}
DI void fox_cumsum(const Params& p, int e) {
  extern __shared__ __attribute__((aligned(16))) char dyn_lds[];
  LAS float* wsum = (LAS float*)dyn_lds;
  const int tid = TIDX, lane = tid & 63, w = tid >> 6;
  for (int bh = blockIdx.x; bh < 16; bh += gridDim.x) {
    const int b = bh >> 3, h = bh & 7;
    const float* FF = (const float*)(p.ws + E_FF) + (size_t)b * T_ * 8 + h;
    float* FC = (float*)(p.ws + E_FC) + (size_t)bh * T_;
    const float bias = p.in[8][e * 8 + h];
    float v[8], s = 0.f;
#pragma unroll
    for (int i = 0; i < 8; ++i) { const float x = FF[(size_t)(tid * 8 + i) * 8] + bias; s += fminf(x, 0.f) - log1pf(__expf(-fabsf(x))); v[i] = s; }
    float incl = s;
#pragma unroll
    for (int o = 1; o < 64; o <<= 1) { const float u = shidx(incl, lane - o); if (lane >= o) incl += u; }
    if (lane == 63) wsum[w] = incl;
    __syncthreads();
    float base = incl - s;
    for (int q = 0; q < w; ++q) base += wsum[q];
#pragma unroll
    for (int i = 0; i < 8; ++i) FC[tid * 8 + i] = (base + v[i]) * LOG2E;
    __syncthreads();
  }
}
DI void hgrn_u_task(const Params& p, int bh, int c, int vt) {
  const int lane = TIDX & 63, lr = lane & 31, g = lane >> 5;
  const bf16_t* VT = (const bf16_t*)(p.ws + E_HIT) + (size_t)bh * 128 * T_ + (size_t)(c * 2) * 4096 + (vt * 32 + lr) * 32 + g * 8;
  const bf16_t* KUT = (const bf16_t*)(p.ws + E_KUT) + (((size_t)bh * 64 + c) * 128 + lr) * 64 + g * 8;
  f32x16 acc[4];
#pragma unroll
  for (int kt = 0; kt < 4; ++kt) acc[kt] = zero16();
#pragma unroll
  for (int ts = 0; ts < 4; ++ts) {
    const bf16x8 a = *(const bf16x8*)(VT + (ts >> 1) * 4096 + (ts & 1) * 16);
#pragma unroll
    for (int kt = 0; kt < 4; ++kt) { const bf16x8 bb = *(const bf16x8*)(KUT + (size_t)kt * 32 * 64 + ts * 16); acc[kt] = mfma32(a, bb, acc[kt]); }
  }
  float* U = (float*)(p.ws + E_U) + ((size_t)bh * 64 + c) * 128 * 128;
#pragma unroll
  for (int kt = 0; kt < 4; ++kt)
#pragma unroll
    for (int i = 0; i < 16; ++i) U[(size_t)(vt * 32 + crow(i, g)) * 128 + kt * 32 + lr] = acc[kt][i];
}
DI void hgrn_scan(const Params& p) {
  const float* U = (const float*)(p.ws + E_U); const float* DL = (const float*)(p.ws + E_DL); bf16_t* ST = (bf16_t*)(p.ws + E_ST);
  for (int idx = blockIdx.x * NTH + TIDX; idx < 16 * 128 * 128; idx += gridDim.x * NTH) {
    const int k = idx & 127, v = (idx >> 7) & 127, bh = idx >> 14;
    float S = 0.f;
#pragma unroll 8
    for (int c = 0; c < 64; ++c) {
      const size_t o = (((size_t)bh * 64 + c) * 128 + v) * 128 + k;
      ST[o] = f2bf(S);
      S = DL[((size_t)bh * 64 + c) * 128 + k] * S + U[o];
    }
  }
}
DI void hgrn_out_task(const Params& p, int e, int bh, int c, int tt) {
  const int lane = TIDX & 63, lr = lane & 31, g = lane >> 5, b = bh >> 3, h = bh & 7;
  const unsigned koff = (unsigned)(lr * 128 + g * 8) * 2u, voffT = (unsigned)(lr * 32 + 4 * g) * 2u, voff256 = (unsigned)(lr * 256 + 4 * g) * 2u; (void)koff; (void)voffT; (void)voff256;
  const size_t rowbase = (size_t)bh * T_ + c * 64;
  const bf16_t* QT = (const bf16_t*)(p.ws + E_QT) + rowbase * 128;
  const bf16_t* KT = (const bf16_t*)(p.ws + E_KT) + rowbase * 128;
  const bf16_t* QS = (const bf16_t*)(p.ws + E_QS) + rowbase * 128;
  const bf16_t* VT = (const bf16_t*)(p.ws + E_HIT) + (size_t)bh * 128 * T_ + (size_t)(c * 2) * 4096;
  const bf16_t* ST = (const bf16_t*)(p.ws + E_ST) + ((size_t)bh * 64 + c) * 128 * 128;
  f32x16 o[4];
#pragma unroll
  for (int i = 0; i < 4; ++i) o[i] = zero16();
  bf16x8 qf[8];
  load_q_raw(qf, QT + (size_t)(tt * 32 + lr) * 128, g);
  for (int st = 0; st <= tt; ++st) {
    f32x16 acc = score_tile(qf, KT + (size_t)st * 32 * 128, koff);
    float a[16];
#pragma unroll
    for (int i = 0; i < 16; ++i) a[i] = (st < tt || crow(i, g) <= lr) ? acc[i] : 0.f;
    bf16x8 pf[2]; pf[0] = pack8(a); pf[1] = pack8(a + 8);
    pv_tile(o, pf, VT + (size_t)st * 4096, 32, voffT);
  }
  load_q_raw(qf, QS + (size_t)(tt * 32 + lr) * 128, g);
#pragma unroll
  for (int vt = 0; vt < 4; ++vt) {
    const bf16_t* sr = ST + (size_t)(vt * 32 + lr) * 128 + g * 8;
#pragma unroll
    for (int ks = 0; ks < 8; ++ks) { const bf16x8 a = *(const bf16x8*)(sr + ks * 16); o[vt] = mfma32(a, qf[ks], o[vt]); }
  }
  float ss = 0.f;
#pragma unroll
  for (int vt = 0; vt < 4; ++vt)
#pragma unroll
    for (int i = 0; i < 16; ++i) ss += o[vt][i] * o[vt][i];
  ss = xhalf_sum(ss);
  const float rs = rsqrtf(ss * (1.f / 128.f) + EPS_);
  const size_t m = (size_t)b * T_ + c * 64 + tt * 32 + lr;
  const bf16_t* hg = (const bf16_t*)(p.ws + E_HG) + m * 1024 + h * 128;
  const float* og = p.in[12] + e * 128;
  bf16_t* orow = (bf16_t*)(p.ws + A_MIXO) + m * D_ + 1024 + h * 128;
#pragma unroll
  for (int vt = 0; vt < 4; ++vt)
#pragma unroll
    for (int q = 0; q < 4; ++q) {
      const int d0 = vt * 32 + q * 8 + 4 * g;
      const s16x4 gv = *(const s16x4*)(hg + d0); const f32x4 gn = *(const f32x4*)(og + d0);
      f32x4 v;
#pragma unroll
      for (int e2 = 0; e2 < 4; ++e2) { const float gg = bf2f((bf16_t)gv[e2]); v[e2] = o[vt][q * 4 + e2] * rs * gn[e2] * (gg * frcp(1.f + __expf(-gg))); }
      st_bf16x4(orow + d0, v);
    }
}

constexpr int PS_LD = 260;
constexpr int NSA_PS_OFF = 65536, NSA_ML_OFF = NSA_PS_OFF + 2 * 32 * PS_LD * 4, NSA_SEL_OFF = NSA_ML_OFF + 8 * 32 * 2 * 4, NSA_LDS = NSA_SEL_OFF + 2 * 32 * 8;
DI void stash_set(LAS unsigned* stw, const f32x16 (&o)[4], float f) {
#pragma unroll
  for (int vt = 0; vt < 4; ++vt)
#pragma unroll
    for (int i = 0; i < 8; ++i) stw[(vt * 8 + i) * 64] = pk2(o[vt][2 * i] * f, o[vt][2 * i + 1] * f);
}
DI void stash_add(LAS unsigned* stw, const f32x16 (&o)[4], float f) {
#pragma unroll
  for (int vt = 0; vt < 4; ++vt)
#pragma unroll
    for (int i = 0; i < 8; ++i) { const unsigned w = stw[(vt * 8 + i) * 64];
      stw[(vt * 8 + i) * 64] = pk2(__uint_as_float(w << 16) + o[vt][2 * i] * f, __uint_as_float(w & 0xffff0000u) + o[vt][2 * i + 1] * f); }
}
struct NsaCtx { int b, gk, tile64, o_idx; };
#define NSA_LANE_CTX() \
  const int tidx = TIDX; \
  const int wave = __builtin_amdgcn_readfirstlane(tidx >> 6), lane = tidx & 63, lr = lane & 31, g = lane >> 5; \
  const int sub = wave >> 2, j = wave & 3, h = c.gk * 4 + j; \
  const int t0 = c.tile64 * 64 + sub * 32, tq = t0 + lr; \
  const unsigned koff = (unsigned)(lr * 128 + g * 8) * 2u, voffT = (unsigned)(lr * 32 + 4 * g) * 2u, voff256 = (unsigned)(lr * 256 + 4 * g) * 2u; \
  const size_t kvh = (size_t)(c.b * 4 + c.gk); \
  const float slope2 = fexp2(-0.5f * (float)(h + 1)) * LOG2E; \
  const int thr = __builtin_amdgcn_readfirstlane((int)(200.f / slope2) + 1);     \
  LAS unsigned char* ldsb = (LAS unsigned char*)dyn_lds; \
  LAS float* psum = (LAS float*)(ldsb + NSA_PS_OFF); LAS float* ml = (LAS float*)(ldsb + NSA_ML_OFF); \
  LAS unsigned long long* sel = (LAS unsigned long long*)(ldsb + NSA_SEL_OFF); \
  LAS unsigned* stw = (LAS unsigned*)ldsb + wave * 32 * 64 + lane; \
  const bf16_t* NQ = (const bf16_t*)(p.ws + O_NQ); const float* qgain = p.in[15] + c.o_idx * 128; \
  (void)koff; (void)voffT; (void)voff256; (void)kvh; (void)slope2; (void)thr; (void)psum; (void)ml; (void)sel; (void)stw; (void)NQ; (void)qgain; (void)sub; (void)j; (void)h; (void)tq; (void)t0

DI void nsa_cmp1(const Params& p, const NsaCtx c) {
  extern __shared__ __attribute__((aligned(16))) char dyn_lds[];
  NSA_LANE_CTX();
  const bf16_t* KCMP = (const bf16_t*)(p.ws + O_KCMP) + kvh * 256 * 128;
  const bf16_t* VCMPT = (const bf16_t*)(p.ws + O_VCMPT) + kvh * 128 * 256;
  const float ftq = (float)tq;
  const int ntile_c = (t0 >> 4) / 32 + 1;
  bf16x8 qf[8];
  load_q_norm(qf, NQ + ((size_t)(c.b * 16 + h) * T_ + tq) * 128, g, qgain, ATTN_SCALE * LOG2E);
  AttnState st; attn_init(st);
#pragma unroll 1
  for (int kt = 0; kt < ntile_c; ++kt) {
    if (t0 - (16 * (32 * kt + 31) + 16) > thr + 32) continue;
    f32x16 acc = score_tile(qf, KCMP + (size_t)kt * 32 * 128, koff);
    float sc[16];
#pragma unroll
    for (int i = 0; i < 16; ++i) {
      const int n = kt * 32 + crow(i, g);
      const float s = acc[i] - slope2 * (ftq - ((float)(16 * n) + 15.5f));
      sc[i] = (16 * n + 31 <= tq) ? s : NEG_INF;
    }
    softmax_step(st, sc, VCMPT + (size_t)kt * 4096, 32, voffT);
  }
  const float inv = attn_inv_l(st);
  const float g_cmp = sigmoidf_(((const float*)(p.ws + O_GT))[((size_t)c.b * T_ + tq) * 48 + h * 3]);
  stash_set(stw, st.o, inv * g_cmp);
  if (g == 0) { ml[(wave * 32 + lr) * 2] = (st.m == NEG_INF) ? 0.f : st.m; ml[(wave * 32 + lr) * 2 + 1] = inv; }
}
DI void nsa_cmp2(const Params& p, const NsaCtx c) {
  extern __shared__ __attribute__((aligned(16))) char dyn_lds[];
  NSA_LANE_CTX();
  const bf16_t* KCMP = (const bf16_t*)(p.ws + O_KCMP) + kvh * 256 * 128;
  const float ftq = (float)tq;
  const int ntile_c = (t0 >> 4) / 32 + 1;
#pragma unroll 1
  for (int kk = 0; kk < 2; ++kk) {
    const int kt = j + 4 * kk;
    float ps[16];
#pragma unroll
    for (int i = 0; i < 16; ++i) ps[i] = 0.f;
    if (kt < ntile_c) {
#pragma unroll 1
      for (int jj = 0; jj < 4; ++jj) {
        const int hh = c.gk * 4 + jj;
        bf16x8 q2[8];
        load_q_norm(q2, NQ + ((size_t)(c.b * 16 + hh) * T_ + tq) * 128, g, qgain, ATTN_SCALE * LOG2E);
        const float sl2 = fexp2(-0.5f * (float)(hh + 1)) * LOG2E;
        if (t0 - (16 * (32 * kt + 31) + 16) > __builtin_amdgcn_readfirstlane((int)(200.f / sl2) + 1) + 32) continue;
        const float mm = ml[((sub * 4 + jj) * 32 + lr) * 2], iv = ml[((sub * 4 + jj) * 32 + lr) * 2 + 1];
        f32x16 acc = score_tile(q2, KCMP + (size_t)kt * 32 * 128, koff);
#pragma unroll
        for (int i = 0; i < 16; ++i) {
          const int n = kt * 32 + crow(i, g);
          const float s = acc[i] - sl2 * (ftq - ((float)(16 * n) + 15.5f));
          const float pr = (16 * n + 31 <= tq) ? fexp2(s - mm) * iv : 0.f;
          ps[i] += pr;
        }
      }
    }
#pragma unroll
    for (int q = 0; q < 4; ++q) {
      f32x4 v; for (int e2 = 0; e2 < 4; ++e2) v[e2] = ps[q * 4 + e2];
      *(LAS f32x4*)(psum + (sub * 32 + lr) * PS_LD + kt * 32 + q * 8 + 4 * g) = v;
    }
  }
}
DI void nsa_topk(const Params& p, const NsaCtx c) {
  extern __shared__ __attribute__((aligned(16))) char dyn_lds[];
  NSA_LANE_CTX();
#pragma unroll 1
  for (int rr = 0; rr < 8; ++rr) {
    const int row = j * 8 + rr, t = c.tile64 * 64 + sub * 32 + row;
    const LAS float* pr = psum + (sub * 32 + row) * PS_LD;
    float imp = 0.f;
#pragma unroll
    for (int d = -1; d <= 3; ++d) { const int n = 4 * lane + d; if (n >= 0 && n <= 254) imp += pr[n]; }
    if (64 * lane > t) imp = NEG_INF;
    if (lane == (t >> 6) || lane == 0) imp = __builtin_inff();
    LAS float* sbw = ml + wave * 64;
    sbw[lane] = imp;
    int rank = 0;
#pragma unroll
    for (int m4 = 0; m4 < 16; ++m4) {
      const f32x4 v4 = *(const LAS f32x4*)(sbw + m4 * 4);
#pragma unroll
      for (int e2 = 0; e2 < 4; ++e2) { const int mm = m4 * 4 + e2; rank += (v4[e2] > imp || (v4[e2] == imp && mm < lane)) ? 1 : 0; }
    }
    const unsigned long long msk = __ballot(rank < 16);
    if (lane == 0) sel[sub * 32 + row] = msk;
  }
}
DI void nsa_winslc(const Params& p, const NsaCtx c) {
  extern __shared__ __attribute__((aligned(16))) char dyn_lds[];
  NSA_LANE_CTX();
  LAS unsigned char* stg = ldsb + NSA_PS_OFF;
  LAS int* tl = (LAS int*)(ldsb + NSA_PS_OFF + 3 * AT_STAGE);
  const bf16_t* KW = (const bf16_t*)(p.ws + O_KW) + kvh * T_ * 128;
  const bf16_t* VWT = (const bf16_t*)(p.ws + O_VWT) + kvh * 128 * T_;
  const bf16_t* KS = (const bf16_t*)(p.ws + O_KS) + kvh * T_ * 128;
  const bf16_t* VST = (const bf16_t*)(p.ws + O_VST) + kvh * 128 * T_;
  const unsigned long long mymask = sel[sub * 32 + lr];
  LaneKV L; lanekv_init(L, tidx, wave);
  bf16x8 qf[8];
  load_q_norm(qf, NQ + ((size_t)(c.b * 16 + h) * T_ + tq) * 128, g, qgain, ATTN_SCALE * LOG2E);
  const size_t m = (size_t)c.b * T_ + tq;
  const float* gt = (const float*)(p.ws + O_GT) + m * 48 + h * 3;
  AttnState st;
  {
    const int hi = c.tile64 * 2 + 1, lo = c.tile64 * 2 - 16 > 0 ? c.tile64 * 2 - 16 : 0, nsteps = hi - lo + 1;
    const int myhi = t0 >> 5, mylo = myhi - 16;
    attn_init(st);
    kv_issue(stg, KW + (size_t)lo * 4096, VWT + (size_t)lo * 4096, L);
    kv_issue(stg + AT_STAGE, KW + (size_t)(lo + 1) * 4096, VWT + (size_t)(lo + 1) * 4096, L);
#pragma unroll 1
    for (int i = 0; i < nsteps; ++i) {
      const int kt = lo + i;
      if (i + 1 < nsteps) AT_WAIT_V(2); else AT_WAIT_V(0);
      AT_BAR();
      if (i + 2 < nsteps) kv_issue(stg + ((i + 2) % 3) * AT_STAGE, KW + (size_t)(kt + 2) * 4096, VWT + (size_t)(kt + 2) * 4096, L);
      if (kt >= mylo && kt <= myhi && t0 - (kt * 32 + 31) <= thr) {
        const LAS unsigned char* sg = stg + (i % 3) * AT_STAGE;
        f32x16 acc = score_tile_lds(qf, sg, L);
        float sc[16];
        const int key0 = kt * 32, d0 = tq - key0 - 4 * g;
        const float fb = slope2 * (float)d0;
#pragma unroll
        for (int q = 0; q < 16; ++q) sc[q] = fmaf(slope2, (float)((q & 3) + 8 * (q >> 2)), acc[q]) - fb;
        if (kt == mylo || kt == myhi) {
#pragma unroll
          for (int q = 0; q < 16; ++q) { const int dist = d0 - ((q & 3) + 8 * (q >> 2)); sc[q] = (dist >= 0 && dist < 512) ? sc[q] : NEG_INF; }
        }
        softmax_step_lds(st, sc, sg + 8192, L);
      }
    }
    stash_add(stw, st.o, attn_inv_l(st) * sigmoidf_(gt[2]));
  }
  unsigned long long uni;
  {
    unsigned lo32 = (unsigned)mymask, hi32 = (unsigned)(mymask >> 32);
#pragma unroll
    for (int o = 1; o < 32; o <<= 1) { lo32 |= shxu(lo32, o); hi32 |= shxu(hi32, o); }
    uni = ((unsigned long long)(unsigned)__builtin_amdgcn_readfirstlane((int)hi32) << 32) | (unsigned)__builtin_amdgcn_readfirstlane((int)lo32);
    const int mbw = t0 >> 6;
    uni &= (mbw >= 63) ? ~0ull : ((1ull << (mbw + 1)) - 1ull);
    if (lane == 0) { tl[160 + wave * 2] = (int)(unsigned)uni; tl[160 + wave * 2 + 1] = (int)(unsigned)(uni >> 32); }
  }
  AT_WAIT_L0();
  AT_BAR();
  {
    unsigned long long ub = 0ull;
#pragma unroll
    for (int w2 = 0; w2 < 8; w2 += 4) ub |= ((unsigned long long)(unsigned)tl[160 + w2 * 2 + 1] << 32) | (unsigned)tl[160 + w2 * 2];
    int n = 0;
    if (wave == 0 && lane == 0) {
      const int thrg = (int)(200.f / (exp2f(-0.5f * (float)(c.gk * 4 + 4)) * LOG2E)) + 1;
      for (int mb = 0; mb <= c.tile64; ++mb) if (((ub >> mb) & 1ull) && c.tile64 * 64 - (mb * 64 + 63) <= thrg) { tl[n++] = mb * 2; tl[n++] = mb * 2 + 1; }
      tl[159] = n;
    }
  }
  AT_WAIT_L0();
  AT_BAR();
  {
    const int nsteps = __builtin_amdgcn_readfirstlane(tl[159]);
    attn_init(st);
    if (nsteps > 0) { const int k0 = __builtin_amdgcn_readfirstlane(tl[0]); kv_issue(stg, KS + (size_t)k0 * 4096, VST + (size_t)k0 * 4096, L); }
    if (nsteps > 1) { const int k1 = __builtin_amdgcn_readfirstlane(tl[1]); kv_issue(stg + AT_STAGE, KS + (size_t)k1 * 4096, VST + (size_t)k1 * 4096, L); }
#pragma unroll 1
    for (int i = 0; i < nsteps; ++i) {
      const int kt = __builtin_amdgcn_readfirstlane(tl[i]);
      if (i + 1 < nsteps) AT_WAIT_V(2); else AT_WAIT_V(0);
      AT_BAR();
      if (i + 2 < nsteps) { const int k2 = __builtin_amdgcn_readfirstlane(tl[i + 2]); kv_issue(stg + ((i + 2) % 3) * AT_STAGE, KS + (size_t)k2 * 4096, VST + (size_t)k2 * 4096, L); }
      const int mb = kt >> 1, key0 = kt * 32;
      if (((uni >> mb) & 1ull) && key0 <= t0 + 31 && t0 - (key0 + 31) <= thr) {
        const bool mine = (mymask >> mb) & 1ull;
        const LAS unsigned char* sg = stg + (i % 3) * AT_STAGE;
        f32x16 acc = score_tile_lds(qf, sg, L);
        float sc[16];
        const int d0 = tq - key0 - 4 * g;
        const float fb = mine ? slope2 * (float)d0 : __builtin_inff();
#pragma unroll
        for (int q = 0; q < 16; ++q) sc[q] = fmaf(slope2, (float)((q & 3) + 8 * (q >> 2)), acc[q]) - fb;
        if (key0 >= t0) {
#pragma unroll
          for (int q = 0; q < 16; ++q) sc[q] = (d0 - ((q & 3) + 8 * (q >> 2)) >= 0) ? sc[q] : NEG_INF;
        }
        softmax_step_lds(st, sc, sg + 8192, L);
      }
    }
  }
  const float f = attn_inv_l(st) * sigmoidf_(gt[1]);
  bf16_t* orow = (bf16_t*)(p.ws + A_MIXO) + m * D_ + h * 128;
#pragma unroll
  for (int vt = 0; vt < 4; ++vt)
#pragma unroll
    for (int q = 0; q < 4; ++q) {
      const unsigned w0 = stw[(vt * 8 + q * 2) * 64], w1 = stw[(vt * 8 + q * 2 + 1) * 64];
      f32x4 v; v[0] = __uint_as_float(w0 << 16) + st.o[vt][q * 4] * f; v[1] = __uint_as_float(w0 & 0xffff0000u) + st.o[vt][q * 4 + 1] * f;
      v[2] = __uint_as_float(w1 << 16) + st.o[vt][q * 4 + 2] * f; v[3] = __uint_as_float(w1 & 0xffff0000u) + st.o[vt][q * 4 + 3] * f;
      st_bf16x4(orow + vt * 32 + q * 8 + 4 * g, v);
    }
  AT_WAIT_L0();
}
DI void nsa_task(const Params& p, int o_idx, int b, int gk, int tile64) {
  const NsaCtx c{b, gk, tile64, o_idx};
  nsa_cmp1(p, c);
  __syncthreads();
  nsa_cmp2(p, c);
  __syncthreads();
  nsa_topk(p, c);
  __syncthreads();
  nsa_winslc(p, c);
  __syncthreads();
}

DI void cmp2_task(const Params& p, int e, int kv, int rt) {
  const int lane = TIDX & 63, lr = lane & 31, g = lane >> 5;
  const int row = rt * 32 + lr;
  const float* SPL = (const float*)(p.ws + O_SPL) + (size_t)kv * 8 * 2048 * 256 + (size_t)row * 256 + g * 8;
  const float* bias = (const float*)(p.ws + A_BIAS1) + (e * 2 + kv) * 256 + g * 8;
  const bf16_t* W2 = (const bf16_t*)(p.ws + W_C2 + (size_t)(e * 2 + kv) * SZ_C2) + (size_t)lr * 256 + g * 8;
  f32x16 acc[4];
#pragma unroll
  for (int i = 0; i < 4; ++i) acc[i] = zero16();
#pragma unroll 2
  for (int ks = 0; ks < 16; ++ks) {
    f32x4 a0 = *(const f32x4*)(bias + ks * 16), a1 = *(const f32x4*)(bias + ks * 16 + 4);
#pragma unroll
    for (int sp = 0; sp < 8; ++sp) { const float* q = SPL + (size_t)sp * 2048 * 256 + ks * 16; a0 += *(const f32x4*)q; a1 += *(const f32x4*)(q + 4); }
    float hv[8];
#pragma unroll
    for (int i = 0; i < 4; ++i) { hv[i] = gelu_tanh(a0[i]); hv[4 + i] = gelu_tanh(a1[i]); }
    const bf16x8 hb = pack8(hv);
#pragma unroll
    for (int dt = 0; dt < 4; ++dt) { const bf16x8 w = *(const bf16x8*)(W2 + (size_t)dt * 32 * 256 + ks * 16); acc[dt] = mfma32(w, hb, acc[dt]); }
  }
  if (kv == 0) {
    float ss = 0.f;
#pragma unroll
    for (int dt = 0; dt < 4; ++dt)
#pragma unroll
      for (int i = 0; i < 16; ++i) ss += acc[dt][i] * acc[dt][i];
    ss = xhalf_sum(ss);
    const float rs = rsqrtf(ss * (1.f / 128.f) + EPS_);
    const float* gn = p.in[16] + (e * 3 + 0) * 128;
    bf16_t* orow = (bf16_t*)(p.ws + O_KCMP) + (size_t)row * 128;
#pragma unroll
    for (int dt = 0; dt < 4; ++dt)
#pragma unroll
      for (int q = 0; q < 4; ++q) {
        const int d0 = dt * 32 + q * 8 + 4 * g;
        const f32x4 gg = *(const f32x4*)(gn + d0);
        f32x4 v; for (int e2 = 0; e2 < 4; ++e2) v[e2] = acc[dt][q * 4 + e2] * rs * gg[e2];
        st_bf16x4(orow + d0, v);
      }
  } else {
    bf16_t* ob = (bf16_t*)(p.ws + O_VCMPT) + (size_t)(row >> 8) * 128 * 256 + (size_t)((row & 255) >> 5) * 4096 + (row & 31);
#pragma unroll
    for (int dt = 0; dt < 4; ++dt)
#pragma unroll
      for (int i = 0; i < 16; ++i) ob[(size_t)(dt * 32 + crow(i, g)) * 32] = f2bf(acc[dt][i]);
  }
}

DI void cmp_bias_jobs(const Params& p) {
  extern __shared__ __attribute__((aligned(16))) char dyn_lds[];
  float* red = (float*)dyn_lds;
  const int tid = TIDX, part = tid >> 5, cl = tid & 31;
  for (int it = (int)gridDim.x - 1 - (int)blockIdx.x; it < 32; it += gridDim.x) {
    const int job = it >> 3, cg8 = it & 7, l = job >> 1, kv = job & 1;
    const float* pe = p.in[kv ? 20 : 17] + (size_t)l * 4096;
    const float* w1 = p.in[kv ? 21 : 18] + (size_t)l * 4096 * 256;
    const int c = cg8 * 32 + cl;
    float s = 0.f;
#pragma unroll 8
    for (int k = part * 256; k < part * 256 + 256; ++k) s += pe[k] * w1[(size_t)k * 256 + c];
    red[part * 32 + cl] = s;
    __syncthreads();
    if (tid < 32) { float a = 0.f; for (int q = 0; q < 16; ++q) a += red[q * 32 + tid]; ((float*)(p.ws + A_BIAS1))[job * 256 + cg8 * 32 + tid] = a; }
    __syncthreads();
  }
}

#define XB_TMO      128
#define XB_XCNT(j)  (256  + 64 * (j))
#define XB_XSUB(j)  (1280 + 64 * (j))
#define XB_XGEN(j)  (2304 + 64 * (j))
#define XB_TOP      3328
#define XB_TOPGEN   3392
#define XCD_BAR_WORDS 3456
#define XB_SPIN_CAP (1u << 18)
DI unsigned xb_ld(unsigned* q)              { return __hip_atomic_load(q, __ATOMIC_RELAXED, __HIP_MEMORY_SCOPE_AGENT); }
DI unsigned xb_add(unsigned* q, unsigned v) { return __hip_atomic_fetch_add(q, v, __ATOMIC_RELAXED, __HIP_MEMORY_SCOPE_AGENT); }
DI unsigned xb_xcc_id() { return (unsigned)__builtin_amdgcn_s_getreg((3 << 11) | 20) & 0xFu; }
#define XB_SPIN(cond, bar) do { unsigned _sp = 0; while (cond) { __builtin_amdgcn_s_sleep(1); \
    if ((++_sp & 255u) == 0u) { if (xb_ld(&(bar)[XB_TMO])) break; if (_sp > XB_SPIN_CAP) { atomicAdd(&(bar)[XB_TMO], 1u); break; } } } } while (0)
struct XcdBarrier { unsigned* bar; unsigned x; volatile LAS unsigned* st; };
DI XcdBarrier xcd_barrier_post(unsigned* bar, volatile LAS unsigned* st) {
  XcdBarrier b; b.bar = bar; b.x = xb_xcc_id(); b.st = st;
  if (threadIdx.x == 0) (void)xb_add(&bar[XB_XCNT(b.x)], 1u);
  return b;
}
DI void xcd_barrier_complete(unsigned* bar, unsigned x, unsigned& nloc, unsigned& nx) {
  const unsigned G = gridDim.x * gridDim.y * gridDim.z;
  unsigned sum, cnt, mine, sp = 0u;
  for (;;) {
    sum = 0u; cnt = 0u; mine = 0u;
#pragma unroll
    for (unsigned j = 0; j < 16; ++j) { const unsigned c = xb_ld(&bar[XB_XCNT(j)]); sum += c; cnt += (c > 0u) ? 1u : 0u; mine = (j == x) ? c : mine; }
    if (sum == G) break;
    __builtin_amdgcn_s_sleep(1);
    if ((++sp & 255u) == 0u) { if (xb_ld(&bar[XB_TMO])) break; if (sp > XB_SPIN_CAP) { atomicAdd(&bar[XB_TMO], 1u); break; } }
  }
  nloc = mine > 0u ? mine : 1u; nx = cnt > 0u ? cnt : 1u;
}
DI void xcd_barrier(const XcdBarrier& b) {
  asm volatile("s_waitcnt vmcnt(0)" ::: "memory");
  __syncthreads();
  if (threadIdx.x == 0) {
    unsigned* bar = b.bar;
    __builtin_amdgcn_s_waitcnt(0);
    unsigned nloc = b.st[0], nx = b.st[1];
    if (nloc == 0u) { xcd_barrier_complete(bar, b.x, nloc, nx); b.st[0] = nloc; b.st[1] = nx; }
    const unsigned old = xb_add(&bar[XB_XSUB(b.x)], 1u);
    const unsigned gen = old / nloc;
    if (old + 1u == (gen + 1u) * nloc) {
      __builtin_amdgcn_fence(__ATOMIC_RELEASE, "agent");
      asm volatile("s_waitcnt vmcnt(0)" ::: "memory");
      const unsigned og = xb_add(&bar[XB_TOP], 1u);
      const unsigned tg = og / nx;
      if (og + 1u == (tg + 1u) * nx) xb_add(&bar[XB_TOPGEN], 1u);
      else XB_SPIN(xb_ld(&bar[XB_TOPGEN]) == tg, bar);
      __builtin_amdgcn_fence(__ATOMIC_ACQUIRE, "agent");
      xb_add(&bar[XB_XGEN(b.x)], 1u);
      asm volatile("s_waitcnt vmcnt(0)" ::: "memory");
    } else {
      XB_SPIN(xb_ld(&bar[XB_XGEN(b.x)]) == gen, bar);
      __builtin_amdgcn_fence(__ATOMIC_ACQUIRE, "agent");
      asm volatile("s_waitcnt vmcnt(0)" ::: "memory");
    }
  }
  __syncthreads();
}

#ifndef ONLY_KEY
#define ONLY_KEY (-1)
#endif
#define KEYOK(k) (ONLY_KEY < 0 || ONLY_KEY == (k))
constexpr int PH_PRE = 1, PH_PER_LAYER = 11, PH_TOTAL = PH_PRE + 4 * PH_PER_LAYER;

DI void run_phase(const Params& p0, int ph) {
  Params p = p0;
  { unsigned long long w_ = (unsigned long long)p0.ws; asm volatile("" : "+s"(w_)); p.ws = (unsigned char*)(__attribute__((address_space(1))) unsigned char*)w_; }
  unsigned char* ws = p.ws;
  if (ph == 0) {
    if (!KEYOK(0)) return;
    transpose_jobs(p);
    rmsnorm_rows(p.in[1], nullptr, (bf16_t*)(ws + A_MEMN), 512);
    xprep_rows(p.in[0], (bf16_t*)(ws + A_H), (float*)(ws + A_SSP), M_);
    cmp_bias_jobs(p);
    return;
  }
  const int layer = (ph - PH_PRE) / PH_PER_LAYER, sidx = (ph - PH_PRE) % PH_PER_LAYER;
  const int step = sidx < 6 ? sidx + 1 : (sidx < 9 ? sidx + 2 : sidx + 3);
  float* sspA = (float*)(ws + A_SSP); float* sspB = sspA + (size_t)M_ * 8; float* sspC = sspB + (size_t)M_ * 8;
  const bool even = (layer & 1) == 0; const int e = layer >> 1;
  const float* xin = layer == 0 ? p.in[0] : (const float*)(ws + A_XRES);
  float* xres = (float*)(ws + A_XRES);
  bf16_t* H = (bf16_t*)(ws + A_H);
  switch (step) {
    case 1:
      if (even) { if (KEYOK(4)) { EpiEvenIn epi{sspA, ws}; gemm_run(H, D_, (const bf16_t*)(ws + W_EIN + e * SZ_EIN), D_, M_, N_EIN, D_, epi); }
        if (layer == 0) { if (KEYOK(1)) { EpiMemKV epi{(bf16_t*)(ws + A_MEMK), (bf16_t*)(ws + A_MEMVT)};
          gemm_run((const bf16_t*)(ws + A_MEMN), D_, (const bf16_t*)(ws + W_MKV), D_, 512, 4096, D_, epi, 160); } } }
      else { if (KEYOK(18)) { EpiOddIn epi{sspA, ws}; gemm_run(H, D_, (const bf16_t*)(ws + W_OIN + e * SZ_OIN), D_, M_, N_OIN, D_, epi); } }
      break;
    case 2:
      if (even) {
        if (KEYOK(5)) {
        headnorm_rows((bf16_t*)(ws + E_FK), 16 * T_, p.in[10] + e * 128, 0, 0);
        if (layer == 0) for (int l = 0; l < 4; ++l) headnorm_rows((bf16_t*)(ws + A_MEMK) + (size_t)l * 8 * 256 * 128, 8 * 256, p.in[27] + l * 128, 0, 0);
        fox_cumsum(p, e);
        hgrn_prep(p, e);
        }
      } else {
        if (KEYOK(19)) {
        headnorm_rows((bf16_t*)(ws + O_KS), 8 * T_, p.in[16] + (e * 3 + 1) * 128, 0, 0);
        headnorm_rows((bf16_t*)(ws + O_KW), 8 * T_, p.in[16] + (e * 3 + 2) * 128, 0, 0);
#pragma unroll 1
        for (int c = 0; c < 16; ++c) {
          const int kv = c >> 3, sp = c & 7;
          EpiF32 epi{(float*)(ws + O_SPL) + (size_t)c * 2048 * 256, 256};
          gemm_run((const bf16_t*)(ws + (kv ? O_VC : O_KC)) + sp * 512, 2048, (const bf16_t*)(ws + W_C1 + (e * 2 + kv) * SZ_C1) + sp * 512, 4096, 2048, 256, 512, epi, c * 8);
        }
        }
      }
      break;
    case 3:
      if (even) {
        if (KEYOK(6)) {
          for (int bt = blockIdx.x; bt < 256; bt += gridDim.x) fox_block(p, e, bt >> 4, bt & 15);
        }
        if (KEYOK(7)) {
          const int wave = TIDX >> 6;
          for (int ti = wave * gridDim.x + blockIdx.x; ti < 4096; ti += 8 * gridDim.x) hgrn_u_task(p, ti >> 8, (ti >> 2) & 63, ti & 3);
        }
      } else {
        if (KEYOK(20)) { const int wave = TIDX >> 6; for (int ti = wave * gridDim.x + blockIdx.x; ti < 128; ti += 8 * gridDim.x) cmp2_task(p, e, ti >> 6, ti & 63); }
      }
      break;
    case 4:
      if (even) { if (KEYOK(8)) hgrn_scan(p); }
      break;
    case 5:
      if (even) {
        if (KEYOK(9)) { const int wave = TIDX >> 6; for (int ti = wave * gridDim.x + blockIdx.x; ti < 2048; ti += 8 * gridDim.x) hgrn_out_task(p, e, ti >> 7, (ti >> 1) & 63, ti & 1); }
      } else {
        if (KEYOK(22)) {
          extern __shared__ __attribute__((aligned(16))) char dyn_lds[];
          volatile LAS unsigned* qs = (volatile LAS unsigned*)((LAS unsigned char*)dyn_lds + NSA_LDS) + 2;
          unsigned* ctr = (unsigned*)(ws + A_BAR) + 3600 + 64 * e;
          for (;;) {
            if (threadIdx.x == 0) qs[0] = __hip_atomic_fetch_add(ctr, 1u, __ATOMIC_RELAXED, __HIP_MEMORY_SCOPE_AGENT);
            __syncthreads();
            const int q = __builtin_amdgcn_readfirstlane((int)qs[0]);
            __syncthreads();
            if (q >= 512) break;
            const int bg = q & 7;
            nsa_task(p, e, bg >> 2, bg & 3, 63 - (q >> 3));
          }
        }
      }
      break;
    case 6: if (KEYOK(10)) {
      EpiResid epi{xin, xres, H, sspB};
      gemm_run((const bf16_t*)(ws + A_MIXO), D_, (const bf16_t*)(ws + (even ? W_EOUT : W_OOUT) + e * SZ_SQ), D_, M_, D_, D_, epi);
    } break;
    case 8: if (KEYOK(11)) {
#pragma unroll 1
      for (int sp = 0; sp < 4; ++sp) {
        EpiF32 epi{(float*)(ws + A_SCR) + (size_t)sp * M_ * 512, 512};
        gemm_run(H + sp * 512, D_, (const bf16_t*)(ws + W_MQ + layer * SZ_MQ) + sp * 512, D_, M_, 512, 512, epi, sp * 64);
      }
    } break;
    case 9:
      if (KEYOK(12)) { for (int bt = blockIdx.x; bt < 256; bt += gridDim.x) memattn_block(p, layer, bt >> 5, bt & 31); }
      break;
    case 10: if (KEYOK(10)) { EpiResid epi{xres, xres, H, sspC}; gemm_run((const bf16_t*)(ws + A_MAO), 512, (const bf16_t*)(ws + W_MO + layer * SZ_MQ), 512, M_, D_, 512, epi); } break;
    case 12: if (KEYOK(13)) { EpiSwiglu epi{sspC, (bf16_t*)(ws + F_HID)}; gemm_run(H, D_, (const bf16_t*)(ws + W_F13 + layer * SZ_F13), D_, M_, N_F13, D_, epi); } break;
    default: if (KEYOK(10)) { EpiResid epi{xres, layer == 3 ? p.out : xres, layer == 3 ? nullptr : H, layer == 3 ? nullptr : sspA}; gemm_run((const bf16_t*)(ws + F_HID), FFN_, (const bf16_t*)(ws + W_F2 + layer * SZ_F2), FFN_, M_, D_, FFN_, epi); } break;
  }
}

__global__ void __launch_bounds__(NTH) fwd_megakernel(Params p) {
#if ONE_LAUNCH
  cg::grid_group grid = cg::this_grid();
  extern __shared__ __attribute__((aligned(16))) char dyn_lds[];
  volatile LAS unsigned* xst = (volatile LAS unsigned*)((LAS unsigned char*)dyn_lds + NSA_LDS);
  if (threadIdx.x == 0) { xst[0] = 0u; xst[1] = 0u; xst[2] = 0u; xst[3] = 0u; }
  __syncthreads();
  const XcdBarrier xb = xcd_barrier_post((unsigned*)(p.ws + A_BAR), xst);
  for (int ph = p.ph_lo; ph < p.ph_hi; ++ph) {
    if (ph >= PH_PRE && (((ph - PH_PRE) / PH_PER_LAYER) & 1) == 1 && (ph - PH_PRE) % PH_PER_LAYER == 3) continue;
    run_phase(p, ph);
    if (ph + 1 < p.ph_hi) { if (ph == 0) grid.sync(); else xcd_barrier(xb); }
  }
#else
  for (int ph = p.ph_lo; ph < p.ph_hi; ++ph) run_phase(p, ph);
#endif
}

extern "C" void kernel_launch(void* const* d_in, const int* in_sizes, int n_in, void* d_out, int out_size, void* d_ws, size_t ws_size, hipStream_t stream) {
  static int grid_blocks = 0;
  constexpr size_t kDynLds = NSA_LDS + 16;
  if (grid_blocks == 0) {
    if (n_in != 31 || ws_size < WS_NEED) { fprintf(stderr, "kernel_launch: need 31 inputs and %zu workspace bytes; got %d, %zu\n", (size_t)WS_NEED, n_in, ws_size); grid_blocks = -1; return; }
    int dev = 0, cus = 0, per_cu = 0;
    hipGetDevice(&dev);
    hipDeviceGetAttribute(&cus, hipDeviceAttributeMultiprocessorCount, dev);
    hipFuncSetAttribute((const void*)fwd_megakernel, hipFuncAttributeMaxDynamicSharedMemorySize, (int)kDynLds);
    hipOccupancyMaxActiveBlocksPerMultiprocessor(&per_cu, (const void*)fwd_megakernel, NTH, kDynLds);
    if (per_cu < 1) per_cu = 1;
    grid_blocks = cus * per_cu;
    if (grid_blocks > 256) grid_blocks = 256;
  }
  if (grid_blocks < 0) return;
  hipMemsetAsync((unsigned char*)d_ws + A_BAR, 0, BAR_BYTES, stream);
  Params p{};
  for (int i = 0; i < 31; ++i) p.in[i] = (const float*)d_in[i];
  p.out = (float*)d_out; p.ws = (unsigned char*)d_ws;
#if ONE_LAUNCH
  p.ph_lo = 0; p.ph_hi = PH_TOTAL;
  void* args[] = {&p};
  hipError_t e = hipLaunchCooperativeKernel((const void*)fwd_megakernel, dim3(grid_blocks), dim3(NTH), args, kDynLds, stream);
  if (e != hipSuccess) fprintf(stderr, "cooperative launch failed: %s (grid %d)\n", hipGetErrorString(e), grid_blocks);
#else
  for (int ph = 0; ph < PH_TOTAL; ++ph) {
    p.ph_lo = ph; p.ph_hi = ph + 1;
    hipLaunchKernelGGL(fwd_megakernel, dim3(grid_blocks), dim3(NTH), kDynLds, stream, p);
  }
#endif
}
```

```cpp
#include <hip/hip_runtime.h>
#include <hip/hip_cooperative_groups.h>
#include <cstdio>
namespace cg = cooperative_groups;

#ifndef ONE_LAUNCH
#define ONE_LAUNCH 1
#endif

typedef unsigned short bf16_t;
typedef short bf16x8 __attribute__((ext_vector_type(8)));
typedef short s16x4 __attribute__((ext_vector_type(4)));
typedef float f32x4 __attribute__((ext_vector_type(4)));
typedef float f32x16 __attribute__((ext_vector_type(16)));
typedef unsigned u32x2 __attribute__((ext_vector_type(2)));
typedef unsigned u32x4 __attribute__((ext_vector_type(4)));
#define DI __device__ __forceinline__

constexpr int T_ = 4096, M_ = 8192, D_ = 2048, NTH = 512;
constexpr float EPS_ = 1e-6f, LOG2E = 1.4426950408889634f, ATTN_SCALE = 0.08838834764831845f;
#define NEG_INF (-__builtin_inff())

constexpr size_t al(size_t x) { return (x + 255) & ~(size_t)255; }
constexpr int N_EIN = 7424, N_OIN = 5376, N_F13 = 11264, FFN_ = 5632;
constexpr size_t SZ_EIN = (size_t)N_EIN * 2048 * 2, SZ_SQ = (size_t)2048 * 2048 * 2, SZ_OIN = (size_t)N_OIN * 2048 * 2;
constexpr size_t SZ_C1 = (size_t)256 * 4096 * 2, SZ_C2 = (size_t)256 * 256 * 2, SZ_MQ = (size_t)512 * 2048 * 2, SZ_MKV = (size_t)1024 * 2048 * 2;
constexpr size_t SZ_F13 = (size_t)N_F13 * 2048 * 2, SZ_F2 = (size_t)2048 * FFN_ * 2;
constexpr size_t W_EIN = 0;
constexpr size_t W_EOUT = W_EIN + 2 * SZ_EIN;
constexpr size_t W_OIN = W_EOUT + 2 * SZ_SQ;
constexpr size_t W_OOUT = W_OIN + 2 * SZ_OIN;
constexpr size_t W_C1 = W_OOUT + 2 * SZ_SQ;
constexpr size_t W_C2 = W_C1 + 4 * SZ_C1;
constexpr size_t W_MQ = W_C2 + 4 * SZ_C2;
constexpr size_t W_MKV = W_MQ + 4 * SZ_MQ;
constexpr size_t W_MO = W_MKV + 4 * SZ_MKV;
constexpr size_t W_F13 = W_MO + 4 * SZ_MQ;
constexpr size_t W_F2 = W_F13 + 4 * SZ_F13;
constexpr size_t W_END = W_F2 + 4 * SZ_F2;
constexpr size_t A_XRES = al(W_END);
constexpr size_t A_H = A_XRES + (size_t)M_ * D_ * 4;
constexpr size_t A_MEMN = A_H + (size_t)M_ * D_ * 2;
constexpr size_t A_MEMK = A_MEMN + (size_t)4 * 512 * 2048 * 2;
constexpr size_t A_MEMVT = A_MEMK + (size_t)4 * 2 * 4 * 256 * 128 * 2;
constexpr size_t A_BIAS1 = A_MEMVT + (size_t)4 * 2 * 4 * 256 * 128 * 2;
constexpr size_t A_QM = A_BIAS1 + 4096;
constexpr size_t A_MAO = A_QM + (size_t)M_ * 512 * 2;
constexpr size_t A_MIXO = A_MAO + (size_t)M_ * 512 * 2;
constexpr size_t A_SSP = A_MIXO + (size_t)M_ * D_ * 2;
constexpr size_t SZ_SSP = (size_t)M_ * 8 * 4;
constexpr size_t A_BAR = A_SSP + 3 * SZ_SSP;
constexpr size_t BAR_BYTES = 16384;
constexpr size_t A_SCR = A_BAR + BAR_BYTES;
constexpr size_t SZ16 = (size_t)M_ * 1024 * 2;
constexpr size_t E_FQ = A_SCR, E_FK = E_FQ + SZ16, E_FVT = E_FK + SZ16, E_HQ = E_FVT + SZ16, E_HF = E_HQ + SZ16  ,
                 E_HIT = E_HF + 2 * SZ16, E_HG = E_HIT + SZ16, E_QT = E_HG + SZ16, E_KT = E_QT + SZ16, E_QS = E_KT + SZ16, E_KUT = E_QS + SZ16,
                 E_U = E_KUT + SZ16  , E_FF = E_U + 4 * SZ16  , E_FC = E_FF + (size_t)M_ * 8 * 4  ,
                 E_DL = E_FC + (size_t)16 * T_ * 4  , E_END = E_DL + (size_t)16 * 64 * 128 * 4;
constexpr size_t E_ST = E_HF;
constexpr size_t SZ8 = (size_t)M_ * 512 * 2;
constexpr size_t O_NQ = A_SCR, O_KC = O_NQ + 2 * SZ16, O_VC = O_KC + SZ8 + 65536, O_KS = O_VC + SZ8 + 65536, O_KW = O_KS + SZ8, O_VST = O_KW + SZ8,
                 O_VWT = O_VST + SZ8, O_GT = O_VWT + SZ8  , O_HC = O_GT + (size_t)M_ * 48 * 4  ,
                 O_KCMP = O_HC + (size_t)2 * 2048 * 256 * 2, O_VCMPT = O_KCMP + (size_t)2048 * 128 * 2, O_SPL = O_VCMPT + (size_t)2048 * 128 * 2  ,
                 O_END = O_SPL + (size_t)16 * 2048 * 256 * 4;
constexpr size_t F_HID = A_SCR;
constexpr size_t F_END = F_HID + (size_t)M_ * FFN_ * 2;
constexpr size_t WS_NEED = (E_END > O_END ? (E_END > F_END ? E_END : F_END) : (O_END > F_END ? O_END : F_END));

struct Params {
  const float* in[31];
  float* out;
  unsigned char* ws;
  int ph_lo, ph_hi;
};

DI int launder(int x) { asm volatile("" : "+v"(x)); return x; }
#define TIDX launder((int)threadIdx.x)
DI float bf2f(bf16_t v) { return __uint_as_float(((unsigned)v) << 16); }
typedef __bf16 hwbf16x2g __attribute__((ext_vector_type(2)));
typedef float f32x2g __attribute__((ext_vector_type(2)));
DI unsigned pk2(float lo, float hi) { const f32x2g f = {lo, hi}; const hwbf16x2g r = __builtin_convertvector(f, hwbf16x2g); return __builtin_bit_cast(unsigned, r); }
DI bf16_t f2bf(float x) { return (bf16_t)(pk2(x, 0.f) & 0xffffu); }
DI int lane_now() { return TIDX & 63; }
DI float shx(float v, int mask) { return __int_as_float(__builtin_amdgcn_ds_bpermute((lane_now() ^ mask) << 2, __float_as_int(v))); }
DI unsigned shxu(unsigned v, int mask) { return (unsigned)__builtin_amdgcn_ds_bpermute((lane_now() ^ mask) << 2, (int)v); }
DI float xhalf_max(float v) { const auto r = __builtin_amdgcn_permlane32_swap(__float_as_uint(v), __float_as_uint(v), false, false); return fmaxf(__uint_as_float(r[0]), __uint_as_float(r[1])); }
DI float xhalf_sum(float v) { const auto r = __builtin_amdgcn_permlane32_swap(__float_as_uint(v), __float_as_uint(v), false, false); return __uint_as_float(r[0]) + __uint_as_float(r[1]); }
DI float shidx(float v, int src) { return __int_as_float(__builtin_amdgcn_ds_bpermute(src << 2, __float_as_int(v))); }
DI float wave_sum(float v) {
#pragma unroll
  for (int o = 1; o < 64; o <<= 1) v += shx(v, o);
  return v;
}
DI float fexp2(float x) { return __builtin_amdgcn_exp2f(x); }
DI float frcp(float x) { return __builtin_amdgcn_rcpf(x); }
DI float sigmoidf_(float x) { return frcp(1.f + __expf(-x)); }
DI f32x16 mfma32(bf16x8 a, bf16x8 b, f32x16 c) { return __builtin_amdgcn_mfma_f32_32x32x16_bf16(a, b, c, 0, 0, 0); }
DI f32x16 zero16() { f32x16 z; for (int i = 0; i < 16; ++i) z[i] = 0.f; return z; }

constexpr int BM = 256, BK = 64, HALF = 128, HT = HALF * BK, NXCD = 8, WGM = 8;
constexpr int GEMM_LDS = 8 * HT * 2;
DI int lds_byte(int r, int c) { int st = (r >> 4) * 2 + (c >> 5), rr = r & 15, cc = c & 31, ob = rr * 64 + cc * 2; return st * 1024 + (ob ^ (((ob >> 9) & 1) << 5)); }
DI void stage_rc(int b, int& R, int& C) { int st = b / 1024, sb = b % 1024, swz = sb ^ (((sb >> 9) & 1) << 5); R = (st >> 1) * 16 + swz / 64; C = (st & 1) * 32 + (swz % 64) / 2; }

#define LAS __attribute__((address_space(3)))
DI const char* uniform_ptr(const char* p) { const unsigned long long v = (unsigned long long)p; const unsigned lo = (unsigned)__builtin_amdgcn_readfirstlane((int)(unsigned)v), hi = (unsigned)__builtin_amdgcn_readfirstlane((int)(unsigned)(v >> 32)); return (const char*)(((unsigned long long)hi << 32) | lo); }
template <class Epi>
DI void gemm_run(const bf16_t* __restrict__ A, int lda, const bf16_t* __restrict__ Bt, int ldb, int M, int N, int K, const Epi& epi, int blk_off = 0) {
  extern __shared__ __attribute__((aligned(16))) char dyn_lds[];
  LAS unsigned char* lds = (LAS unsigned char*)dyn_lds;
  const int tid = TIDX, wid = __builtin_amdgcn_readfirstlane(tid >> 6), lane = tid & 63, wr = wid >> 2, wc = wid & 3, fr = lane & 15, fq = lane >> 4;
  const int nt = K / BK;
  unsigned voffA[2], voffB[2];
#pragma unroll
  for (int i = 0; i < 2; ++i) { int R, C; stage_rc(tid * 16 + i * 8192, R, C); voffA[i] = (unsigned)(R * lda + C) * 2u; voffB[i] = (unsigned)(R * ldb + C) * 2u; }
  const size_t kstep = (size_t)(BK * 2);
  const size_t hstepA = (size_t)HALF * lda * 2, hstepB = (size_t)HALF * ldb * 2;
  const unsigned ldsw = (unsigned)wid * 1024u;
  const int aoff = lds_byte(wr * 64 + fr, fq * 8), boff = lds_byte(wc * 32 + fr, fq * 8);
  constexpr int HTB = HT * 2;
#define G_SA(b, h) (((b) * 2 + (h)) * HTB)
#define G_SB(b, h) ((4 + (b) * 2 + (h)) * HTB)
#define G_STAGE(bufoff, gbase, voff) do { _Pragma("unroll") for (int _i = 0; _i < 2; ++_i) \
    __builtin_amdgcn_global_load_lds((const unsigned*)(uniform_ptr((const char*)(gbase)) + (voff)[_i]), (LAS unsigned*)(lds + (bufoff) + ldsw + _i * 8192), 16, 0, 0); } while (0)
#define G_LDA(dst, b, h) do { _Pragma("unroll") for (int m = 0; m < 4; ++m) _Pragma("unroll") for (int k = 0; k < 2; ++k) dst[m][k] = *(const LAS bf16x8*)(lds + G_SA(b, h) + aoff + m * 2048 + k * 1024); } while (0)
#define G_LDB(dst, b, h) do { _Pragma("unroll") for (int n = 0; n < 2; ++n) _Pragma("unroll") for (int k = 0; k < 2; ++k) dst[n][k] = *(const LAS bf16x8*)(lds + G_SB(b, h) + boff + n * 2048 + k * 1024); } while (0)
#define G_MMA(ai, bj, At, Bx) do { __builtin_amdgcn_s_setprio(1); _Pragma("unroll") for (int m = 0; m < 4; ++m) _Pragma("unroll") for (int n = 0; n < 2; ++n) _Pragma("unroll") for (int k = 0; k < 2; ++k) \
    acc[ai][bj][m][n] = __builtin_amdgcn_mfma_f32_16x16x32_bf16(Bx[n][k], At[m][k], acc[ai][bj][m][n], 0, 0, 0); __builtin_amdgcn_s_setprio(0); } while (0)
#define WAIT_V(n) asm volatile("s_waitcnt vmcnt(" #n ")" ::: "memory")
#define WAIT_L(n) asm volatile("s_waitcnt lgkmcnt(" #n ")" ::: "memory")
#define BAR __builtin_amdgcn_s_barrier()
#define SCHED __builtin_amdgcn_sched_barrier(0)
  const int nM = M / BM, nN = N / BM, nwg = nM * nN;
  for (int u = (int)((blockIdx.x + gridDim.x - blk_off) % gridDim.x); u < nwg; u += gridDim.x) {
    int wgid = u;
    { int q = nwg / NXCD, r = nwg % NXCD, xcd = wgid % NXCD, off = wgid / NXCD; wgid = (xcd < r ? xcd * (q + 1) : r * (q + 1) + (xcd - r) * q) + off; }
    int nig = WGM * nN, gid = wgid / nig, fm = gid * WGM, gsz = min(nM - fm, WGM);
    const int pm = __builtin_amdgcn_readfirstlane(fm + ((wgid % nig) % gsz)), pn = __builtin_amdgcn_readfirstlane((wgid % nig) / gsz), brow = pm * BM, bcol = pn * BM;
    f32x4 acc[2][2][4][2];
#pragma unroll
    for (int a = 0; a < 2; ++a)
#pragma unroll
      for (int b = 0; b < 2; ++b)
#pragma unroll
        for (int m = 0; m < 4; ++m)
#pragma unroll
          for (int n = 0; n < 2; ++n) acc[a][b][m][n] = (f32x4){0.f, 0.f, 0.f, 0.f};
    bf16x8 At[4][2], B0[2][2], B1[2][2];
    const char* cA = (const char*)A + (size_t)brow * lda * 2; const char* cB = (const char*)Bt + (size_t)bcol * ldb * 2;
    G_STAGE(G_SB(0, 0), cB, voffB); G_STAGE(G_SA(0, 0), cA, voffA); G_STAGE(G_SB(0, 1), cB + hstepB, voffB); G_STAGE(G_SA(0, 1), cA + hstepA, voffA);
    if (wr == 1) BAR;
    WAIT_V(4); BAR;
    G_STAGE(G_SB(1, 0), cB + kstep, voffB); G_STAGE(G_SA(1, 0), cA + kstep, voffA); G_STAGE(G_SB(1, 1), cB + hstepB + kstep, voffB);
    WAIT_V(6); BAR;
    for (int t = 0; t < nt - 2; t += 2) {
      const char* a1 = cA + (size_t)(t + 1) * kstep;
      const char* a2 = cA + (size_t)(t + 2) * kstep; const char* b2 = cB + (size_t)(t + 2) * kstep;
      const char* a3 = a2 + kstep; const char* b3 = b2 + kstep;
      G_LDB(B0, 0, 0); SCHED; G_LDA(At, 0, 0); G_STAGE(G_SA(1, 1), a1 + hstepA, voffA);
      WAIT_L(8); BAR; WAIT_L(0); G_MMA(0, 0, At, B0); BAR; SCHED;
      G_LDB(B1, 0, 1); G_STAGE(G_SB(0, 0), b2, voffB);
      BAR; WAIT_L(0); G_MMA(0, 1, At, B1); BAR;
      G_LDA(At, 0, 1); G_STAGE(G_SA(0, 0), a2, voffA);
      BAR; WAIT_L(0); G_MMA(1, 0, At, B0); BAR; SCHED;
      G_STAGE(G_SB(0, 1), b2 + hstepB, voffB);
      WAIT_V(6); BAR; G_MMA(1, 1, At, B1); BAR;
      G_LDB(B0, 1, 0); SCHED; G_LDA(At, 1, 0); G_STAGE(G_SA(0, 1), a2 + hstepA, voffA);
      WAIT_L(8); BAR; WAIT_L(0); G_MMA(0, 0, At, B0); BAR; SCHED;
      G_LDB(B1, 1, 1); G_STAGE(G_SB(1, 0), b3, voffB);
      BAR; WAIT_L(0); G_MMA(0, 1, At, B1); BAR;
      G_LDA(At, 1, 1); G_STAGE(G_SA(1, 0), a3, voffA);
      BAR; WAIT_L(0); G_MMA(1, 0, At, B0); BAR; SCHED;
      G_STAGE(G_SB(1, 1), b3 + hstepB, voffB);
      WAIT_V(6); BAR; G_MMA(1, 1, At, B1); BAR;
    }
    { G_LDB(B0, 0, 0); G_LDA(At, 0, 0); G_STAGE(G_SA(1, 1), cA + (size_t)(nt - 1) * kstep + hstepA, voffA);
      BAR; WAIT_L(0); G_MMA(0, 0, At, B0); BAR;
      G_LDB(B1, 0, 1); BAR; WAIT_L(0); G_MMA(0, 1, At, B1); BAR;
      G_LDA(At, 0, 1); WAIT_V(4); BAR; WAIT_L(0); G_MMA(1, 0, At, B0); G_MMA(1, 1, At, B1); BAR; }
    { G_LDB(B0, 1, 0); G_LDA(At, 1, 0); WAIT_V(2); BAR; WAIT_L(0); G_MMA(0, 0, At, B0); BAR;
      G_LDB(B1, 1, 1); WAIT_V(0); BAR; WAIT_L(0); G_MMA(0, 1, At, B1); BAR;
      G_LDA(At, 1, 1); BAR; WAIT_L(0); G_MMA(1, 0, At, B0); G_MMA(1, 1, At, B1); BAR; }
    if (wr == 0) BAR;
    float rowss[2][4];
    const int lane_e = TIDX & 63, fr_e = lane_e & 15, fq_e = lane_e >> 4;
#pragma unroll
    for (int ai = 0; ai < 2; ++ai)
#pragma unroll
      for (int m = 0; m < 4; ++m) {
        const int row = brow + ai * HALF + wr * 64 + m * 16 + fr_e;
        const float rsc = epi.rowscale(row);
        float ssq = 0.f;
#pragma unroll
        for (int bj = 0; bj < 2; ++bj)
          ssq += epi(row, bcol + bj * HALF + wc * 32, fq_e, acc[ai][bj][m][0] * rsc, acc[ai][bj][m][1] * rsc);
        rowss[ai][m] = ssq;
        __builtin_amdgcn_sched_barrier(0);
      }
    if constexpr (Epi::HAS_SS) {
      float* ssp = epi.ssp_ptr();
      if (ssp) {
        LAS float* red = (LAS float*)lds;
#pragma unroll
        for (int ai = 0; ai < 2; ++ai)
#pragma unroll
          for (int m = 0; m < 4; ++m) {
            float v = rowss[ai][m];
            v += shx(v, 16); v += shx(v, 32);
            if (fq_e == 0) red[(ai * HALF + wr * 64 + m * 16 + fr_e) * 4 + wc] = v;
          }
        __syncthreads();
        { const int t2 = TIDX; if (t2 < 256) { const LAS float* q = red + t2 * 4; ssp[(size_t)(brow + t2) * 8 + pn] = (q[0] + q[1]) + (q[2] + q[3]); } }
      }
    }
    __syncthreads();
  }
}

typedef __bf16 hwbf16x2e __attribute__((ext_vector_type(2)));
typedef float f32x2e __attribute__((ext_vector_type(2)));
DI unsigned pk2e(float lo, float hi) { const f32x2e f = {lo, hi}; const hwbf16x2e r = __builtin_convertvector(f, hwbf16x2e); return __builtin_bit_cast(unsigned, r); }
DI void st_bf16x4(bf16_t* p, f32x4 v) { u32x2 o; o.x = pk2e(v[0], v[1]); o.y = pk2e(v[2], v[3]); *(u32x2*)p = o; }
DI void st_tr4(bf16_t* p, size_t stride, f32x4 v) { p[0] = f2bf(v[0]); p[stride] = f2bf(v[1]); p[2 * stride] = f2bf(v[2]); p[3 * stride] = f2bf(v[3]); }

struct EpiEvenIn {
  static constexpr bool HAS_SS = false;
  const float* ssp_in;
  DI float rowscale(int row) const { const f32x4 a = *(const f32x4*)(ssp_in + (size_t)row * 8), b = *(const f32x4*)(ssp_in + (size_t)row * 8 + 4);
    return rsqrtf((((a[0] + a[1]) + (a[2] + a[3])) + ((b[0] + b[1]) + (b[2] + b[3]))) * (1.f / D_) + EPS_); }
  DI float* ssp_ptr() const { return nullptr; }
  unsigned char* ws;
  DI void one(int row, int c, f32x4 v) const {
    const int b = row >> 12, t = row & 4095;
    if (c < 3072) {
      const int seg = c >> 10, cc = c & 1023, h = cc >> 7, d = cc & 127;
      if (seg < 2) st_bf16x4((bf16_t*)(ws + (seg == 0 ? E_FQ : E_FK)) + ((size_t)(b * 8 + h) * T_ + t) * 128 + d, v);
      else st_tr4((bf16_t*)(ws + E_FVT) + (size_t)(b * 8 + h) * 128 * T_ + (size_t)(t >> 5) * 4096 + d * 32 + ((((t & 31) >> 2) ^ ((d >> 2) & 7)) << 2) + (t & 3), 32, v);
    } else if (c < 4096) { st_bf16x4((bf16_t*)(ws + E_HQ) + (size_t)row * 1024 + (c - 3072), v);
    } else if (c < 5120) { *(f32x4*)((float*)(ws + E_HF) + (size_t)row * 1024 + (c - 4096)) = v;
    } else if (c < 6144) { const int cc = c - 5120, h = cc >> 7, d = cc & 127; st_tr4((bf16_t*)(ws + E_HIT) + (size_t)(b * 8 + h) * 128 * T_ + (size_t)(t >> 5) * 4096 + d * 32 + (t & 31), 32, v);
    } else if (c < 7168) { st_bf16x4((bf16_t*)(ws + E_HG) + (size_t)row * 1024 + (c - 6144), v);
    } else if (c < 7176) { *(f32x4*)((float*)(ws + E_FF) + (size_t)row * 8 + (c - 7168)) = v; }
  }
  DI float operator()(int row, int colbase, int fq, f32x4 v0, f32x4 v1) const { one(row, colbase + 4 * fq, v0); one(row, colbase + 16 + 4 * fq, v1); return 0.f; }
};
struct EpiOddIn {
  static constexpr bool HAS_SS = false;
  const float* ssp_in;
  DI float rowscale(int row) const { const f32x4 a = *(const f32x4*)(ssp_in + (size_t)row * 8), b = *(const f32x4*)(ssp_in + (size_t)row * 8 + 4);
    return rsqrtf((((a[0] + a[1]) + (a[2] + a[3])) + ((b[0] + b[1]) + (b[2] + b[3]))) * (1.f / D_) + EPS_); }
  DI float* ssp_ptr() const { return nullptr; }
  unsigned char* ws;
  DI void one(int row, int c, f32x4 v) const {
    const int b = row >> 12, t = row & 4095;
    if (c < 2048) { const int h = c >> 7, d = c & 127; st_bf16x4((bf16_t*)(ws + O_NQ) + ((size_t)(b * 16 + h) * T_ + t) * 128 + d, v); }
    else if (c < 5120) {
      const int seg = (c - 2048) >> 9, cc = (c - 2048) & 511, g = cc >> 7, d = cc & 127;
      if (seg == 3 || seg == 5) st_tr4((bf16_t*)(ws + (seg == 3 ? O_VST : O_VWT)) + (size_t)(b * 4 + g) * 128 * T_ + (size_t)(t >> 5) * 4096 + d * 32 + ((((t & 31) >> 2) ^ ((d >> 2) & 7)) << 2) + (t & 3), 32, v);
      else { const size_t off = seg == 0 ? O_KC : seg == 1 ? O_VC : seg == 2 ? O_KS : O_KW;
        st_bf16x4((bf16_t*)(ws + off) + ((size_t)(b * 4 + g) * T_ + t) * 128 + d, v); }
    } else if (c < 5168) { *(f32x4*)((float*)(ws + O_GT) + (size_t)row * 48 + (c - 5120)) = v; }
  }
  DI float operator()(int row, int colbase, int fq, f32x4 v0, f32x4 v1) const { one(row, colbase + 4 * fq, v0); one(row, colbase + 16 + 4 * fq, v1); return 0.f; }
};
struct EpiResid {
  static constexpr bool HAS_SS = true;
  const float* src; float* dst; bf16_t* xb; float* ssp;
  DI float rowscale(int) const { return 1.f; }
  DI float* ssp_ptr() const { return ssp; }
  DI float operator()(int row, int colbase, int fq, f32x4 v0, f32x4 v1) const {
    const size_t o = (size_t)row * D_ + colbase + 4 * fq;
    const f32x4 a = *(const f32x4*)(src + o) + v0, b = *(const f32x4*)(src + o + 16) + v1;
    *(f32x4*)(dst + o) = a; *(f32x4*)(dst + o + 16) = b;
    if (xb) { st_bf16x4(xb + o, a); st_bf16x4(xb + o + 16, b); }
    return ((a[0] * a[0] + a[1] * a[1]) + (a[2] * a[2] + a[3] * a[3])) + ((b[0] * b[0] + b[1] * b[1]) + (b[2] * b[2] + b[3] * b[3]));
  }
};
struct EpiMemQ {
  static constexpr bool HAS_SS = false;
  const float* ssp_in;
  DI float rowscale(int row) const { const f32x4 a = *(const f32x4*)(ssp_in + (size_t)row * 8), b = *(const f32x4*)(ssp_in + (size_t)row * 8 + 4);
    return rsqrtf((((a[0] + a[1]) + (a[2] + a[3])) + ((b[0] + b[1]) + (b[2] + b[3]))) * (1.f / D_) + EPS_); }
  DI float* ssp_ptr() const { return nullptr; }
  bf16_t* qm;
  DI float operator()(int row, int colbase, int fq, f32x4 v0, f32x4 v1) const {
    const int b = row >> 12, t = row & 4095, c = colbase + 4 * fq, h = c >> 7, d = c & 127;
    bf16_t* p = qm + ((size_t)(b * 4 + h) * T_ + t) * 128 + d;
    st_bf16x4(p, v0); st_bf16x4(p + 16, v1); return 0.f;
  }
};
struct EpiMemKV {
  static constexpr bool HAS_SS = false;
  DI float rowscale(int) const { return 1.f; }
  DI float* ssp_ptr() const { return nullptr; }
  bf16_t* mk; bf16_t* mvt;
  DI void one(int row, int c0, f32x4 v) const {
    const int b = row >> 8, s = row & 255, l = c0 >> 10, c = c0 & 1023;
    const size_t lo = (size_t)l * 8 * 256 * 128;
    if (c < 512) { const int h = c >> 7, d = c & 127; st_bf16x4(mk + lo + ((size_t)(b * 4 + h) * 256 + s) * 128 + d, v); }
    else { const int cc = c - 512, h = cc >> 7, d = cc & 127;
      st_tr4(mvt + lo + (size_t)(b * 4 + h) * 128 * 256 + (size_t)(s >> 5) * 4096 + d * 32 + ((((s & 31) >> 2) ^ ((d >> 2) & 7)) << 2) + (s & 3), 32, v); }
  }
  DI float operator()(int row, int colbase, int fq, f32x4 v0, f32x4 v1) const { one(row, colbase + 4 * fq, v0); one(row, colbase + 16 + 4 * fq, v1); return 0.f; }
};
struct EpiSwiglu {
  static constexpr bool HAS_SS = false;
  const float* ssp_in;
  DI float rowscale(int row) const { const f32x4 a = *(const f32x4*)(ssp_in + (size_t)row * 8), b = *(const f32x4*)(ssp_in + (size_t)row * 8 + 4);
    return rsqrtf((((a[0] + a[1]) + (a[2] + a[3])) + ((b[0] + b[1]) + (b[2] + b[3]))) * (1.f / D_) + EPS_); }
  DI float* ssp_ptr() const { return nullptr; }
  bf16_t* hid;
  DI float operator()(int row, int colbase, int fq, f32x4 v0, f32x4 v1) const {
    f32x4 r;
#pragma unroll
    for (int e = 0; e < 4; ++e) r[e] = v0[e] * sigmoidf_(v0[e]) * v1[e];
    st_bf16x4(hid + (size_t)row * FFN_ + (colbase >> 1) + 4 * fq, r); return 0.f;
  }
};
DI float gelu_tanh(float x) { const float u = 0.7978845608028654f * (x + 0.044715f * x * x * x); const float e = __expf(2.f * u); const float th = 1.f - 2.f * frcp(e + 1.f); return 0.5f * x * (1.f + th); }
struct EpiF32 {
  static constexpr bool HAS_SS = false;
  DI float rowscale(int) const { return 1.f; }
  DI float* ssp_ptr() const { return nullptr; }
  float* dst; int ld;
  DI float operator()(int row, int colbase, int fq, f32x4 v0, f32x4 v1) const {
    float* q = dst + (size_t)row * ld + colbase + 4 * fq; *(f32x4*)q = v0; *(f32x4*)(q + 16) = v1; return 0.f;
  }
};
struct EpiCmp1 {
  static constexpr bool HAS_SS = false;
  DI float rowscale(int) const { return 1.f; }
  DI float* ssp_ptr() const { return nullptr; }
  bf16_t* hc; const float* bias;
  DI float operator()(int row, int colbase, int fq, f32x4 v0, f32x4 v1) const {
    const int c = colbase + 4 * fq;
    f32x4 b0 = *(const f32x4*)(bias + c), b1 = *(const f32x4*)(bias + c + 16), r0, r1;
#pragma unroll
    for (int e = 0; e < 4; ++e) { r0[e] = gelu_tanh(v0[e] + b0[e]); r1[e] = gelu_tanh(v1[e] + b1[e]); }
    st_bf16x4(hc + (size_t)row * 256 + c, r0); st_bf16x4(hc + (size_t)row * 256 + c + 16, r1); return 0.f;
  }
};
struct EpiCmp2 {
  static constexpr bool HAS_SS = false;
  DI float rowscale(int) const { return 1.f; }
  DI float* ssp_ptr() const { return nullptr; }
  bf16_t* dst; int isv;
  DI void one(int row, int c, f32x4 v) const {
    if (c >= 128) return;
    if (!isv) st_bf16x4(dst + (size_t)row * 128 + c, v);
    else st_tr4(dst + ((size_t)(row >> 8) * 128 + c) * 256 + (row & 255), 256, v);
  }
  DI float operator()(int row, int colbase, int fq, f32x4 v0, f32x4 v1) const { one(row, colbase + 4 * fq, v0); one(row, colbase + 16 + 4 * fq, v1); return 0.f; }
};

struct TDesc { const float* src; const float* src2; const float* rscale; bf16_t* dst; int K, Nsrc, map, k0, n0; };
constexpr int TR_LD = 260;
DI bool decode_tile(const Params& p, int gi, TDesc& d) {
#define TCLS(CNT, KK, NS, ND, MP, SRC, SRC2, RS, RSS, DB, DS) { const int ntn = (ND) / 256, per = ((KK) / 64) * ntn, tot = (CNT) * per; \
    if (gi < tot) { const int l = gi / per, tl = gi % per; d.src = (SRC) + (size_t)l * (KK) * (NS); d.src2 = (SRC2) ? (SRC2) + (size_t)l * (KK) * (NS) : nullptr; \
      d.rscale = (RS) ? (RS) + (size_t)l * (RSS) : nullptr; d.dst = (bf16_t*)(p.ws + (DB) + (size_t)l * (DS)); d.K = (KK); d.Nsrc = (NS); d.map = (MP); \
      d.k0 = (tl / ntn) * 64; d.n0 = (tl % ntn) * 256; return true; } gi -= tot; }
  const float* nul = nullptr;
  TCLS(4, 2048, 5632, N_F13, 2, p.in[28], p.in[29], p.in[4], 2048, W_F13, SZ_F13)
  TCLS(4, 5632, 2048, 2048, 0, p.in[30], nul, nul, 0, W_F2, SZ_F2)
  TCLS(2, 2048, 7176, N_EIN, 1, p.in[6], nul, p.in[2], 4096, W_EIN, SZ_EIN)
  TCLS(2, 2048, 5168, N_OIN, 0, p.in[13], nul, p.in[2] + 2048, 4096, W_OIN, SZ_OIN)
  TCLS(2, 2048, 2048, 2048, 0, p.in[7], nul, nul, 0, W_EOUT, SZ_SQ)
  TCLS(2, 2048, 2048, 2048, 0, p.in[14], nul, nul, 0, W_OOUT, SZ_SQ)
  TCLS(4, 2048, 1024, 1024, 0, p.in[24], nul, p.in[5], 2048, W_MKV, SZ_MKV)
  TCLS(4, 2048, 512, 512, 0, p.in[23], nul, p.in[3], 2048, W_MQ, SZ_MQ)
  TCLS(4, 512, 2048, 2048, 0, p.in[25], nul, nul, 0, W_MO, SZ_MQ)
  TCLS(2, 4096, 256, 256, 0, p.in[18], nul, nul, 0, W_C1, 2 * SZ_C1)
  TCLS(2, 4096, 256, 256, 0, p.in[21], nul, nul, 0, W_C1 + SZ_C1, 2 * SZ_C1)
  TCLS(2, 256, 128, 256, 0, p.in[19], nul, nul, 0, W_C2, 2 * SZ_C2)
  TCLS(2, 256, 128, 256, 0, p.in[22], nul, nul, 0, W_C2 + SZ_C2, 2 * SZ_C2)
#undef TCLS
  return false;
}
DI void tr_load(const TDesc& d, int tid, f32x4 (&v)[8]) {
  const int lane = tid & 63, w = tid >> 6, n = d.n0 + lane * 4;
  const float* s = d.src; int col;
  if (d.map == 0) col = n < d.Nsrc ? n : -1;
  else if (d.map == 1) col = n < 3072 ? n : (n < 7168 ? n + 8 : (n < 7176 ? n - 7168 + 3072 : -1));
  else { col = (n >> 5) * 16 + (n & 15); if (n & 16) s = d.src2; }
#pragma unroll
  for (int r = 0; r < 8; ++r) {
    const int k = d.k0 + w * 8 + r;
    v[r] = col >= 0 ? *(const f32x4*)(s + (size_t)k * d.Nsrc + col) : (f32x4){0.f, 0.f, 0.f, 0.f};
  }
  if (d.rscale) {
#pragma unroll
    for (int r = 0; r < 8; ++r) { const float g = d.rscale[d.k0 + w * 8 + r]; v[r] = v[r] * g; }
  }
}
DI void transpose_jobs(const Params& p) {
  extern __shared__ __attribute__((aligned(16))) char dyn_lds[];
  LAS float* lds = (LAS float*)dyn_lds;
  const int tid = TIDX, lane = tid & 63, w = tid >> 6;
  TDesc da, db; f32x4 va[8], vb[8];
  int gi = blockIdx.x;
  bool ha = decode_tile(p, gi, da); if (ha) tr_load(da, tid, va);
  gi += gridDim.x;
  bool hb = ha && decode_tile(p, gi, db); if (hb) tr_load(db, tid, vb);
#define TR_EMIT(V, D) do { \
    _Pragma("unroll") for (int r = 0; r < 8; ++r) *(LAS f32x4*)(lds + (w * 8 + r) * TR_LD + lane * 4) = V[r]; \
    __syncthreads(); \
    const TDesc cur_ = D; \
    gi += gridDim.x; \
    const bool hn_ = decode_tile(p, gi, D); if (hn_) tr_load(D, tid, V); \
    const int nl = tid & 255; \
    _Pragma("unroll") for (int q = 0; q < 4; ++q) { \
      const int kc = (tid >> 8) + 2 * q; const LAS float* c = lds + (kc * 8) * TR_LD + nl; u32x4 o; \
      o.x = pk2(c[0], c[TR_LD]); o.y = pk2(c[2 * TR_LD], c[3 * TR_LD]); o.z = pk2(c[4 * TR_LD], c[5 * TR_LD]); o.w = pk2(c[6 * TR_LD], c[7 * TR_LD]); \
      *(u32x4*)(cur_.dst + (size_t)(cur_.n0 + nl) * cur_.K + cur_.k0 + kc * 8) = o; } \
    __syncthreads(); \
    h_ = hn_; } while (0)
  while (ha) {
    bool h_;
    TR_EMIT(va, da); ha = h_;
    if (!hb) break;
    TR_EMIT(vb, db); hb = h_;
    if (!ha) { while (hb) { TR_EMIT(vb, db); hb = h_; } break; }
  }
#undef TR_EMIT
}

DI void rmsnorm_rows(const float* __restrict__ x, const float* __restrict__ gain, bf16_t* __restrict__ out, int rows) {
  const int lane = TIDX & 63, gw = blockIdx.x * 8 + (TIDX >> 6), nw = gridDim.x * 8;
  for (int r = gw; r < rows; r += nw) {
    const f32x4* xr = (const f32x4*)(x + (size_t)r * D_) + lane;
    f32x4 v[8]; float s = 0.f;
#pragma unroll
    for (int j = 0; j < 8; ++j) { v[j] = xr[64 * j]; s += v[j][0] * v[j][0] + v[j][1] * v[j][1] + v[j][2] * v[j][2] + v[j][3] * v[j][3]; }
    const float rs = rsqrtf(wave_sum(s) * (1.f / D_) + EPS_);
#pragma unroll
    for (int j = 0; j < 8; ++j) {
      const f32x4 g = gain ? *((const f32x4*)gain + lane + 64 * j) : (f32x4){1.f, 1.f, 1.f, 1.f};
      f32x4 o; for (int e = 0; e < 4; ++e) o[e] = v[j][e] * rs * g[e];
      st_bf16x4(out + (size_t)r * D_ + (lane + 64 * j) * 4, o);
    }
  }
}

DI void xprep_rows(const float* __restrict__ x, bf16_t* __restrict__ xb, float* __restrict__ ssp, int rows) {
  const int tid = TIDX, lane = tid & 63, gw = blockIdx.x * 8 + (tid >> 6), nw = gridDim.x * 8;
  for (int r = gw; r < rows; r += nw) {
    const f32x4* xr = (const f32x4*)(x + (size_t)r * D_) + lane;
    float s = 0.f;
#pragma unroll
    for (int j = 0; j < 8; ++j) { const f32x4 v = xr[64 * j]; s += v[0] * v[0] + v[1] * v[1] + v[2] * v[2] + v[3] * v[3]; st_bf16x4(xb + (size_t)r * D_ + (lane + 64 * j) * 4, v); }
    s = wave_sum(s);
    if (lane < 8) ssp[(size_t)r * 8 + lane] = lane == 0 ? s : 0.f;
  }
}

DI void headnorm_rows(bf16_t* buf, int rows, const float* __restrict__ gain, int item0, int nitems_total) {
  const int lane = TIDX & 63, gw = blockIdx.x * 8 + (TIDX >> 6), nw = gridDim.x * 8;
  const int sub = lane >> 4, l16 = lane & 15;
  (void)item0; (void)nitems_total;
  for (int it = gw; it < rows / 4; it += nw) {
    bf16_t* rp = buf + (size_t)(it * 4 + sub) * 128 + l16 * 8;
    bf16x8 raw = *(const bf16x8*)rp;
    float f[8], s = 0.f;
#pragma unroll
    for (int e = 0; e < 8; ++e) { f[e] = bf2f((bf16_t)raw[e]); s += f[e] * f[e]; }
    s += shx(s, 1); s += shx(s, 2); s += shx(s, 4); s += shx(s, 8);
    const float rs = rsqrtf(s * (1.f / 128.f) + EPS_);
    u32x4 o;
    o.x = pk2(f[0] * rs * gain[l16 * 8 + 0], f[1] * rs * gain[l16 * 8 + 1]); o.y = pk2(f[2] * rs * gain[l16 * 8 + 2], f[3] * rs * gain[l16 * 8 + 3]);
    o.z = pk2(f[4] * rs * gain[l16 * 8 + 4], f[5] * rs * gain[l16 * 8 + 5]); o.w = pk2(f[6] * rs * gain[l16 * 8 + 6], f[7] * rs * gain[l16 * 8 + 7]);
    *(u32x4*)rp = o;
  }
}

struct AttnState { f32x16 o[4]; float m, l; };
DI void attn_init(AttnState& s) { for (int i = 0; i < 4; ++i) s.o[i] = zero16(); s.m = NEG_INF; s.l = 0.f; }
DI int crow(int i, int g) { return (i & 3) + 8 * (i >> 2) + 4 * g; }

DI void load_q_raw(bf16x8 (&qf)[8], const bf16_t* qrow, int g) {
#pragma unroll
  for (int ks = 0; ks < 8; ++ks) qf[ks] = *(const bf16x8*)(qrow + ks * 16 + g * 8);
}
DI void load_q_norm(bf16x8 (&qf)[8], const bf16_t* qrow, int g, const float* __restrict__ gain, float scale) {
  float ss = 0.f;
#pragma unroll
  for (int ks = 0; ks < 8; ++ks) { qf[ks] = *(const bf16x8*)(qrow + ks * 16 + g * 8);
#pragma unroll
    for (int e = 0; e < 8; ++e) { const float f = bf2f((bf16_t)qf[ks][e]); ss += f * f; } }
  ss = xhalf_sum(ss);
  const float rs = rsqrtf(ss * (1.f / 128.f) + EPS_) * scale;
#pragma unroll
  for (int ks = 0; ks < 8; ++ks) {
    const f32x4 g0 = *(const f32x4*)(gain + ks * 16 + g * 8), g1 = *(const f32x4*)(gain + ks * 16 + g * 8 + 4);
    u32x4 o;
    o.x = pk2(bf2f((bf16_t)qf[ks][0]) * rs * g0[0], bf2f((bf16_t)qf[ks][1]) * rs * g0[1]);
    o.y = pk2(bf2f((bf16_t)qf[ks][2]) * rs * g0[2], bf2f((bf16_t)qf[ks][3]) * rs * g0[3]);
    o.z = pk2(bf2f((bf16_t)qf[ks][4]) * rs * g1[0], bf2f((bf16_t)qf[ks][5]) * rs * g1[1]);
    o.w = pk2(bf2f((bf16_t)qf[ks][6]) * rs * g1[2], bf2f((bf16_t)qf[ks][7]) * rs * g1[3]);
    qf[ks] = __builtin_bit_cast(bf16x8, o);
  }
}
DI f32x16 score_tile(const bf16x8 (&qf)[8], const bf16_t* __restrict__ Kp  , unsigned koff  ) {
  f32x16 acc = zero16();
  const char* kr = (const char*)Kp;
#pragma unroll
  for (int ks = 0; ks < 8; ++ks) { const bf16x8 a = *(const bf16x8*)(kr + (size_t)(koff + ks * 32)); acc = mfma32(a, qf[ks], acc); }
  return acc;
}
typedef __bf16 hwbf16x2 __attribute__((ext_vector_type(2)));
typedef float f32x2 __attribute__((ext_vector_type(2)));
DI unsigned pk2h(float lo, float hi) { const f32x2 f = {lo, hi}; const hwbf16x2 r = __builtin_convertvector(f, hwbf16x2); return __builtin_bit_cast(unsigned, r); }
DI bf16x8 pack8(const float* p) { u32x4 o; o.x = pk2h(p[0], p[1]); o.y = pk2h(p[2], p[3]); o.z = pk2h(p[4], p[5]); o.w = pk2h(p[6], p[7]); return __builtin_bit_cast(bf16x8, o); }
DI void pv_tile(f32x16 (&o)[4], const bf16x8 (&pf)[2], const bf16_t* __restrict__ VTp  , size_t ldv, unsigned voff  ) {
#pragma unroll
  for (int vt = 0; vt < 4; ++vt) {
    const char* vr = (const char*)(VTp + (size_t)(vt * 32) * ldv);
#pragma unroll
    for (int s = 0; s < 2; ++s) {
      const s16x4 lo = *(const s16x4*)(vr + (size_t)(voff + 32 * s)), hi = *(const s16x4*)(vr + (size_t)(voff + 32 * s + 16));
      const bf16x8 a = __builtin_shufflevector(lo, hi, 0, 1, 2, 3, 4, 5, 6, 7);
      o[vt] = mfma32(a, pf[s], o[vt]);
    }
  }
}
DI void softmax_step(AttnState& st, float (&sc)[16], const bf16_t* __restrict__ VTp, size_t ldv, unsigned voff) {
  float mx = st.m;
#pragma unroll
  for (int i = 0; i < 16; ++i) mx = fmaxf(mx, sc[i]);
  mx = xhalf_max(mx);
  const float ms = (mx == NEG_INF) ? 0.f : mx;
  const float alpha = fexp2(st.m - ms);
  st.m = mx;
  float ps = 0.f;
#pragma unroll
  for (int i = 0; i < 16; ++i) { sc[i] = fexp2(sc[i] - ms); ps += sc[i]; }
  st.l = st.l * alpha + ps;
#pragma unroll
  for (int vt = 0; vt < 4; ++vt)
#pragma unroll
    for (int i = 0; i < 16; ++i) st.o[vt][i] *= alpha;
  bf16x8 pf[2]; pf[0] = pack8(sc); pf[1] = pack8(sc + 8);
  pv_tile(st.o, pf, VTp, ldv, voff);
}
DI float attn_inv_l(const AttnState& st) { const float l = xhalf_sum(st.l); return l > 0.f ? frcp(l) : 0.f; }
DI void store_o(const f32x16 (&o)[4], float scale, bf16_t* orow, int g) {
#pragma unroll
  for (int vt = 0; vt < 4; ++vt)
#pragma unroll
    for (int q = 0; q < 4; ++q) {
      f32x4 v; for (int e = 0; e < 4; ++e) v[e] = o[vt][q * 4 + e] * scale;
      st_bf16x4(orow + vt * 32 + q * 8 + 4 * g, v);
    }
}

constexpr int AT_STAGE = 16384;
#define AT_WAIT_V(n) asm volatile("s_waitcnt vmcnt(" #n ")" ::: "memory")
#define AT_WAIT_L0() asm volatile("s_waitcnt lgkmcnt(0)" ::: "memory")
#define AT_BAR() __builtin_amdgcn_s_barrier()
struct LaneKV {
  unsigned ksrc, vsrc, ldsw;
  unsigned kx, xh, vrow, vo[4];
};
DI void lanekv_init(LaneKV& L, int tid, int wid) {
  const int lane = tid & 63, lr = lane & 31, g = lane >> 5, r = tid >> 4, pos = tid & 15;
  L.ksrc = (unsigned)(r * 256 + ((pos ^ (r & 15)) << 4)); L.vsrc = (unsigned)tid * 16u; L.ldsw = (unsigned)wid * 1024u;
  L.kx = (unsigned)(lr * 256 + ((g ^ (lr & 1)) << 4)); L.xh = (unsigned)((lr & 15) >> 1); L.vrow = (unsigned)lr * 64u;
  const int y = (lr >> 2) & 7;
#pragma unroll
  for (int q = 0; q < 4; ++q) L.vo[q] = (unsigned)(((g + 2 * q) ^ y) << 3);
}
DI void kv_issue(LAS unsigned char* st, const bf16_t* Kt, const bf16_t* Vt, const LaneKV& L) {
  __builtin_amdgcn_global_load_lds((const unsigned*)((const char*)Kt + L.ksrc), (LAS unsigned*)(st + L.ldsw), 16, 0, 0);
  __builtin_amdgcn_global_load_lds((const unsigned*)((const char*)Vt + L.vsrc), (LAS unsigned*)(st + 8192 + L.ldsw), 16, 0, 0);
}
DI f32x16 score_tile_lds(const bf16x8 (&qf)[8], const LAS unsigned char* st, const LaneKV& L) {
  f32x16 acc = zero16();
#pragma unroll
  for (int ks = 0; ks < 8; ++ks) { const bf16x8 a = *(const LAS bf16x8*)(st + L.kx + (((unsigned)ks ^ L.xh) << 5)); acc = mfma32(a, qf[ks], acc); }
  return acc;
}
DI void pv_tile_lds(f32x16 (&o)[4], const bf16x8 (&pf)[2], const LAS unsigned char* stv, const LaneKV& L) {
#pragma unroll
  for (int vt = 0; vt < 4; ++vt) {
#pragma unroll
    for (int s2 = 0; s2 < 2; ++s2) {
      const s16x4 lo = *(const LAS s16x4*)(stv + vt * 2048 + L.vrow + L.vo[2 * s2]), hi = *(const LAS s16x4*)(stv + vt * 2048 + L.vrow + L.vo[2 * s2 + 1]);
      const bf16x8 a = __builtin_shufflevector(lo, hi, 0, 1, 2, 3, 4, 5, 6, 7);
      o[vt] = mfma32(a, pf[s2], o[vt]);
    }
  }
}
DI void softmax_step_lds(AttnState& st, float (&sc)[16], const LAS unsigned char* stv, const LaneKV& L) {
  float mx = st.m;
#pragma unroll
  for (int i = 0; i < 16; ++i) mx = fmaxf(mx, sc[i]);
  mx = xhalf_max(mx);
  const float ms = (mx == NEG_INF) ? 0.f : mx;
  if (__builtin_amdgcn_ballot_w64(mx > st.m) != 0ull) {
    const float alpha = fexp2(st.m - ms);
    st.l *= alpha;
#pragma unroll
    for (int vt = 0; vt < 4; ++vt)
#pragma unroll
      for (int i = 0; i < 16; ++i) st.o[vt][i] *= alpha;
  }
  st.m = mx;
  float ps = 0.f;
#pragma unroll
  for (int i = 0; i < 16; ++i) { sc[i] = fexp2(sc[i] - ms); ps += sc[i]; }
  st.l += ps;
  bf16x8 pf[2]; pf[0] = pack8(sc); pf[1] = pack8(sc + 8);
  pv_tile_lds(st.o, pf, stv, L);
}

DI void softmax_step2_lds(AttnState& st, float (&sa)[16], float (&sb)[16], const LAS unsigned char* stva, const LAS unsigned char* stvb, const LaneKV& L) {
  float mx = st.m;
#pragma unroll
  for (int i = 0; i < 16; ++i) mx = fmaxf(mx, fmaxf(sa[i], sb[i]));
  mx = xhalf_max(mx);
  const float ms = (mx == NEG_INF) ? 0.f : mx;
  if (__builtin_amdgcn_ballot_w64(mx > st.m) != 0ull) {
    const float alpha = fexp2(st.m - ms);
    st.l *= alpha;
#pragma unroll
    for (int vt = 0; vt < 4; ++vt)
#pragma unroll
      for (int i = 0; i < 16; ++i) st.o[vt][i] *= alpha;
  }
  st.m = mx;
  float ps = 0.f;
#pragma unroll
  for (int i = 0; i < 16; ++i) { sa[i] = fexp2(sa[i] - ms); sb[i] = fexp2(sb[i] - ms); ps += sa[i] + sb[i]; }
  st.l += ps;
  bf16x8 pfa[2], pfb[2]; pfa[0] = pack8(sa); pfa[1] = pack8(sa + 8); pfb[0] = pack8(sb); pfb[1] = pack8(sb + 8);
  __builtin_amdgcn_sched_barrier(0);
  pv_tile_lds(st.o, pfa, stva, L);
  __builtin_amdgcn_sched_barrier(0);
  pv_tile_lds(st.o, pfb, stvb, L);
  __builtin_amdgcn_sched_barrier(0);
}

DI void memattn_block(const Params& p, int layer, int bh, int tile4) {
  extern __shared__ __attribute__((aligned(16))) char dyn_lds[];
  LAS unsigned char* ldsb = (LAS unsigned char*)dyn_lds;
  const int tid = TIDX, wid = __builtin_amdgcn_readfirstlane(tid >> 6), lane = tid & 63, lr = lane & 31, g = lane >> 5;
  const int tile = tile4 * 4 + (wid & 3);
  const int tq = tile * 32 + lr, b = bh >> 2, h = bh & 3;
  const bf16_t* Kb = (const bf16_t*)(p.ws + A_MEMK) + ((size_t)layer * 8 + bh) * 256 * 128;
  const bf16_t* VT = (const bf16_t*)(p.ws + A_MEMVT) + ((size_t)layer * 8 + bh) * 128 * 256;
  LaneKV L; lanekv_init(L, tid, wid);
#pragma unroll
  for (int kt = 0; kt < 8; ++kt) kv_issue(ldsb + kt * AT_STAGE, Kb + (size_t)kt * 4096, VT + (size_t)kt * 4096, L);
  bf16x8 qf[8];
  if (wid < 4) {
    const size_t mrow = (size_t)b * T_ + tq;
    const float* qp = (const float*)(p.ws + A_SCR) + mrow * 512 + h * 128 + g * 8;
    const float* sp8 = (const float*)(p.ws + A_SSP) + SZ_SSP / 4 + mrow * 8;
    const f32x4 s0 = *(const f32x4*)sp8, s1 = *(const f32x4*)(sp8 + 4);
    const float rr = rsqrtf((((s0[0] + s0[1]) + (s0[2] + s0[3])) + ((s1[0] + s1[1]) + (s1[2] + s1[3]))) * (1.f / D_) + EPS_);
    f32x4 qa[8], qb[8]; float ss = 0.f;
#pragma unroll
    for (int ks = 0; ks < 8; ++ks) {
      f32x4 a = *(const f32x4*)(qp + ks * 16), c = *(const f32x4*)(qp + ks * 16 + 4);
#pragma unroll
      for (int sp = 1; sp < 4; ++sp) { a += *(const f32x4*)(qp + (size_t)sp * M_ * 512 + ks * 16); c += *(const f32x4*)(qp + (size_t)sp * M_ * 512 + ks * 16 + 4); }
      a = a * rr; c = c * rr; qa[ks] = a; qb[ks] = c;
      ss += (a[0] * a[0] + a[1] * a[1]) + (a[2] * a[2] + a[3] * a[3]) + (c[0] * c[0] + c[1] * c[1]) + (c[2] * c[2] + c[3] * c[3]);
    }
    ss = xhalf_sum(ss);
    const float rs = rsqrtf(ss * (1.f / 128.f) + EPS_) * (ATTN_SCALE * LOG2E);
    const float* gain = p.in[26] + layer * 128 + g * 8;
#pragma unroll
    for (int ks = 0; ks < 8; ++ks) {
      const f32x4 g0 = *(const f32x4*)(gain + ks * 16), g1 = *(const f32x4*)(gain + ks * 16 + 4);
      float v[8];
#pragma unroll
      for (int i = 0; i < 4; ++i) { v[i] = qa[ks][i] * rs * g0[i]; v[4 + i] = qb[ks][i] * rs * g1[i]; }
      qf[ks] = pack8(v);
    }
  }
  AT_WAIT_V(0);
  AT_BAR();
  if (wid < 4) {
    AttnState st; attn_init(st);
#pragma unroll 1
    for (int kt = 0; kt < 8; ++kt) {
      const LAS unsigned char* sg = ldsb + kt * AT_STAGE;
      f32x16 acc = score_tile_lds(qf, sg, L);
      float sc[16];
#pragma unroll
      for (int i = 0; i < 16; ++i) sc[i] = acc[i];
      softmax_step_lds(st, sc, sg + 8192, L);
    }
    const float inv = attn_inv_l(st);
    store_o(st.o, inv, (bf16_t*)(p.ws + A_MAO) + (size_t)(b * T_ + tq) * 512 + h * 128, g);
  }
  AT_WAIT_L0();
  __syncthreads();
}

DI void fox_block(const Params& p, int e, int bh, int j) {
  extern __shared__ __attribute__((aligned(16))) char dyn_lds[];
  LAS unsigned char* lds = (LAS unsigned char*)dyn_lds;
  LAS float* c2l = (LAS float*)(lds + 4 * AT_STAGE);
  const int tid = TIDX, wid = __builtin_amdgcn_readfirstlane(tid >> 6), lane = tid & 63, lr = lane & 31, g = lane >> 5;
  const int kidx = wid < 4 ? wid : 11 - wid, tile = j + 16 * kidx, nsteps = (j + 114) >> 1;
  const int tq = tile * 32 + lr, b = bh >> 3, h = bh & 7;
  const bf16_t* Q = (const bf16_t*)(p.ws + E_FQ) + (size_t)bh * T_ * 128;
  const bf16_t* Kb = (const bf16_t*)(p.ws + E_FK) + (size_t)bh * T_ * 128;
  const bf16_t* VT = (const bf16_t*)(p.ws + E_FVT) + (size_t)bh * 128 * T_;
  const float* c2 = (const float*)(p.ws + E_FC) + (size_t)bh * T_;
  LaneKV L; lanekv_init(L, tid, wid);
  kv_issue(lds, Kb, VT, L);
  kv_issue(lds + AT_STAGE, Kb + 4096, VT + 4096, L);
  { const int nc = nsteps * 64 < T_ ? nsteps * 64 : T_; for (int i = tid; i < nc; i += NTH) c2l[i] = c2[i]; }
  bf16x8 qf[8];
  load_q_norm(qf, Q + (size_t)tq * 128, g, p.in[9] + e * 128, ATTN_SCALE * LOG2E);
  AttnState st; attn_init(st);
  AT_WAIT_L0();
#pragma unroll 1
  for (int i = 0; i < nsteps; ++i) {
    AT_WAIT_V(0);
    AT_BAR();
    if (i + 1 < nsteps) {
      LAS unsigned char* nx = lds + ((i + 1) & 1) * 2 * AT_STAGE;
      kv_issue(nx, Kb + (size_t)(2 * i + 2) * 4096, VT + (size_t)(2 * i + 2) * 4096, L);
      kv_issue(nx + AT_STAGE, Kb + (size_t)(2 * i + 3) * 4096, VT + (size_t)(2 * i + 3) * 4096, L);
    }
    const int ka = 2 * i, kb = ka + 1;
    const LAS unsigned char* sg = lds + (i & 1) * 2 * AT_STAGE;
    if (kb <= tile) {
      f32x16 acca = score_tile_lds(qf, sg, L); __builtin_amdgcn_sched_barrier(0); f32x16 accb = score_tile_lds(qf, sg + AT_STAGE, L); __builtin_amdgcn_sched_barrier(0);
      float sa[16], sb[16];
#pragma unroll
      for (int q = 0; q < 4; ++q) {
        const f32x4 ca = *(const LAS f32x4*)(c2l + ka * 32 + 8 * q + 4 * g), cb = *(const LAS f32x4*)(c2l + kb * 32 + 8 * q + 4 * g);
#pragma unroll
        for (int e2 = 0; e2 < 4; ++e2) { sa[q * 4 + e2] = acca[q * 4 + e2] - ca[e2]; sb[q * 4 + e2] = accb[q * 4 + e2] - cb[e2]; }
      }
      if (kb == tile) {
#pragma unroll
        for (int q = 0; q < 16; ++q) sb[q] = (crow(q, g) <= lr) ? sb[q] : NEG_INF;
      }
      softmax_step2_lds(st, sa, sb, sg + 8192, sg + AT_STAGE + 8192, L);
    } else if (ka <= tile) {
      f32x16 acc = score_tile_lds(qf, sg, L);
      float sc[16];
#pragma unroll
      for (int q = 0; q < 4; ++q) {
        const f32x4 cs = *(const LAS f32x4*)(c2l + ka * 32 + 8 * q + 4 * g);
#pragma unroll
        for (int e2 = 0; e2 < 4; ++e2) sc[q * 4 + e2] = acc[q * 4 + e2] - cs[e2];
      }
#pragma unroll
      for (int q = 0; q < 16; ++q) sc[q] = (crow(q, g) <= lr) ? sc[q] : NEG_INF;
      softmax_step_lds(st, sc, sg + 8192, L);
    }
  }
  const float inv = attn_inv_l(st);
  store_o(st.o, inv, (bf16_t*)(p.ws + A_MIXO) + (size_t)(b * T_ + tq) * D_ + h * 128, g);
  AT_WAIT_L0();
  __syncthreads();
}

DI void fox_task(const Params& p, int e, int bh, int tile) {
  const int lane = TIDX & 63, lr = lane & 31, g = lane >> 5;
  const unsigned koff = (unsigned)(lr * 128 + g * 8) * 2u, voffT = (unsigned)(lr * 32 + 4 * g) * 2u, voff256 = (unsigned)(lr * 256 + 4 * g) * 2u; (void)koff; (void)voffT; (void)voff256;
  const int t0 = tile * 32, tq = t0 + lr, b = bh >> 3, h = bh & 7;
  const bf16_t* Q = (const bf16_t*)(p.ws + E_FQ) + (size_t)bh * T_ * 128;
  const bf16_t* Kb = (const bf16_t*)(p.ws + E_FK) + (size_t)bh * T_ * 128;
  const bf16_t* VT = (const bf16_t*)(p.ws + E_FVT) + (size_t)bh * 128 * T_;
  const float* c2 = (const float*)(p.ws + E_FC) + (size_t)bh * T_;
  bf16x8 qf[8];
  load_q_norm(qf, Q + (size_t)tq * 128, g, p.in[9] + e * 128, ATTN_SCALE * LOG2E);
  const float ct = c2[tq];
  AttnState st; attn_init(st);
  for (int kt = 0; kt <= tile; ++kt) {
    const int key0 = kt * 32;
    f32x16 acc = score_tile(qf, Kb + (size_t)key0 * 128, koff);
    float sc[16];
#pragma unroll
    for (int q = 0; q < 4; ++q) {
      const f32x4 cs = *(const f32x4*)(c2 + key0 + 8 * q + 4 * g);
#pragma unroll
      for (int e2 = 0; e2 < 4; ++e2) {
        const int i = q * 4 + e2; const int key = key0 + crow(i, g);
        const float s = acc[i] + (ct - cs[e2]);
        sc[i] = (key <= tq) ? s : NEG_INF;
      }
    }
    softmax_step(st, sc, VT + (size_t)key0 * 128, 32, voffT);
  }
  const float inv = attn_inv_l(st);
  store_o(st.o, inv, (bf16_t*)(p.ws + A_MIXO) + (size_t)(b * T_ + tq) * D_ + h * 128, g);
}

DI void hgrn_prep(const Params& p, int e) {
  const float* HF = (const float*)(p.ws + E_HF);
  const bf16_t* HQ = (const bf16_t*)(p.ws + E_HQ);
  bf16_t* QT = (bf16_t*)(p.ws + E_QT); bf16_t* KT = (bf16_t*)(p.ws + E_KT); bf16_t* QS = (bf16_t*)(p.ws + E_QS); bf16_t* KUT = (bf16_t*)(p.ws + E_KUT);
  float* DL = (float*)(p.ws + E_DL);
  const float* lg = p.in[11];
  for (int idx = blockIdx.x * NTH + TIDX; idx < 16 * 64 * 128; idx += gridDim.x * NTH) {
    const int k = idx & 127, c = (idx >> 7) & 63, bh = idx >> 13, b = bh >> 3, h = bh & 7, col = h * 128 + k;
    const float lb = (e == 0) ? 0.f : 1.f / (1.f + __expf(lg[col] - lg[1024 + col]));
    const size_t m0 = (size_t)b * T_ + c * 64;
    float bsum = 0.f, bmid = 0.f;
#pragma unroll 1
    for (int t16 = 0; t16 < 4; ++t16) {
      float zc[16];
#pragma unroll
      for (int tt = 0; tt < 16; ++tt) zc[tt] = HF[(m0 + t16 * 16 + tt) * 1024 + col];
#pragma unroll
      for (int tt = 0; tt < 16; ++tt) {
        const float z = zc[tt];
        const float a = __expf(-fabsf(z)), ri = __builtin_amdgcn_rcpf(1.f + a);
        const float sg = z >= 0.f ? ri : a * ri;
        bsum += (e == 0) ? (fminf(z, 0.f) - __logf(1.f + a)) : __logf(lb + (1.f - lb) * sg);
      }
      if (t16 == 1) bmid = bsum;
    }
    const float blast = bsum;
    DL[((size_t)bh * 64 + c) * 128 + k] = __expf(blast);
    const float emid = __expf(bmid), elast = __expf(blast - bmid);
    bsum = 0.f;
    const size_t hb = ((size_t)bh * T_ + c * 64) * 128 + k;
    bf16_t* kut = KUT + (((size_t)bh * 64 + c) * 128 + k) * 64;
#pragma unroll 1
    for (int t8 = 0; t8 < 8; ++t8) {
      float ku[8], zc[8], qc[8];
#pragma unroll
      for (int tt = 0; tt < 8; ++tt) { zc[tt] = HF[(m0 + t8 * 8 + tt) * 1024 + col]; qc[tt] = bf2f(HQ[(m0 + t8 * 8 + tt) * 1024 + col]); }
#pragma unroll
      for (int tt = 0; tt < 8; ++tt) {
        const int t = t8 * 8 + tt;
        const float z = zc[tt];
        const float a = __expf(-fabsf(z)), ri = __builtin_amdgcn_rcpf(1.f + a);
        const float sg = z >= 0.f ? ri : a * ri, sgn = z >= 0.f ? a * ri : ri;
        bsum += (e == 0) ? (fminf(z, 0.f) - __logf(1.f + a)) : __logf(lb + (1.f - lb) * sg);
        const float kh = (1.f - lb) * sgn;
        const float qv = qc[tt]; const float qh = qv * __builtin_amdgcn_rcpf(1.f + __expf(-qv));
        const float ed = __expf(bsum - bmid), edi = __builtin_amdgcn_rcpf(ed);
        QT[hb + (size_t)t * 128] = f2bf(qh * ed);
        KT[hb + (size_t)t * 128] = f2bf(kh * edi);
        QS[hb + (size_t)t * 128] = f2bf(qh * ed * emid);
        ku[tt] = kh * edi * elast;
      }
      *(bf16x8*)(kut + t8 * 8) = pack8(ku);
    }
  }
}
DI void fox_cumsum(const Params& p, int e) {
  extern __shared__ __attribute__((aligned(16))) char dyn_lds[];
  LAS float* wsum = (LAS float*)dyn_lds;
  const int tid = TIDX, lane = tid & 63, w = tid >> 6;
  for (int bh = blockIdx.x; bh < 16; bh += gridDim.x) {
    const int b = bh >> 3, h = bh & 7;
    const float* FF = (const float*)(p.ws + E_FF) + (size_t)b * T_ * 8 + h;
    float* FC = (float*)(p.ws + E_FC) + (size_t)bh * T_;
    const float bias = p.in[8][e * 8 + h];
    float v[8], s = 0.f;
#pragma unroll
    for (int i = 0; i < 8; ++i) { const float x = FF[(size_t)(tid * 8 + i) * 8] + bias; s += fminf(x, 0.f) - log1pf(__expf(-fabsf(x))); v[i] = s; }
    float incl = s;
#pragma unroll
    for (int o = 1; o < 64; o <<= 1) { const float u = shidx(incl, lane - o); if (lane >= o) incl += u; }
    if (lane == 63) wsum[w] = incl;
    __syncthreads();
    float base = incl - s;
    for (int q = 0; q < w; ++q) base += wsum[q];
#pragma unroll
    for (int i = 0; i < 8; ++i) FC[tid * 8 + i] = (base + v[i]) * LOG2E;
    __syncthreads();
  }
}
DI void hgrn_u_task(const Params& p, int bh, int c, int vt) {
  const int lane = TIDX & 63, lr = lane & 31, g = lane >> 5;
  const bf16_t* VT = (const bf16_t*)(p.ws + E_HIT) + (size_t)bh * 128 * T_ + (size_t)(c * 2) * 4096 + (vt * 32 + lr) * 32 + g * 8;
  const bf16_t* KUT = (const bf16_t*)(p.ws + E_KUT) + (((size_t)bh * 64 + c) * 128 + lr) * 64 + g * 8;
  f32x16 acc[4];
#pragma unroll
  for (int kt = 0; kt < 4; ++kt) acc[kt] = zero16();
#pragma unroll
  for (int ts = 0; ts < 4; ++ts) {
    const bf16x8 a = *(const bf16x8*)(VT + (ts >> 1) * 4096 + (ts & 1) * 16);
#pragma unroll
    for (int kt = 0; kt < 4; ++kt) { const bf16x8 bb = *(const bf16x8*)(KUT + (size_t)kt * 32 * 64 + ts * 16); acc[kt] = mfma32(a, bb, acc[kt]); }
  }
  bf16_t* U = (bf16_t*)(p.ws + E_U) + ((size_t)bh * 64 + c) * 128 * 128;
#pragma unroll
  for (int kt = 0; kt < 4; ++kt)
#pragma unroll
    for (int i = 0; i < 16; ++i) U[(size_t)(vt * 32 + crow(i, g)) * 128 + kt * 32 + lr] = f2bf(acc[kt][i]);
}
DI void hgrn_scan(const Params& p) {
  const bf16_t* U = (const bf16_t*)(p.ws + E_U); const float* DL = (const float*)(p.ws + E_DL); bf16_t* ST = (bf16_t*)(p.ws + E_ST);
  for (int idx = blockIdx.x * NTH + TIDX; idx < 16 * 128 * 128; idx += gridDim.x * NTH) {
    const int k = idx & 127, v = (idx >> 7) & 127, bh = idx >> 14;
    float S = 0.f;
#pragma unroll 8
    for (int c = 0; c < 64; ++c) {
      const size_t o = (((size_t)bh * 64 + c) * 128 + v) * 128 + k;
      ST[o] = f2bf(S);
      S = DL[((size_t)bh * 64 + c) * 128 + k] * S + bf2f(U[o]);
    }
  }
}
DI void hgrn_out_task(const Params& p, int e, int bh, int c, int tt) {
  const int lane = TIDX & 63, lr = lane & 31, g = lane >> 5, b = bh >> 3, h = bh & 7;
  const unsigned koff = (unsigned)(lr * 128 + g * 8) * 2u, voffT = (unsigned)(lr * 32 + 4 * g) * 2u, voff256 = (unsigned)(lr * 256 + 4 * g) * 2u; (void)koff; (void)voffT; (void)voff256;
  const size_t rowbase = (size_t)bh * T_ + c * 64;
  const bf16_t* QT = (const bf16_t*)(p.ws + E_QT) + rowbase * 128;
  const bf16_t* KT = (const bf16_t*)(p.ws + E_KT) + rowbase * 128;
  const bf16_t* QS = (const bf16_t*)(p.ws + E_QS) + rowbase * 128;
  const bf16_t* VT = (const bf16_t*)(p.ws + E_HIT) + (size_t)bh * 128 * T_ + (size_t)(c * 2) * 4096;
  const bf16_t* ST = (const bf16_t*)(p.ws + E_ST) + ((size_t)bh * 64 + c) * 128 * 128;
  f32x16 o[4];
#pragma unroll
  for (int i = 0; i < 4; ++i) o[i] = zero16();
  bf16x8 qf[8];
  load_q_raw(qf, QT + (size_t)(tt * 32 + lr) * 128, g);
  for (int st = 0; st <= tt; ++st) {
    f32x16 acc = score_tile(qf, KT + (size_t)st * 32 * 128, koff);
    float a[16];
#pragma unroll
    for (int i = 0; i < 16; ++i) a[i] = (st < tt || crow(i, g) <= lr) ? acc[i] : 0.f;
    bf16x8 pf[2]; pf[0] = pack8(a); pf[1] = pack8(a + 8);
    pv_tile(o, pf, VT + (size_t)st * 4096, 32, voffT);
  }
  load_q_raw(qf, QS + (size_t)(tt * 32 + lr) * 128, g);
#pragma unroll
  for (int vt = 0; vt < 4; ++vt) {
    const bf16_t* sr = ST + (size_t)(vt * 32 + lr) * 128 + g * 8;
#pragma unroll
    for (int ks = 0; ks < 8; ++ks) { const bf16x8 a = *(const bf16x8*)(sr + ks * 16); o[vt] = mfma32(a, qf[ks], o[vt]); }
  }
  float ss = 0.f;
#pragma unroll
  for (int vt = 0; vt < 4; ++vt)
#pragma unroll
    for (int i = 0; i < 16; ++i) ss += o[vt][i] * o[vt][i];
  ss = xhalf_sum(ss);
  const float rs = rsqrtf(ss * (1.f / 128.f) + EPS_);
  const size_t m = (size_t)b * T_ + c * 64 + tt * 32 + lr;
  const bf16_t* hg = (const bf16_t*)(p.ws + E_HG) + m * 1024 + h * 128;
  const float* og = p.in[12] + e * 128;
  bf16_t* orow = (bf16_t*)(p.ws + A_MIXO) + m * D_ + 1024 + h * 128;
#pragma unroll
  for (int vt = 0; vt < 4; ++vt)
#pragma unroll
    for (int q = 0; q < 4; ++q) {
      const int d0 = vt * 32 + q * 8 + 4 * g;
      const s16x4 gv = *(const s16x4*)(hg + d0); const f32x4 gn = *(const f32x4*)(og + d0);
      f32x4 v;
#pragma unroll
      for (int e2 = 0; e2 < 4; ++e2) { const float gg = bf2f((bf16_t)gv[e2]); v[e2] = o[vt][q * 4 + e2] * rs * gn[e2] * (gg * frcp(1.f + __expf(-gg))); }
      st_bf16x4(orow + d0, v);
    }
}

constexpr int PS_LD = 260;
constexpr int NSA_PS_OFF = 65536, NSA_ML_OFF = NSA_PS_OFF + 2 * 32 * PS_LD * 4, NSA_SEL_OFF = NSA_ML_OFF + 8 * 32 * 2 * 4, NSA_LDS = NSA_SEL_OFF + 2 * 32 * 8;
DI void stash_set(LAS unsigned* stw, const f32x16 (&o)[4], float f) {
#pragma unroll
  for (int vt = 0; vt < 4; ++vt)
#pragma unroll
    for (int i = 0; i < 8; ++i) stw[(vt * 8 + i) * 64] = pk2(o[vt][2 * i] * f, o[vt][2 * i + 1] * f);
}
DI void stash_add(LAS unsigned* stw, const f32x16 (&o)[4], float f) {
#pragma unroll
  for (int vt = 0; vt < 4; ++vt)
#pragma unroll
    for (int i = 0; i < 8; ++i) { const unsigned w = stw[(vt * 8 + i) * 64];
      stw[(vt * 8 + i) * 64] = pk2(__uint_as_float(w << 16) + o[vt][2 * i] * f, __uint_as_float(w & 0xffff0000u) + o[vt][2 * i + 1] * f); }
}
struct NsaCtx { int b, gk, tile64, o_idx; };
#define NSA_LANE_CTX() \
  const int tidx = TIDX; \
  const int wave = __builtin_amdgcn_readfirstlane(tidx >> 6), lane = tidx & 63, lr = lane & 31, g = lane >> 5; \
  const int sub = wave >> 2, j = wave & 3, h = c.gk * 4 + j; \
  const int t0 = c.tile64 * 64 + sub * 32, tq = t0 + lr; \
  const unsigned koff = (unsigned)(lr * 128 + g * 8) * 2u, voffT = (unsigned)(lr * 32 + 4 * g) * 2u, voff256 = (unsigned)(lr * 256 + 4 * g) * 2u; \
  const size_t kvh = (size_t)(c.b * 4 + c.gk); \
  const float slope2 = fexp2(-0.5f * (float)(h + 1)) * LOG2E; \
  const int thr = __builtin_amdgcn_readfirstlane((int)(200.f / slope2) + 1);     \
  LAS unsigned char* ldsb = (LAS unsigned char*)dyn_lds; \
  LAS float* psum = (LAS float*)(ldsb + NSA_PS_OFF); LAS float* ml = (LAS float*)(ldsb + NSA_ML_OFF); \
  LAS unsigned long long* sel = (LAS unsigned long long*)(ldsb + NSA_SEL_OFF); \
  LAS unsigned* stw = (LAS unsigned*)ldsb + wave * 32 * 64 + lane; \
  const bf16_t* NQ = (const bf16_t*)(p.ws + O_NQ); const float* qgain = p.in[15] + c.o_idx * 128; \
  (void)koff; (void)voffT; (void)voff256; (void)kvh; (void)slope2; (void)thr; (void)psum; (void)ml; (void)sel; (void)stw; (void)NQ; (void)qgain; (void)sub; (void)j; (void)h; (void)tq; (void)t0

DI void nsa_cmp1(const Params& p, const NsaCtx c) {
  extern __shared__ __attribute__((aligned(16))) char dyn_lds[];
  NSA_LANE_CTX();
  const bf16_t* KCMP = (const bf16_t*)(p.ws + O_KCMP) + kvh * 256 * 128;
  const bf16_t* VCMPT = (const bf16_t*)(p.ws + O_VCMPT) + kvh * 128 * 256;
  const float ftq = (float)tq;
  const int ntile_c = (t0 >> 4) / 32 + 1;
  bf16x8 qf[8];
  load_q_norm(qf, NQ + ((size_t)(c.b * 16 + h) * T_ + tq) * 128, g, qgain, ATTN_SCALE * LOG2E);
  AttnState st; attn_init(st);
#pragma unroll 1
  for (int kt = 0; kt < ntile_c; ++kt) {
    if (t0 - (16 * (32 * kt + 31) + 16) > thr + 32) continue;
    f32x16 acc = score_tile(qf, KCMP + (size_t)kt * 32 * 128, koff);
    float sc[16];
#pragma unroll
    for (int i = 0; i < 16; ++i) {
      const int n = kt * 32 + crow(i, g);
      const float s = acc[i] - slope2 * (ftq - ((float)(16 * n) + 15.5f));
      sc[i] = (16 * n + 31 <= tq) ? s : NEG_INF;
    }
    softmax_step(st, sc, VCMPT + (size_t)kt * 4096, 32, voffT);
  }
  const float inv = attn_inv_l(st);
  const float g_cmp = sigmoidf_(((const float*)(p.ws + O_GT))[((size_t)c.b * T_ + tq) * 48 + h * 3]);
  stash_set(stw, st.o, inv * g_cmp);
  if (g == 0) { ml[(wave * 32 + lr) * 2] = (st.m == NEG_INF) ? 0.f : st.m; ml[(wave * 32 + lr) * 2 + 1] = inv; }
}
DI void nsa_cmp2(const Params& p, const NsaCtx c) {
  extern __shared__ __attribute__((aligned(16))) char dyn_lds[];
  NSA_LANE_CTX();
  const bf16_t* KCMP = (const bf16_t*)(p.ws + O_KCMP) + kvh * 256 * 128;
  const float ftq = (float)tq;
  const int ntile_c = (t0 >> 4) / 32 + 1;
#pragma unroll 1
  for (int kk = 0; kk < 2; ++kk) {
    const int kt = j + 4 * kk;
    float ps[16];
#pragma unroll
    for (int i = 0; i < 16; ++i) ps[i] = 0.f;
    if (kt < ntile_c) {
#pragma unroll 1
      for (int jj = 0; jj < 4; ++jj) {
        const int hh = c.gk * 4 + jj;
        bf16x8 q2[8];
        load_q_norm(q2, NQ + ((size_t)(c.b * 16 + hh) * T_ + tq) * 128, g, qgain, ATTN_SCALE * LOG2E);
        const float sl2 = fexp2(-0.5f * (float)(hh + 1)) * LOG2E;
        if (t0 - (16 * (32 * kt + 31) + 16) > __builtin_amdgcn_readfirstlane((int)(200.f / sl2) + 1) + 32) continue;
        const float mm = ml[((sub * 4 + jj) * 32 + lr) * 2], iv = ml[((sub * 4 + jj) * 32 + lr) * 2 + 1];
        f32x16 acc = score_tile(q2, KCMP + (size_t)kt * 32 * 128, koff);
#pragma unroll
        for (int i = 0; i < 16; ++i) {
          const int n = kt * 32 + crow(i, g);
          const float s = acc[i] - sl2 * (ftq - ((float)(16 * n) + 15.5f));
          const float pr = (16 * n + 31 <= tq) ? fexp2(s - mm) * iv : 0.f;
          ps[i] += pr;
        }
      }
    }
#pragma unroll
    for (int q = 0; q < 4; ++q) {
      f32x4 v; for (int e2 = 0; e2 < 4; ++e2) v[e2] = ps[q * 4 + e2];
      *(LAS f32x4*)(psum + (sub * 32 + lr) * PS_LD + kt * 32 + q * 8 + 4 * g) = v;
    }
  }
}
DI void nsa_topk(const Params& p, const NsaCtx c) {
  extern __shared__ __attribute__((aligned(16))) char dyn_lds[];
  NSA_LANE_CTX();
#pragma unroll 1
  for (int rr = 0; rr < 8; ++rr) {
    const int row = j * 8 + rr, t = c.tile64 * 64 + sub * 32 + row;
    const LAS float* pr = psum + (sub * 32 + row) * PS_LD;
    float imp = 0.f;
#pragma unroll
    for (int d = -1; d <= 3; ++d) { const int n = 4 * lane + d; if (n >= 0 && n <= 254) imp += pr[n]; }
    if (64 * lane > t) imp = NEG_INF;
    if (lane == (t >> 6) || lane == 0) imp = __builtin_inff();
    LAS float* sbw = ml + wave * 64;
    sbw[lane] = imp;
    int rank = 0;
#pragma unroll
    for (int m4 = 0; m4 < 16; ++m4) {
      const f32x4 v4 = *(const LAS f32x4*)(sbw + m4 * 4);
#pragma unroll
      for (int e2 = 0; e2 < 4; ++e2) { const int mm = m4 * 4 + e2; rank += (v4[e2] > imp || (v4[e2] == imp && mm < lane)) ? 1 : 0; }
    }
    const unsigned long long msk = __ballot(rank < 16);
    if (lane == 0) sel[sub * 32 + row] = msk;
  }
}
DI void nsa_winslc(const Params& p, const NsaCtx c) {
  extern __shared__ __attribute__((aligned(16))) char dyn_lds[];
  NSA_LANE_CTX();
  LAS unsigned char* stg = ldsb + NSA_PS_OFF;
  LAS int* tl = (LAS int*)(ldsb + NSA_PS_OFF + 3 * AT_STAGE);
  const bf16_t* KW = (const bf16_t*)(p.ws + O_KW) + kvh * T_ * 128;
  const bf16_t* VWT = (const bf16_t*)(p.ws + O_VWT) + kvh * 128 * T_;
  const bf16_t* KS = (const bf16_t*)(p.ws + O_KS) + kvh * T_ * 128;
  const bf16_t* VST = (const bf16_t*)(p.ws + O_VST) + kvh * 128 * T_;
  const unsigned long long mymask = sel[sub * 32 + lr];
  LaneKV L; lanekv_init(L, tidx, wave);
  bf16x8 qf[8];
  load_q_norm(qf, NQ + ((size_t)(c.b * 16 + h) * T_ + tq) * 128, g, qgain, ATTN_SCALE * LOG2E);
  const size_t m = (size_t)c.b * T_ + tq;
  const float* gt = (const float*)(p.ws + O_GT) + m * 48 + h * 3;
  AttnState st;
  {
    const int hi = c.tile64 * 2 + 1, lo = c.tile64 * 2 - 16 > 0 ? c.tile64 * 2 - 16 : 0, nsteps = hi - lo + 1;
    const int myhi = t0 >> 5, mylo = myhi - 16;
    attn_init(st);
    kv_issue(stg, KW + (size_t)lo * 4096, VWT + (size_t)lo * 4096, L);
    kv_issue(stg + AT_STAGE, KW + (size_t)(lo + 1) * 4096, VWT + (size_t)(lo + 1) * 4096, L);
#pragma unroll 1
    for (int i = 0; i < nsteps; ++i) {
      const int kt = lo + i;
      if (i + 1 < nsteps) AT_WAIT_V(2); else AT_WAIT_V(0);
      AT_BAR();
      if (i + 2 < nsteps) kv_issue(stg + ((i + 2) % 3) * AT_STAGE, KW + (size_t)(kt + 2) * 4096, VWT + (size_t)(kt + 2) * 4096, L);
      if (kt >= mylo && kt <= myhi && t0 - (kt * 32 + 31) <= thr) {
        const LAS unsigned char* sg = stg + (i % 3) * AT_STAGE;
        f32x16 acc = score_tile_lds(qf, sg, L);
        float sc[16];
        const int key0 = kt * 32, d0 = tq - key0 - 4 * g;
        const float fb = slope2 * (float)d0;
#pragma unroll
        for (int q = 0; q < 16; ++q) sc[q] = fmaf(slope2, (float)((q & 3) + 8 * (q >> 2)), acc[q]) - fb;
        if (kt == mylo || kt == myhi) {
#pragma unroll
          for (int q = 0; q < 16; ++q) { const int dist = d0 - ((q & 3) + 8 * (q >> 2)); sc[q] = (dist >= 0 && dist < 512) ? sc[q] : NEG_INF; }
        }
        softmax_step_lds(st, sc, sg + 8192, L);
      }
    }
    stash_add(stw, st.o, attn_inv_l(st) * sigmoidf_(gt[2]));
  }
  unsigned long long uni;
  {
    unsigned lo32 = (unsigned)mymask, hi32 = (unsigned)(mymask >> 32);
#pragma unroll
    for (int o = 1; o < 32; o <<= 1) { lo32 |= shxu(lo32, o); hi32 |= shxu(hi32, o); }
    uni = ((unsigned long long)(unsigned)__builtin_amdgcn_readfirstlane((int)hi32) << 32) | (unsigned)__builtin_amdgcn_readfirstlane((int)lo32);
    const int mbw = t0 >> 6;
    uni &= (mbw >= 63) ? ~0ull : ((1ull << (mbw + 1)) - 1ull);
    if (lane == 0) { tl[160 + wave * 2] = (int)(unsigned)uni; tl[160 + wave * 2 + 1] = (int)(unsigned)(uni >> 32); }
  }
  AT_WAIT_L0();
  AT_BAR();
  {
    unsigned long long ub = 0ull;
#pragma unroll
    for (int w2 = 0; w2 < 8; w2 += 4) ub |= ((unsigned long long)(unsigned)tl[160 + w2 * 2 + 1] << 32) | (unsigned)tl[160 + w2 * 2];
    int n = 0;
    if (wave == 0 && lane == 0) {
      const int thrg = (int)(200.f / (exp2f(-0.5f * (float)(c.gk * 4 + 4)) * LOG2E)) + 1;
      for (int mb = 0; mb <= c.tile64; ++mb) if (((ub >> mb) & 1ull) && c.tile64 * 64 - (mb * 64 + 63) <= thrg) { tl[n++] = mb * 2; tl[n++] = mb * 2 + 1; }
      tl[159] = n;
    }
  }
  AT_WAIT_L0();
  AT_BAR();
  {
    const int nsteps = __builtin_amdgcn_readfirstlane(tl[159]);
    attn_init(st);
    if (nsteps > 0) { const int k0 = __builtin_amdgcn_readfirstlane(tl[0]); kv_issue(stg, KS + (size_t)k0 * 4096, VST + (size_t)k0 * 4096, L); }
    if (nsteps > 1) { const int k1 = __builtin_amdgcn_readfirstlane(tl[1]); kv_issue(stg + AT_STAGE, KS + (size_t)k1 * 4096, VST + (size_t)k1 * 4096, L); }
#pragma unroll 1
    for (int i = 0; i < nsteps; ++i) {
      const int kt = __builtin_amdgcn_readfirstlane(tl[i]);
      if (i + 1 < nsteps) AT_WAIT_V(2); else AT_WAIT_V(0);
      AT_BAR();
      if (i + 2 < nsteps) { const int k2 = __builtin_amdgcn_readfirstlane(tl[i + 2]); kv_issue(stg + ((i + 2) % 3) * AT_STAGE, KS + (size_t)k2 * 4096, VST + (size_t)k2 * 4096, L); }
      const int mb = kt >> 1, key0 = kt * 32;
      if (((uni >> mb) & 1ull) && key0 <= t0 + 31 && t0 - (key0 + 31) <= thr) {
        const bool mine = (mymask >> mb) & 1ull;
        const LAS unsigned char* sg = stg + (i % 3) * AT_STAGE;
        f32x16 acc = score_tile_lds(qf, sg, L);
        float sc[16];
        const int d0 = tq - key0 - 4 * g;
        const float fb = mine ? slope2 * (float)d0 : __builtin_inff();
#pragma unroll
        for (int q = 0; q < 16; ++q) sc[q] = fmaf(slope2, (float)((q & 3) + 8 * (q >> 2)), acc[q]) - fb;
        if (key0 >= t0) {
#pragma unroll
          for (int q = 0; q < 16; ++q) sc[q] = (d0 - ((q & 3) + 8 * (q >> 2)) >= 0) ? sc[q] : NEG_INF;
        }
        softmax_step_lds(st, sc, sg + 8192, L);
      }
    }
  }
  const float f = attn_inv_l(st) * sigmoidf_(gt[1]);
  bf16_t* orow = (bf16_t*)(p.ws + A_MIXO) + m * D_ + h * 128;
#pragma unroll
  for (int vt = 0; vt < 4; ++vt)
#pragma unroll
    for (int q = 0; q < 4; ++q) {
      const unsigned w0 = stw[(vt * 8 + q * 2) * 64], w1 = stw[(vt * 8 + q * 2 + 1) * 64];
      f32x4 v; v[0] = __uint_as_float(w0 << 16) + st.o[vt][q * 4] * f; v[1] = __uint_as_float(w0 & 0xffff0000u) + st.o[vt][q * 4 + 1] * f;
      v[2] = __uint_as_float(w1 << 16) + st.o[vt][q * 4 + 2] * f; v[3] = __uint_as_float(w1 & 0xffff0000u) + st.o[vt][q * 4 + 3] * f;
      st_bf16x4(orow + vt * 32 + q * 8 + 4 * g, v);
    }
  AT_WAIT_L0();
}
DI void nsa_task(const Params& p, int o_idx, int b, int gk, int tile64) {
  const NsaCtx c{b, gk, tile64, o_idx};
  nsa_cmp1(p, c);
  __syncthreads();
  nsa_cmp2(p, c);
  __syncthreads();
  nsa_topk(p, c);
  __syncthreads();
  nsa_winslc(p, c);
  __syncthreads();
}

DI void cmp2_task(const Params& p, int e, int kv, int rt) {
  const int lane = TIDX & 63, lr = lane & 31, g = lane >> 5;
  const int row = rt * 32 + lr;
  const float* SPL = (const float*)(p.ws + O_SPL) + (size_t)kv * 8 * 2048 * 256 + (size_t)row * 256 + g * 8;
  const float* bias = (const float*)(p.ws + A_BIAS1) + (e * 2 + kv) * 256 + g * 8;
  const bf16_t* W2 = (const bf16_t*)(p.ws + W_C2 + (size_t)(e * 2 + kv) * SZ_C2) + (size_t)lr * 256 + g * 8;
  f32x16 acc[4];
#pragma unroll
  for (int i = 0; i < 4; ++i) acc[i] = zero16();
#pragma unroll 2
  for (int ks = 0; ks < 16; ++ks) {
    f32x4 a0 = *(const f32x4*)(bias + ks * 16), a1 = *(const f32x4*)(bias + ks * 16 + 4);
#pragma unroll
    for (int sp = 0; sp < 8; ++sp) { const float* q = SPL + (size_t)sp * 2048 * 256 + ks * 16; a0 += *(const f32x4*)q; a1 += *(const f32x4*)(q + 4); }
    float hv[8];
#pragma unroll
    for (int i = 0; i < 4; ++i) { hv[i] = gelu_tanh(a0[i]); hv[4 + i] = gelu_tanh(a1[i]); }
    const bf16x8 hb = pack8(hv);
#pragma unroll
    for (int dt = 0; dt < 4; ++dt) { const bf16x8 w = *(const bf16x8*)(W2 + (size_t)dt * 32 * 256 + ks * 16); acc[dt] = mfma32(w, hb, acc[dt]); }
  }
  if (kv == 0) {
    float ss = 0.f;
#pragma unroll
    for (int dt = 0; dt < 4; ++dt)
#pragma unroll
      for (int i = 0; i < 16; ++i) ss += acc[dt][i] * acc[dt][i];
    ss = xhalf_sum(ss);
    const float rs = rsqrtf(ss * (1.f / 128.f) + EPS_);
    const float* gn = p.in[16] + (e * 3 + 0) * 128;
    bf16_t* orow = (bf16_t*)(p.ws + O_KCMP) + (size_t)row * 128;
#pragma unroll
    for (int dt = 0; dt < 4; ++dt)
#pragma unroll
      for (int q = 0; q < 4; ++q) {
        const int d0 = dt * 32 + q * 8 + 4 * g;
        const f32x4 gg = *(const f32x4*)(gn + d0);
        f32x4 v; for (int e2 = 0; e2 < 4; ++e2) v[e2] = acc[dt][q * 4 + e2] * rs * gg[e2];
        st_bf16x4(orow + d0, v);
      }
  } else {
    bf16_t* ob = (bf16_t*)(p.ws + O_VCMPT) + (size_t)(row >> 8) * 128 * 256 + (size_t)((row & 255) >> 5) * 4096 + (row & 31);
#pragma unroll
    for (int dt = 0; dt < 4; ++dt)
#pragma unroll
      for (int i = 0; i < 16; ++i) ob[(size_t)(dt * 32 + crow(i, g)) * 32] = f2bf(acc[dt][i]);
  }
}

DI void cmp_bias_jobs(const Params& p) {
  extern __shared__ __attribute__((aligned(16))) char dyn_lds[];
  float* red = (float*)dyn_lds;
  const int tid = TIDX, part = tid >> 5, cl = tid & 31;
  for (int it = (int)gridDim.x - 1 - (int)blockIdx.x; it < 32; it += gridDim.x) {
    const int job = it >> 3, cg8 = it & 7, l = job >> 1, kv = job & 1;
    const float* pe = p.in[kv ? 20 : 17] + (size_t)l * 4096;
    const float* w1 = p.in[kv ? 21 : 18] + (size_t)l * 4096 * 256;
    const int c = cg8 * 32 + cl;
    float s = 0.f;
#pragma unroll 8
    for (int k = part * 256; k < part * 256 + 256; ++k) s += pe[k] * w1[(size_t)k * 256 + c];
    red[part * 32 + cl] = s;
    __syncthreads();
    if (tid < 32) { float a = 0.f; for (int q = 0; q < 16; ++q) a += red[q * 32 + tid]; ((float*)(p.ws + A_BIAS1))[job * 256 + cg8 * 32 + tid] = a; }
    __syncthreads();
  }
}

#define XB_TMO      128
#define XB_XCNT(j)  (256  + 64 * (j))
#define XB_XSUB(j)  (1280 + 64 * (j))
#define XB_XGEN(j)  (2304 + 64 * (j))
#define XB_TOP      3328
#define XB_TOPGEN   3392
#define XCD_BAR_WORDS 3456
#define XB_SPIN_CAP (1u << 18)
DI unsigned xb_ld(unsigned* q)              { return __hip_atomic_load(q, __ATOMIC_RELAXED, __HIP_MEMORY_SCOPE_AGENT); }
DI unsigned xb_add(unsigned* q, unsigned v) { return __hip_atomic_fetch_add(q, v, __ATOMIC_RELAXED, __HIP_MEMORY_SCOPE_AGENT); }
DI unsigned xb_xcc_id() { return (unsigned)__builtin_amdgcn_s_getreg((3 << 11) | 20) & 0xFu; }
#define XB_SPIN(cond, bar) do { unsigned _sp = 0; while (cond) { __builtin_amdgcn_s_sleep(1); \
    if ((++_sp & 255u) == 0u) { if (xb_ld(&(bar)[XB_TMO])) break; if (_sp > XB_SPIN_CAP) { atomicAdd(&(bar)[XB_TMO], 1u); break; } } } } while (0)
struct XcdBarrier { unsigned* bar; unsigned x; volatile LAS unsigned* st; };
DI XcdBarrier xcd_barrier_post(unsigned* bar, volatile LAS unsigned* st) {
  XcdBarrier b; b.bar = bar; b.x = xb_xcc_id(); b.st = st;
  if (threadIdx.x == 0) (void)xb_add(&bar[XB_XCNT(b.x)], 1u);
  return b;
}
DI void xcd_barrier_complete(unsigned* bar, unsigned x, unsigned& nloc, unsigned& nx) {
  const unsigned G = gridDim.x * gridDim.y * gridDim.z;
  unsigned sum, cnt, mine, sp = 0u;
  for (;;) {
    sum = 0u; cnt = 0u; mine = 0u;
#pragma unroll
    for (unsigned j = 0; j < 16; ++j) { const unsigned c = xb_ld(&bar[XB_XCNT(j)]); sum += c; cnt += (c > 0u) ? 1u : 0u; mine = (j == x) ? c : mine; }
    if (sum == G) break;
    __builtin_amdgcn_s_sleep(1);
    if ((++sp & 255u) == 0u) { if (xb_ld(&bar[XB_TMO])) break; if (sp > XB_SPIN_CAP) { atomicAdd(&bar[XB_TMO], 1u); break; } }
  }
  nloc = mine > 0u ? mine : 1u; nx = cnt > 0u ? cnt : 1u;
}
DI void xcd_barrier(const XcdBarrier& b) {
  asm volatile("s_waitcnt vmcnt(0)" ::: "memory");
  __syncthreads();
  if (threadIdx.x == 0) {
    unsigned* bar = b.bar;
    __builtin_amdgcn_s_waitcnt(0);
    unsigned nloc = b.st[0], nx = b.st[1];
    if (nloc == 0u) { xcd_barrier_complete(bar, b.x, nloc, nx); b.st[0] = nloc; b.st[1] = nx; }
    const unsigned old = xb_add(&bar[XB_XSUB(b.x)], 1u);
    const unsigned gen = old / nloc;
    if (old + 1u == (gen + 1u) * nloc) {
      __builtin_amdgcn_fence(__ATOMIC_RELEASE, "agent");
      asm volatile("s_waitcnt vmcnt(0)" ::: "memory");
      const unsigned og = xb_add(&bar[XB_TOP], 1u);
      const unsigned tg = og / nx;
      if (og + 1u == (tg + 1u) * nx) xb_add(&bar[XB_TOPGEN], 1u);
      else XB_SPIN(xb_ld(&bar[XB_TOPGEN]) == tg, bar);
      __builtin_amdgcn_fence(__ATOMIC_ACQUIRE, "agent");
      xb_add(&bar[XB_XGEN(b.x)], 1u);
      asm volatile("s_waitcnt vmcnt(0)" ::: "memory");
    } else {
      XB_SPIN(xb_ld(&bar[XB_XGEN(b.x)]) == gen, bar);
      __builtin_amdgcn_fence(__ATOMIC_ACQUIRE, "agent");
      asm volatile("s_waitcnt vmcnt(0)" ::: "memory");
    }
  }
  __syncthreads();
}

#ifndef ONLY_KEY
#define ONLY_KEY (-1)
#endif
#define KEYOK(k) (ONLY_KEY < 0 || ONLY_KEY == (k))
constexpr int PH_PRE = 1, PH_PER_LAYER = 11, PH_TOTAL = PH_PRE + 4 * PH_PER_LAYER;

DI void run_phase(const Params& p0, int ph) {
  Params p = p0;
  { unsigned long long w_ = (unsigned long long)p0.ws; asm volatile("" : "+s"(w_)); p.ws = (unsigned char*)(__attribute__((address_space(1))) unsigned char*)w_; }
  unsigned char* ws = p.ws;
  if (ph == 0) {
    if (!KEYOK(0)) return;
    transpose_jobs(p);
    rmsnorm_rows(p.in[1], nullptr, (bf16_t*)(ws + A_MEMN), 512);
    xprep_rows(p.in[0], (bf16_t*)(ws + A_H), (float*)(ws + A_SSP), M_);
    cmp_bias_jobs(p);
    return;
  }
  const int layer = (ph - PH_PRE) / PH_PER_LAYER, sidx = (ph - PH_PRE) % PH_PER_LAYER;
  const int step = sidx < 6 ? sidx + 1 : (sidx < 9 ? sidx + 2 : sidx + 3);
  float* sspA = (float*)(ws + A_SSP); float* sspB = sspA + (size_t)M_ * 8; float* sspC = sspB + (size_t)M_ * 8;
  const bool even = (layer & 1) == 0; const int e = layer >> 1;
  const float* xin = layer == 0 ? p.in[0] : (const float*)(ws + A_XRES);
  float* xres = (float*)(ws + A_XRES);
  bf16_t* H = (bf16_t*)(ws + A_H);
  switch (step) {
    case 1:
      if (even) { if (KEYOK(4)) { EpiEvenIn epi{sspA, ws}; gemm_run(H, D_, (const bf16_t*)(ws + W_EIN + e * SZ_EIN), D_, M_, N_EIN, D_, epi); }
        if (layer == 0) { if (KEYOK(1)) { EpiMemKV epi{(bf16_t*)(ws + A_MEMK), (bf16_t*)(ws + A_MEMVT)};
          gemm_run((const bf16_t*)(ws + A_MEMN), D_, (const bf16_t*)(ws + W_MKV), D_, 512, 4096, D_, epi, 160); } } }
      else { if (KEYOK(18)) { EpiOddIn epi{sspA, ws}; gemm_run(H, D_, (const bf16_t*)(ws + W_OIN + e * SZ_OIN), D_, M_, N_OIN, D_, epi); } }
      break;
    case 2:
      if (even) {
        if (KEYOK(5)) {
        headnorm_rows((bf16_t*)(ws + E_FK), 16 * T_, p.in[10] + e * 128, 0, 0);
        if (layer == 0) for (int l = 0; l < 4; ++l) headnorm_rows((bf16_t*)(ws + A_MEMK) + (size_t)l * 8 * 256 * 128, 8 * 256, p.in[27] + l * 128, 0, 0);
        fox_cumsum(p, e);
        hgrn_prep(p, e);
        }
      } else {
        if (KEYOK(19)) {
        headnorm_rows((bf16_t*)(ws + O_KS), 8 * T_, p.in[16] + (e * 3 + 1) * 128, 0, 0);
        headnorm_rows((bf16_t*)(ws + O_KW), 8 * T_, p.in[16] + (e * 3 + 2) * 128, 0, 0);
#pragma unroll 1
        for (int c = 0; c < 16; ++c) {
          const int kv = c >> 3, sp = c & 7;
          EpiF32 epi{(float*)(ws + O_SPL) + (size_t)c * 2048 * 256, 256};
          gemm_run((const bf16_t*)(ws + (kv ? O_VC : O_KC)) + sp * 512, 2048, (const bf16_t*)(ws + W_C1 + (e * 2 + kv) * SZ_C1) + sp * 512, 4096, 2048, 256, 512, epi, c * 8);
        }
        }
      }
      break;
    case 3:
      if (even) {
        if (KEYOK(6)) {
          for (int bt = blockIdx.x; bt < 256; bt += gridDim.x) fox_block(p, e, bt >> 4, bt & 15);
        }
        if (KEYOK(7)) {
          const int wave = TIDX >> 6;
          for (int ti = wave * gridDim.x + blockIdx.x; ti < 4096; ti += 8 * gridDim.x) hgrn_u_task(p, ti >> 8, (ti >> 2) & 63, ti & 3);
        }
      } else {
        if (KEYOK(20)) { const int wave = TIDX >> 6; for (int ti = wave * gridDim.x + blockIdx.x; ti < 128; ti += 8 * gridDim.x) cmp2_task(p, e, ti >> 6, ti & 63); }
      }
      break;
    case 4:
      if (even) { if (KEYOK(8)) hgrn_scan(p); }
      break;
    case 5:
      if (even) {
        if (KEYOK(9)) { const int wave = TIDX >> 6; for (int ti = wave * gridDim.x + blockIdx.x; ti < 2048; ti += 8 * gridDim.x) hgrn_out_task(p, e, ti >> 7, (ti >> 1) & 63, ti & 1); }
      } else {
        if (KEYOK(22)) {
          extern __shared__ __attribute__((aligned(16))) char dyn_lds[];
          volatile LAS unsigned* qs = (volatile LAS unsigned*)((LAS unsigned char*)dyn_lds + NSA_LDS) + 2;
          unsigned* ctr = (unsigned*)(ws + A_BAR) + 3600 + 64 * e;
          for (;;) {
            if (threadIdx.x == 0) qs[0] = __hip_atomic_fetch_add(ctr, 1u, __ATOMIC_RELAXED, __HIP_MEMORY_SCOPE_AGENT);
            __syncthreads();
            const int q = __builtin_amdgcn_readfirstlane((int)qs[0]);
            __syncthreads();
            if (q >= 512) break;
            const int bg = q & 7;
            nsa_task(p, e, bg >> 2, bg & 3, 63 - (q >> 3));
          }
        }
      }
      break;
    case 6: if (KEYOK(10)) {
      EpiResid epi{xin, xres, H, sspB};
      gemm_run((const bf16_t*)(ws + A_MIXO), D_, (const bf16_t*)(ws + (even ? W_EOUT : W_OOUT) + e * SZ_SQ), D_, M_, D_, D_, epi);
    } break;
    case 8: if (KEYOK(11)) {
#pragma unroll 1
      for (int sp = 0; sp < 4; ++sp) {
        EpiF32 epi{(float*)(ws + A_SCR) + (size_t)sp * M_ * 512, 512};
        gemm_run(H + sp * 512, D_, (const bf16_t*)(ws + W_MQ + layer * SZ_MQ) + sp * 512, D_, M_, 512, 512, epi, sp * 64);
      }
    } break;
    case 9:
      if (KEYOK(12)) { for (int bt = blockIdx.x; bt < 256; bt += gridDim.x) memattn_block(p, layer, bt >> 5, bt & 31); }
      break;
    case 10: if (KEYOK(10)) { EpiResid epi{xres, xres, H, sspC}; gemm_run((const bf16_t*)(ws + A_MAO), 512, (const bf16_t*)(ws + W_MO + layer * SZ_MQ), 512, M_, D_, 512, epi); } break;
    case 12: if (KEYOK(13)) { EpiSwiglu epi{sspC, (bf16_t*)(ws + F_HID)}; gemm_run(H, D_, (const bf16_t*)(ws + W_F13 + layer * SZ_F13), D_, M_, N_F13, D_, epi); } break;
    default: if (KEYOK(10)) { EpiResid epi{xres, layer == 3 ? p.out : xres, layer == 3 ? nullptr : H, layer == 3 ? nullptr : sspA}; gemm_run((const bf16_t*)(ws + F_HID), FFN_, (const bf16_t*)(ws + W_F2 + layer * SZ_F2), FFN_, M_, D_, FFN_, epi); } break;
  }
}

__global__ void __launch_bounds__(NTH) fwd_megakernel(Params p) {
#if ONE_LAUNCH
  cg::grid_group grid = cg::this_grid();
  extern __shared__ __attribute__((aligned(16))) char dyn_lds[];
  volatile LAS unsigned* xst = (volatile LAS unsigned*)((LAS unsigned char*)dyn_lds + NSA_LDS);
  if (threadIdx.x == 0) { xst[0] = 0u; xst[1] = 0u; xst[2] = 0u; xst[3] = 0u; }
  __syncthreads();
  const XcdBarrier xb = xcd_barrier_post((unsigned*)(p.ws + A_BAR), xst);
  for (int ph = p.ph_lo; ph < p.ph_hi; ++ph) {
    if (ph >= PH_PRE && (((ph - PH_PRE) / PH_PER_LAYER) & 1) == 1 && (ph - PH_PRE) % PH_PER_LAYER == 3) continue;
    run_phase(p, ph);
    if (ph + 1 < p.ph_hi) { if (ph == 0) grid.sync(); else xcd_barrier(xb); }
  }
#else
  for (int ph = p.ph_lo; ph < p.ph_hi; ++ph) run_phase(p, ph);
#endif
}

extern "C" void kernel_launch(void* const* d_in, const int* in_sizes, int n_in, void* d_out, int out_size, void* d_ws, size_t ws_size, hipStream_t stream) {
  static int grid_blocks = 0;
  constexpr size_t kDynLds = NSA_LDS + 16;
  if (grid_blocks == 0) {
    if (n_in != 31 || ws_size < WS_NEED) { fprintf(stderr, "kernel_launch: need 31 inputs and %zu workspace bytes; got %d, %zu\n", (size_t)WS_NEED, n_in, ws_size); grid_blocks = -1; return; }
    int dev = 0, cus = 0, per_cu = 0;
    hipGetDevice(&dev);
    hipDeviceGetAttribute(&cus, hipDeviceAttributeMultiprocessorCount, dev);
    hipFuncSetAttribute((const void*)fwd_megakernel, hipFuncAttributeMaxDynamicSharedMemorySize, (int)kDynLds);
    hipOccupancyMaxActiveBlocksPerMultiprocessor(&per_cu, (const void*)fwd_megakernel, NTH, kDynLds);
    if (per_cu < 1) per_cu = 1;
    grid_blocks = cus * per_cu;
    if (grid_blocks > 256) grid_blocks = 256;
  }
  if (grid_blocks < 0) return;
  hipMemsetAsync((unsigned char*)d_ws + A_BAR, 0, BAR_BYTES, stream);
  Params p{};
  for (int i = 0; i < 31; ++i) p.in[i] = (const float*)d_in[i];
  p.out = (float*)d_out; p.ws = (unsigned char*)d_ws;
#if ONE_LAUNCH
  p.ph_lo = 0; p.ph_hi = PH_TOTAL;
  void* args[] = {&p};
  hipError_t e = hipLaunchCooperativeKernel((const void*)fwd_megakernel, dim3(grid_blocks), dim3(NTH), args, kDynLds, stream);
  if (e != hipSuccess) fprintf(stderr, "cooperative launch failed: %s (grid %d)\n", hipGetErrorString(e), grid_blocks);
#else
  for (int ph = 0; ph < PH_TOTAL; ++ph) {
    p.ph_lo = ph; p.ph_hi = ph + 1;
    hipLaunchKernelGGL(fwd_megakernel, dim3(grid_blocks), dim3(NTH), kDynLds, stream, p);
  }
#endif
}
```

```cpp
#include <hip/hip_runtime.h>
#include <hip/hip_cooperative_groups.h>
#include <cstdio>
namespace cg = cooperative_groups;

#ifndef ONE_LAUNCH
#define ONE_LAUNCH 1
#endif

typedef unsigned short bf16_t;
typedef short bf16x8 __attribute__((ext_vector_type(8)));
typedef short s16x4 __attribute__((ext_vector_type(4)));
typedef float f32x4 __attribute__((ext_vector_type(4)));
typedef float f32x16 __attribute__((ext_vector_type(16)));
typedef unsigned u32x2 __attribute__((ext_vector_type(2)));
typedef unsigned u32x4 __attribute__((ext_vector_type(4)));
#define DI __device__ __forceinline__

constexpr int T_ = 4096, M_ = 8192, D_ = 2048, NTH = 512;
constexpr float EPS_ = 1e-6f, LOG2E = 1.4426950408889634f, ATTN_SCALE = 0.08838834764831845f;
#define NEG_INF (-__builtin_inff())

constexpr size_t al(size_t x) { return (x + 255) & ~(size_t)255; }
constexpr int N_EIN = 7424, N_OIN = 5376, N_F13 = 11264, FFN_ = 5632;
constexpr size_t SZ_EIN = (size_t)N_EIN * 2048 * 2, SZ_SQ = (size_t)2048 * 2048 * 2, SZ_OIN = (size_t)N_OIN * 2048 * 2;
constexpr size_t SZ_C1 = (size_t)256 * 4096 * 2, SZ_C2 = (size_t)256 * 256 * 2, SZ_MQ = (size_t)512 * 2048 * 2, SZ_MKV = (size_t)1024 * 2048 * 2;
constexpr size_t SZ_F13 = (size_t)N_F13 * 2048 * 2, SZ_F2 = (size_t)2048 * FFN_ * 2;
constexpr size_t W_EIN = 0;
constexpr size_t W_EOUT = W_EIN + 2 * SZ_EIN;
constexpr size_t W_OIN = W_EOUT + 2 * SZ_SQ;
constexpr size_t W_OOUT = W_OIN + 2 * SZ_OIN;
constexpr size_t W_C1 = W_OOUT + 2 * SZ_SQ;
constexpr size_t W_C2 = W_C1 + 4 * SZ_C1;
constexpr size_t W_MQ = W_C2 + 4 * SZ_C2;
constexpr size_t W_MKV = W_MQ + 4 * SZ_MQ;
constexpr size_t W_MO = W_MKV + 4 * SZ_MKV;
constexpr size_t W_F13 = W_MO + 4 * SZ_MQ;
constexpr size_t W_F2 = W_F13 + 4 * SZ_F13;
constexpr size_t W_END = W_F2 + 4 * SZ_F2;
constexpr size_t A_XRES = al(W_END);
constexpr size_t A_H = A_XRES + (size_t)M_ * D_ * 4;
constexpr size_t A_MEMN = A_H + (size_t)M_ * D_ * 2;
constexpr size_t A_MEMK = A_MEMN + (size_t)4 * 512 * 2048 * 2;
constexpr size_t A_MEMVT = A_MEMK + (size_t)4 * 2 * 4 * 256 * 128 * 2;
constexpr size_t A_BIAS1 = A_MEMVT + (size_t)4 * 2 * 4 * 256 * 128 * 2;
constexpr size_t A_QM = A_BIAS1 + 4096;
constexpr size_t A_MAO = A_QM + (size_t)M_ * 512 * 2;
constexpr size_t A_MIXO = A_MAO + (size_t)M_ * 512 * 2;
constexpr size_t A_SSP = A_MIXO + (size_t)M_ * D_ * 2;
constexpr size_t SZ_SSP = (size_t)M_ * 8 * 4;
constexpr size_t A_BAR = A_SSP + 3 * SZ_SSP;
constexpr size_t BAR_BYTES = 16384;
constexpr size_t A_SCR = A_BAR + BAR_BYTES;
constexpr size_t SZ16 = (size_t)M_ * 1024 * 2;
constexpr size_t E_FQ = A_SCR, E_FK = E_FQ + SZ16, E_FVT = E_FK + SZ16, E_HQ = E_FVT + SZ16, E_HF = E_HQ + SZ16  ,
                 E_HIT = E_HF + 2 * SZ16, E_HG = E_HIT + SZ16, E_QT = E_HG + SZ16, E_KT = E_QT + SZ16, E_QS = E_KT + SZ16, E_KUT = E_QS + SZ16,
                 E_U = E_KUT + SZ16  , E_FF = E_U + 4 * SZ16  , E_FC = E_FF + (size_t)M_ * 8 * 4  ,
                 E_DL = E_FC + (size_t)16 * T_ * 4  , E_END = E_DL + (size_t)16 * 64 * 128 * 4;
constexpr size_t E_ST = E_HF;
constexpr size_t SZ8 = (size_t)M_ * 512 * 2;
constexpr size_t O_NQ = A_SCR, O_KC = O_NQ + 2 * SZ16, O_VC = O_KC + SZ8 + 65536, O_KS = O_VC + SZ8 + 65536, O_KW = O_KS + SZ8, O_VST = O_KW + SZ8,
                 O_VWT = O_VST + SZ8, O_GT = O_VWT + SZ8  , O_HC = O_GT + (size_t)M_ * 48 * 4  ,
                 O_KCMP = O_HC + (size_t)2 * 2048 * 256 * 2, O_VCMPT = O_KCMP + (size_t)2048 * 128 * 2, O_SPL = O_VCMPT + (size_t)2048 * 128 * 2  ,
                 O_END = O_SPL + (size_t)16 * 2048 * 256 * 4;
constexpr size_t F_HID = A_SCR;
constexpr size_t F_END = F_HID + (size_t)M_ * FFN_ * 2;
constexpr size_t WS_NEED = (E_END > O_END ? (E_END > F_END ? E_END : F_END) : (O_END > F_END ? O_END : F_END));

struct Params {
  const float* in[31];
  float* out;
  unsigned char* ws;
  int ph_lo, ph_hi;
};

DI int launder(int x) { asm volatile("" : "+v"(x)); return x; }
#define TIDX launder((int)threadIdx.x)
DI float bf2f(bf16_t v) { return __uint_as_float(((unsigned)v) << 16); }
typedef __bf16 hwbf16x2g __attribute__((ext_vector_type(2)));
typedef float f32x2g __attribute__((ext_vector_type(2)));
DI unsigned pk2(float lo, float hi) { const f32x2g f = {lo, hi}; const hwbf16x2g r = __builtin_convertvector(f, hwbf16x2g); return __builtin_bit_cast(unsigned, r); }
DI bf16_t f2bf(float x) { return (bf16_t)(pk2(x, 0.f) & 0xffffu); }
DI int lane_now() { return TIDX & 63; }
DI float shx(float v, int mask) { return __int_as_float(__builtin_amdgcn_ds_bpermute((lane_now() ^ mask) << 2, __float_as_int(v))); }
DI unsigned shxu(unsigned v, int mask) { return (unsigned)__builtin_amdgcn_ds_bpermute((lane_now() ^ mask) << 2, (int)v); }
DI float xhalf_max(float v) { const auto r = __builtin_amdgcn_permlane32_swap(__float_as_uint(v), __float_as_uint(v), false, false); return fmaxf(__uint_as_float(r[0]), __uint_as_float(r[1])); }
DI float xhalf_sum(float v) { const auto r = __builtin_amdgcn_permlane32_swap(__float_as_uint(v), __float_as_uint(v), false, false); return __uint_as_float(r[0]) + __uint_as_float(r[1]); }
DI float shidx(float v, int src) { return __int_as_float(__builtin_amdgcn_ds_bpermute(src << 2, __float_as_int(v))); }
DI float wave_sum(float v) {
#pragma unroll
  for (int o = 1; o < 64; o <<= 1) v += shx(v, o);
  return v;
}
DI float fexp2(float x) { return __builtin_amdgcn_exp2f(x); }
DI float frcp(float x) { return __builtin_amdgcn_rcpf(x); }
DI float sigmoidf_(float x) { return frcp(1.f + __expf(-x)); }
DI f32x16 mfma32(bf16x8 a, bf16x8 b, f32x16 c) { return __builtin_amdgcn_mfma_f32_32x32x16_bf16(a, b, c, 0, 0, 0); }
DI f32x16 zero16() { f32x16 z; for (int i = 0; i < 16; ++i) z[i] = 0.f; return z; }

constexpr int BM = 256, BK = 64, HALF = 128, HT = HALF * BK, NXCD = 8, WGM = 8;
constexpr int GEMM_LDS = 8 * HT * 2;
DI int lds_byte(int r, int c) { int st = (r >> 4) * 2 + (c >> 5), rr = r & 15, cc = c & 31, ob = rr * 64 + cc * 2; return st * 1024 + (ob ^ (((ob >> 9) & 1) << 5)); }
DI void stage_rc(int b, int& R, int& C) { int st = b / 1024, sb = b % 1024, swz = sb ^ (((sb >> 9) & 1) << 5); R = (st >> 1) * 16 + swz / 64; C = (st & 1) * 32 + (swz % 64) / 2; }

#define LAS __attribute__((address_space(3)))
DI const char* uniform_ptr(const char* p) { const unsigned long long v = (unsigned long long)p; const unsigned lo = (unsigned)__builtin_amdgcn_readfirstlane((int)(unsigned)v), hi = (unsigned)__builtin_amdgcn_readfirstlane((int)(unsigned)(v >> 32)); return (const char*)(((unsigned long long)hi << 32) | lo); }
template <class Epi>
DI void gemm_run(const bf16_t* __restrict__ A, int lda, const bf16_t* __restrict__ Bt, int ldb, int M, int N, int K, const Epi& epi, int blk_off = 0) {
  extern __shared__ __attribute__((aligned(16))) char dyn_lds[];
  LAS unsigned char* lds = (LAS unsigned char*)dyn_lds;
  const int tid = TIDX, wid = __builtin_amdgcn_readfirstlane(tid >> 6), lane = tid & 63, wr = wid >> 2, wc = wid & 3, fr = lane & 15, fq = lane >> 4;
  const int nt = K / BK;
  unsigned voffA[2], voffB[2];
#pragma unroll
  for (int i = 0; i < 2; ++i) { int R, C; stage_rc(tid * 16 + i * 8192, R, C); voffA[i] = (unsigned)(R * lda + C) * 2u; voffB[i] = (unsigned)(R * ldb + C) * 2u; }
  const size_t kstep = (size_t)(BK * 2);
  const size_t hstepA = (size_t)HALF * lda * 2, hstepB = (size_t)HALF * ldb * 2;
  const unsigned ldsw = (unsigned)wid * 1024u;
  const int aoff = lds_byte(wr * 64 + fr, fq * 8), boff = lds_byte(wc * 32 + fr, fq * 8);
  constexpr int HTB = HT * 2;
#define G_SA(b, h) (((b) * 2 + (h)) * HTB)
#define G_SB(b, h) ((4 + (b) * 2 + (h)) * HTB)
#define G_STAGE(bufoff, gbase, voff) do { _Pragma("unroll") for (int _i = 0; _i < 2; ++_i) \
    __builtin_amdgcn_global_load_lds((const unsigned*)(uniform_ptr((const char*)(gbase)) + (voff)[_i]), (LAS unsigned*)(lds + (bufoff) + ldsw + _i * 8192), 16, 0, 0); } while (0)
#define G_LDA(dst, b, h) do { _Pragma("unroll") for (int m = 0; m < 4; ++m) _Pragma("unroll") for (int k = 0; k < 2; ++k) dst[m][k] = *(const LAS bf16x8*)(lds + G_SA(b, h) + aoff + m * 2048 + k * 1024); } while (0)
#define G_LDB(dst, b, h) do { _Pragma("unroll") for (int n = 0; n < 2; ++n) _Pragma("unroll") for (int k = 0; k < 2; ++k) dst[n][k] = *(const LAS bf16x8*)(lds + G_SB(b, h) + boff + n * 2048 + k * 1024); } while (0)
#define G_MMA(ai, bj, At, Bx) do { __builtin_amdgcn_s_setprio(1); _Pragma("unroll") for (int m = 0; m < 4; ++m) _Pragma("unroll") for (int n = 0; n < 2; ++n) _Pragma("unroll") for (int k = 0; k < 2; ++k) \
    acc[ai][bj][m][n] = __builtin_amdgcn_mfma_f32_16x16x32_bf16(Bx[n][k], At[m][k], acc[ai][bj][m][n], 0, 0, 0); __builtin_amdgcn_s_setprio(0); } while (0)
#define WAIT_V(n) asm volatile("s_waitcnt vmcnt(" #n ")" ::: "memory")
#define WAIT_L(n) asm volatile("s_waitcnt lgkmcnt(" #n ")" ::: "memory")
#define BAR __builtin_amdgcn_s_barrier()
#define SCHED __builtin_amdgcn_sched_barrier(0)
  const int nM = M / BM, nN = N / BM, nwg = nM * nN;
  for (int u = (int)((blockIdx.x + gridDim.x - blk_off) % gridDim.x); u < nwg; u += gridDim.x) {
    int wgid = u;
    { int q = nwg / NXCD, r = nwg % NXCD, xcd = wgid % NXCD, off = wgid / NXCD; wgid = (xcd < r ? xcd * (q + 1) : r * (q + 1) + (xcd - r) * q) + off; }
    int nig = WGM * nN, gid = wgid / nig, fm = gid * WGM, gsz = min(nM - fm, WGM);
    const int pm = __builtin_amdgcn_readfirstlane(fm + ((wgid % nig) % gsz)), pn = __builtin_amdgcn_readfirstlane((wgid % nig) / gsz), brow = pm * BM, bcol = pn * BM;
    f32x4 acc[2][2][4][2];
#pragma unroll
    for (int a = 0; a < 2; ++a)
#pragma unroll
      for (int b = 0; b < 2; ++b)
#pragma unroll
        for (int m = 0; m < 4; ++m)
#pragma unroll
          for (int n = 0; n < 2; ++n) acc[a][b][m][n] = (f32x4){0.f, 0.f, 0.f, 0.f};
    bf16x8 At[4][2], B0[2][2], B1[2][2];
    const char* cA = (const char*)A + (size_t)brow * lda * 2; const char* cB = (const char*)Bt + (size_t)bcol * ldb * 2;
    G_STAGE(G_SB(0, 0), cB, voffB); G_STAGE(G_SA(0, 0), cA, voffA); G_STAGE(G_SB(0, 1), cB + hstepB, voffB); G_STAGE(G_SA(0, 1), cA + hstepA, voffA);
    if (wr == 1) BAR;
    WAIT_V(4); BAR;
    G_STAGE(G_SB(1, 0), cB + kstep, voffB); G_STAGE(G_SA(1, 0), cA + kstep, voffA); G_STAGE(G_SB(1, 1), cB + hstepB + kstep, voffB);
    WAIT_V(6); BAR;
    for (int t = 0; t < nt - 2; t += 2) {
      const char* a1 = cA + (size_t)(t + 1) * kstep;
      const char* a2 = cA + (size_t)(t + 2) * kstep; const char* b2 = cB + (size_t)(t + 2) * kstep;
      const char* a3 = a2 + kstep; const char* b3 = b2 + kstep;
      G_LDB(B0, 0, 0); SCHED; G_LDA(At, 0, 0); G_STAGE(G_SA(1, 1), a1 + hstepA, voffA);
      WAIT_L(8); BAR; WAIT_L(0); G_MMA(0, 0, At, B0); BAR; SCHED;
      G_LDB(B1, 0, 1); G_STAGE(G_SB(0, 0), b2, voffB);
      BAR; WAIT_L(0); G_MMA(0, 1, At, B1); BAR;
      G_LDA(At, 0, 1); G_STAGE(G_SA(0, 0), a2, voffA);
      BAR; WAIT_L(0); G_MMA(1, 0, At, B0); BAR; SCHED;
      G_STAGE(G_SB(0, 1), b2 + hstepB, voffB);
      WAIT_V(6); BAR; G_MMA(1, 1, At, B1); BAR;
      G_LDB(B0, 1, 0); SCHED; G_LDA(At, 1, 0); G_STAGE(G_SA(0, 1), a2 + hstepA, voffA);
      WAIT_L(8); BAR; WAIT_L(0); G_MMA(0, 0, At, B0); BAR; SCHED;
      G_LDB(B1, 1, 1); G_STAGE(G_SB(1, 0), b3, voffB);
      BAR; WAIT_L(0); G_MMA(0, 1, At, B1); BAR;
      G_LDA(At, 1, 1); G_STAGE(G_SA(1, 0), a3, voffA);
      BAR; WAIT_L(0); G_MMA(1, 0, At, B0); BAR; SCHED;
      G_STAGE(G_SB(1, 1), b3 + hstepB, voffB);
      WAIT_V(6); BAR; G_MMA(1, 1, At, B1); BAR;
    }
    { G_LDB(B0, 0, 0); G_LDA(At, 0, 0); G_STAGE(G_SA(1, 1), cA + (size_t)(nt - 1) * kstep + hstepA, voffA);
      BAR; WAIT_L(0); G_MMA(0, 0, At, B0); BAR;
      G_LDB(B1, 0, 1); BAR; WAIT_L(0); G_MMA(0, 1, At, B1); BAR;
      G_LDA(At, 0, 1); WAIT_V(4); BAR; WAIT_L(0); G_MMA(1, 0, At, B0); G_MMA(1, 1, At, B1); BAR; }
    { G_LDB(B0, 1, 0); G_LDA(At, 1, 0); WAIT_V(2); BAR; WAIT_L(0); G_MMA(0, 0, At, B0); BAR;
      G_LDB(B1, 1, 1); WAIT_V(0); BAR; WAIT_L(0); G_MMA(0, 1, At, B1); BAR;
      G_LDA(At, 1, 1); BAR; WAIT_L(0); G_MMA(1, 0, At, B0); G_MMA(1, 1, At, B1); BAR; }
    if (wr == 0) BAR;
    float rowss[2][4];
    const int lane_e = TIDX & 63, fr_e = lane_e & 15, fq_e = lane_e >> 4;
#pragma unroll
    for (int ai = 0; ai < 2; ++ai)
#pragma unroll
      for (int m = 0; m < 4; ++m) {
        const int row = brow + ai * HALF + wr * 64 + m * 16 + fr_e;
        const float rsc = epi.rowscale(row);
        float ssq = 0.f;
#pragma unroll
        for (int bj = 0; bj < 2; ++bj)
          ssq += epi(row, bcol + bj * HALF + wc * 32, fq_e, acc[ai][bj][m][0] * rsc, acc[ai][bj][m][1] * rsc);
        rowss[ai][m] = ssq;
        __builtin_amdgcn_sched_barrier(0);
      }
    if constexpr (Epi::HAS_SS) {
      float* ssp = epi.ssp_ptr();
      if (ssp) {
        LAS float* red = (LAS float*)lds;
#pragma unroll
        for (int ai = 0; ai < 2; ++ai)
#pragma unroll
          for (int m = 0; m < 4; ++m) {
            float v = rowss[ai][m];
            v += shx(v, 16); v += shx(v, 32);
            if (fq_e == 0) red[(ai * HALF + wr * 64 + m * 16 + fr_e) * 4 + wc] = v;
          }
        __syncthreads();
        { const int t2 = TIDX; if (t2 < 256) { const LAS float* q = red + t2 * 4; ssp[(size_t)(brow + t2) * 8 + pn] = (q[0] + q[1]) + (q[2] + q[3]); } }
      }
    }
    __syncthreads();
  }
}

typedef __bf16 hwbf16x2e __attribute__((ext_vector_type(2)));
typedef float f32x2e __attribute__((ext_vector_type(2)));
DI unsigned pk2e(float lo, float hi) { const f32x2e f = {lo, hi}; const hwbf16x2e r = __builtin_convertvector(f, hwbf16x2e); return __builtin_bit_cast(unsigned, r); }
DI void st_bf16x4(bf16_t* p, f32x4 v) { u32x2 o; o.x = pk2e(v[0], v[1]); o.y = pk2e(v[2], v[3]); *(u32x2*)p = o; }
DI void st_tr4(bf16_t* p, size_t stride, f32x4 v) { p[0] = f2bf(v[0]); p[stride] = f2bf(v[1]); p[2 * stride] = f2bf(v[2]); p[3 * stride] = f2bf(v[3]); }

struct EpiEvenIn {
  static constexpr bool HAS_SS = false;
  const float* ssp_in;
  DI float rowscale(int row) const { const f32x4 a = *(const f32x4*)(ssp_in + (size_t)row * 8), b = *(const f32x4*)(ssp_in + (size_t)row * 8 + 4);
    return rsqrtf((((a[0] + a[1]) + (a[2] + a[3])) + ((b[0] + b[1]) + (b[2] + b[3]))) * (1.f / D_) + EPS_); }
  DI float* ssp_ptr() const { return nullptr; }
  unsigned char* ws;
  DI void one(int row, int c, f32x4 v) const {
    const int b = row >> 12, t = row & 4095;
    if (c < 3072) {
      const int seg = c >> 10, cc = c & 1023, h = cc >> 7, d = cc & 127;
      if (seg < 2) st_bf16x4((bf16_t*)(ws + (seg == 0 ? E_FQ : E_FK)) + ((size_t)(b * 8 + h) * T_ + t) * 128 + d, v);
      else st_tr4((bf16_t*)(ws + E_FVT) + (size_t)(b * 8 + h) * 128 * T_ + (size_t)(t >> 5) * 4096 + d * 32 + ((((t & 31) >> 2) ^ ((d >> 2) & 7)) << 2) + (t & 3), 32, v);
    } else if (c < 4096) { st_bf16x4((bf16_t*)(ws + E_HQ) + (size_t)row * 1024 + (c - 3072), v);
    } else if (c < 5120) { *(f32x4*)((float*)(ws + E_HF) + (size_t)row * 1024 + (c - 4096)) = v;
    } else if (c < 6144) { const int cc = c - 5120, h = cc >> 7, d = cc & 127; st_tr4((bf16_t*)(ws + E_HIT) + (size_t)(b * 8 + h) * 128 * T_ + (size_t)(t >> 5) * 4096 + d * 32 + (t & 31), 32, v);
    } else if (c < 7168) { st_bf16x4((bf16_t*)(ws + E_HG) + (size_t)row * 1024 + (c - 6144), v);
    } else if (c < 7176) { *(f32x4*)((float*)(ws + E_FF) + (size_t)row * 8 + (c - 7168)) = v; }
  }
  DI float operator()(int row, int colbase, int fq, f32x4 v0, f32x4 v1) const { one(row, colbase + 4 * fq, v0); one(row, colbase + 16 + 4 * fq, v1); return 0.f; }
};
struct EpiOddIn {
  static constexpr bool HAS_SS = false;
  const float* ssp_in;
  DI float rowscale(int row) const { const f32x4 a = *(const f32x4*)(ssp_in + (size_t)row * 8), b = *(const f32x4*)(ssp_in + (size_t)row * 8 + 4);
    return rsqrtf((((a[0] + a[1]) + (a[2] + a[3])) + ((b[0] + b[1]) + (b[2] + b[3]))) * (1.f / D_) + EPS_); }
  DI float* ssp_ptr() const { return nullptr; }
  unsigned char* ws;
  DI void one(int row, int c, f32x4 v) const {
    const int b = row >> 12, t = row & 4095;
    if (c < 2048) { const int h = c >> 7, d = c & 127; st_bf16x4((bf16_t*)(ws + O_NQ) + ((size_t)(b * 16 + h) * T_ + t) * 128 + d, v); }
    else if (c < 5120) {
      const int seg = (c - 2048) >> 9, cc = (c - 2048) & 511, g = cc >> 7, d = cc & 127;
      if (seg == 3 || seg == 5) st_tr4((bf16_t*)(ws + (seg == 3 ? O_VST : O_VWT)) + (size_t)(b * 4 + g) * 128 * T_ + (size_t)(t >> 5) * 4096 + d * 32 + ((((t & 31) >> 2) ^ ((d >> 2) & 7)) << 2) + (t & 3), 32, v);
      else { const size_t off = seg == 0 ? O_KC : seg == 1 ? O_VC : seg == 2 ? O_KS : O_KW;
        st_bf16x4((bf16_t*)(ws + off) + ((size_t)(b * 4 + g) * T_ + t) * 128 + d, v); }
    } else if (c < 5168) { *(f32x4*)((float*)(ws + O_GT) + (size_t)row * 48 + (c - 5120)) = v; }
  }
  DI float operator()(int row, int colbase, int fq, f32x4 v0, f32x4 v1) const { one(row, colbase + 4 * fq, v0); one(row, colbase + 16 + 4 * fq, v1); return 0.f; }
};
struct EpiResid {
  static constexpr bool HAS_SS = true;
  const float* src; float* dst; bf16_t* xb; float* ssp;
  DI float rowscale(int) const { return 1.f; }
  DI float* ssp_ptr() const { return ssp; }
  DI float operator()(int row, int colbase, int fq, f32x4 v0, f32x4 v1) const {
    const size_t o = (size_t)row * D_ + colbase + 4 * fq;
    const f32x4 a = *(const f32x4*)(src + o) + v0, b = *(const f32x4*)(src + o + 16) + v1;
    *(f32x4*)(dst + o) = a; *(f32x4*)(dst + o + 16) = b;
    if (xb) { st_bf16x4(xb + o, a); st_bf16x4(xb + o + 16, b); }
    return ((a[0] * a[0] + a[1] * a[1]) + (a[2] * a[2] + a[3] * a[3])) + ((b[0] * b[0] + b[1] * b[1]) + (b[2] * b[2] + b[3] * b[3]));
  }
};
struct EpiMemQ {
  static constexpr bool HAS_SS = false;
  const float* ssp_in;
  DI float rowscale(int row) const { const f32x4 a = *(const f32x4*)(ssp_in + (size_t)row * 8), b = *(const f32x4*)(ssp_in + (size_t)row * 8 + 4);
    return rsqrtf((((a[0] + a[1]) + (a[2] + a[3])) + ((b[0] + b[1]) + (b[2] + b[3]))) * (1.f / D_) + EPS_); }
  DI float* ssp_ptr() const { return nullptr; }
  bf16_t* qm;
  DI float operator()(int row, int colbase, int fq, f32x4 v0, f32x4 v1) const {
    const int b = row >> 12, t = row & 4095, c = colbase + 4 * fq, h = c >> 7, d = c & 127;
    bf16_t* p = qm + ((size_t)(b * 4 + h) * T_ + t) * 128 + d;
    st_bf16x4(p, v0); st_bf16x4(p + 16, v1); return 0.f;
  }
};
struct EpiMemKV {
  static constexpr bool HAS_SS = false;
  DI float rowscale(int) const { return 1.f; }
  DI float* ssp_ptr() const { return nullptr; }
  bf16_t* mk; bf16_t* mvt;
  DI void one(int row, int c0, f32x4 v) const {
    const int b = row >> 8, s = row & 255, l = c0 >> 10, c = c0 & 1023;
    const size_t lo = (size_t)l * 8 * 256 * 128;
    if (c < 512) { const int h = c >> 7, d = c & 127; st_bf16x4(mk + lo + ((size_t)(b * 4 + h) * 256 + s) * 128 + d, v); }
    else { const int cc = c - 512, h = cc >> 7, d = cc & 127;
      st_tr4(mvt + lo + (size_t)(b * 4 + h) * 128 * 256 + (size_t)(s >> 5) * 4096 + d * 32 + ((((s & 31) >> 2) ^ ((d >> 2) & 7)) << 2) + (s & 3), 32, v); }
  }
  DI float operator()(int row, int colbase, int fq, f32x4 v0, f32x4 v1) const { one(row, colbase + 4 * fq, v0); one(row, colbase + 16 + 4 * fq, v1); return 0.f; }
};
struct EpiSwiglu {
  static constexpr bool HAS_SS = false;
  const float* ssp_in;
  DI float rowscale(int row) const { const f32x4 a = *(const f32x4*)(ssp_in + (size_t)row * 8), b = *(const f32x4*)(ssp_in + (size_t)row * 8 + 4);
    return rsqrtf((((a[0] + a[1]) + (a[2] + a[3])) + ((b[0] + b[1]) + (b[2] + b[3]))) * (1.f / D_) + EPS_); }
  DI float* ssp_ptr() const { return nullptr; }
  bf16_t* hid;
  DI float operator()(int row, int colbase, int fq, f32x4 v0, f32x4 v1) const {
    f32x4 r;
#pragma unroll
    for (int e = 0; e < 4; ++e) r[e] = v0[e] * sigmoidf_(v0[e]) * v1[e];
    st_bf16x4(hid + (size_t)row * FFN_ + (colbase >> 1) + 4 * fq, r); return 0.f;
  }
};
DI float gelu_tanh(float x) { const float u = 0.7978845608028654f * (x + 0.044715f * x * x * x); const float e = __expf(2.f * u); const float th = 1.f - 2.f * frcp(e + 1.f); return 0.5f * x * (1.f + th); }
struct EpiF32 {
  static constexpr bool HAS_SS = false;
  DI float rowscale(int) const { return 1.f; }
  DI float* ssp_ptr() const { return nullptr; }
  float* dst; int ld;
  DI float operator()(int row, int colbase, int fq, f32x4 v0, f32x4 v1) const {
    float* q = dst + (size_t)row * ld + colbase + 4 * fq; *(f32x4*)q = v0; *(f32x4*)(q + 16) = v1; return 0.f;
  }
};
struct EpiBf16Tok {
  static constexpr bool HAS_SS = false;
  DI float rowscale(int) const { return 1.f; }
  DI float* ssp_ptr() const { return nullptr; }
  bf16_t* dst; int ld;
  DI float operator()(int row, int colbase, int fq, f32x4 v0, f32x4 v1) const {
    bf16_t* q = dst + (size_t)row * ld + colbase + 4 * fq; st_bf16x4(q, v0); st_bf16x4(q + 16, v1); return 0.f;
  }
};
struct EpiCmp1 {
  static constexpr bool HAS_SS = false;
  DI float rowscale(int) const { return 1.f; }
  DI float* ssp_ptr() const { return nullptr; }
  bf16_t* hc; const float* bias;
  DI float operator()(int row, int colbase, int fq, f32x4 v0, f32x4 v1) const {
    const int c = colbase + 4 * fq;
    f32x4 b0 = *(const f32x4*)(bias + c), b1 = *(const f32x4*)(bias + c + 16), r0, r1;
#pragma unroll
    for (int e = 0; e < 4; ++e) { r0[e] = gelu_tanh(v0[e] + b0[e]); r1[e] = gelu_tanh(v1[e] + b1[e]); }
    st_bf16x4(hc + (size_t)row * 256 + c, r0); st_bf16x4(hc + (size_t)row * 256 + c + 16, r1); return 0.f;
  }
};
struct EpiCmp2 {
  static constexpr bool HAS_SS = false;
  DI float rowscale(int) const { return 1.f; }
  DI float* ssp_ptr() const { return nullptr; }
  bf16_t* dst; int isv;
  DI void one(int row, int c, f32x4 v) const {
    if (c >= 128) return;
    if (!isv) st_bf16x4(dst + (size_t)row * 128 + c, v);
    else st_tr4(dst + ((size_t)(row >> 8) * 128 + c) * 256 + (row & 255), 256, v);
  }
  DI float operator()(int row, int colbase, int fq, f32x4 v0, f32x4 v1) const { one(row, colbase + 4 * fq, v0); one(row, colbase + 16 + 4 * fq, v1); return 0.f; }
};

struct TDesc { const float* src; const float* src2; const float* rscale; bf16_t* dst; int K, Nsrc, map, k0, n0; };
constexpr int TR_LD = 260;
DI bool decode_tile(const Params& p, int gi, TDesc& d) {
#define TCLS(CNT, KK, NS, ND, MP, SRC, SRC2, RS, RSS, DB, DS) { const int ntn = (ND) / 256, per = ((KK) / 64) * ntn, tot = (CNT) * per; \
    if (gi < tot) { const int l = gi / per, tl = gi % per; d.src = (SRC) + (size_t)l * (KK) * (NS); d.src2 = (SRC2) ? (SRC2) + (size_t)l * (KK) * (NS) : nullptr; \
      d.rscale = (RS) ? (RS) + (size_t)l * (RSS) : nullptr; d.dst = (bf16_t*)(p.ws + (DB) + (size_t)l * (DS)); d.K = (KK); d.Nsrc = (NS); d.map = (MP); \
      d.k0 = (tl / ntn) * 64; d.n0 = (tl % ntn) * 256; return true; } gi -= tot; }
  const float* nul = nullptr;
  TCLS(4, 2048, 5632, N_F13, 2, p.in[28], p.in[29], p.in[4], 2048, W_F13, SZ_F13)
  TCLS(4, 5632, 2048, 2048, 0, p.in[30], nul, nul, 0, W_F2, SZ_F2)
  TCLS(2, 2048, 7176, N_EIN, 1, p.in[6], nul, p.in[2], 4096, W_EIN, SZ_EIN)
  TCLS(2, 2048, 5168, N_OIN, 0, p.in[13], nul, p.in[2] + 2048, 4096, W_OIN, SZ_OIN)
  TCLS(2, 2048, 2048, 2048, 0, p.in[7], nul, nul, 0, W_EOUT, SZ_SQ)
  TCLS(2, 2048, 2048, 2048, 0, p.in[14], nul, nul, 0, W_OOUT, SZ_SQ)
  TCLS(4, 2048, 1024, 1024, 0, p.in[24], nul, p.in[5], 2048, W_MKV, SZ_MKV)
  TCLS(4, 2048, 512, 512, 0, p.in[23], nul, p.in[3], 2048, W_MQ, SZ_MQ)
  TCLS(4, 512, 2048, 2048, 0, p.in[25], nul, nul, 0, W_MO, SZ_MQ)
  TCLS(2, 4096, 256, 256, 0, p.in[18], nul, nul, 0, W_C1, 2 * SZ_C1)
  TCLS(2, 4096, 256, 256, 0, p.in[21], nul, nul, 0, W_C1 + SZ_C1, 2 * SZ_C1)
  TCLS(2, 256, 128, 256, 0, p.in[19], nul, nul, 0, W_C2, 2 * SZ_C2)
  TCLS(2, 256, 128, 256, 0, p.in[22], nul, nul, 0, W_C2 + SZ_C2, 2 * SZ_C2)
#undef TCLS
  return false;
}
DI void tr_load(const TDesc& d, int tid, f32x4 (&v)[8]) {
  const int lane = tid & 63, w = tid >> 6, n = d.n0 + lane * 4;
  const float* s = d.src; int col;
  if (d.map == 0) col = n < d.Nsrc ? n : -1;
  else if (d.map == 1) col = n < 3072 ? n : (n < 7168 ? n + 8 : (n < 7176 ? n - 7168 + 3072 : -1));
  else { col = (n >> 5) * 16 + (n & 15); if (n & 16) s = d.src2; }
#pragma unroll
  for (int r = 0; r < 8; ++r) {
    const int k = d.k0 + w * 8 + r;
    v[r] = col >= 0 ? *(const f32x4*)(s + (size_t)k * d.Nsrc + col) : (f32x4){0.f, 0.f, 0.f, 0.f};
  }
  if (d.rscale) {
#pragma unroll
    for (int r = 0; r < 8; ++r) { const float g = d.rscale[d.k0 + w * 8 + r]; v[r] = v[r] * g; }
  }
}
DI void transpose_jobs(const Params& p) {
  extern __shared__ __attribute__((aligned(16))) char dyn_lds[];
  LAS float* lds = (LAS float*)dyn_lds;
  const int tid = TIDX, lane = tid & 63, w = tid >> 6;
  TDesc da, db; f32x4 va[8], vb[8];
  int gi = blockIdx.x;
  bool ha = decode_tile(p, gi, da); if (ha) tr_load(da, tid, va);
  gi += gridDim.x;
  bool hb = ha && decode_tile(p, gi, db); if (hb) tr_load(db, tid, vb);
#define TR_EMIT(V, D) do { \
    _Pragma("unroll") for (int r = 0; r < 8; ++r) *(LAS f32x4*)(lds + (w * 8 + r) * TR_LD + lane * 4) = V[r]; \
    __syncthreads(); \
    const TDesc cur_ = D; \
    gi += gridDim.x; \
    const bool hn_ = decode_tile(p, gi, D); if (hn_) tr_load(D, tid, V); \
    const int nl = tid & 255; \
    _Pragma("unroll") for (int q = 0; q < 4; ++q) { \
      const int kc = (tid >> 8) + 2 * q; const LAS float* c = lds + (kc * 8) * TR_LD + nl; u32x4 o; \
      o.x = pk2(c[0], c[TR_LD]); o.y = pk2(c[2 * TR_LD], c[3 * TR_LD]); o.z = pk2(c[4 * TR_LD], c[5 * TR_LD]); o.w = pk2(c[6 * TR_LD], c[7 * TR_LD]); \
      *(u32x4*)(cur_.dst + (size_t)(cur_.n0 + nl) * cur_.K + cur_.k0 + kc * 8) = o; } \
    __syncthreads(); \
    h_ = hn_; } while (0)
  while (ha) {
    bool h_;
    TR_EMIT(va, da); ha = h_;
    if (!hb) break;
    TR_EMIT(vb, db); hb = h_;
    if (!ha) { while (hb) { TR_EMIT(vb, db); hb = h_; } break; }
  }
#undef TR_EMIT
}

DI void rmsnorm_rows(const float* __restrict__ x, const float* __restrict__ gain, bf16_t* __restrict__ out, int rows) {
  const int lane = TIDX & 63, gw = blockIdx.x * 8 + (TIDX >> 6), nw = gridDim.x * 8;
  for (int r = gw; r < rows; r += nw) {
    const f32x4* xr = (const f32x4*)(x + (size_t)r * D_) + lane;
    f32x4 v[8]; float s = 0.f;
#pragma unroll
    for (int j = 0; j < 8; ++j) { v[j] = xr[64 * j]; s += v[j][0] * v[j][0] + v[j][1] * v[j][1] + v[j][2] * v[j][2] + v[j][3] * v[j][3]; }
    const float rs = rsqrtf(wave_sum(s) * (1.f / D_) + EPS_);
#pragma unroll
    for (int j = 0; j < 8; ++j) {
      const f32x4 g = gain ? *((const f32x4*)gain + lane + 64 * j) : (f32x4){1.f, 1.f, 1.f, 1.f};
      f32x4 o; for (int e = 0; e < 4; ++e) o[e] = v[j][e] * rs * g[e];
      st_bf16x4(out + (size_t)r * D_ + (lane + 64 * j) * 4, o);
    }
  }
}

DI void xprep_rows(const float* __restrict__ x, bf16_t* __restrict__ xb, float* __restrict__ ssp, int rows) {
  const int tid = TIDX, lane = tid & 63, gw = blockIdx.x * 8 + (tid >> 6), nw = gridDim.x * 8;
  for (int r = gw; r < rows; r += nw) {
    const f32x4* xr = (const f32x4*)(x + (size_t)r * D_) + lane;
    float s = 0.f;
#pragma unroll
    for (int j = 0; j < 8; ++j) { const f32x4 v = xr[64 * j]; s += v[0] * v[0] + v[1] * v[1] + v[2] * v[2] + v[3] * v[3]; st_bf16x4(xb + (size_t)r * D_ + (lane + 64 * j) * 4, v); }
    s = wave_sum(s);
    if (lane < 8) ssp[(size_t)r * 8 + lane] = lane == 0 ? s : 0.f;
  }
}

DI void headnorm_rows(bf16_t* buf, int rows, const float* __restrict__ gain, int item0, int nitems_total) {
  const int lane = TIDX & 63, gw = blockIdx.x * 8 + (TIDX >> 6), nw = gridDim.x * 8;
  const int sub = lane >> 4, l16 = lane & 15;
  (void)item0; (void)nitems_total;
  for (int it = gw; it < rows / 4; it += nw) {
    bf16_t* rp = buf + (size_t)(it * 4 + sub) * 128 + l16 * 8;
    bf16x8 raw = *(const bf16x8*)rp;
    float f[8], s = 0.f;
#pragma unroll
    for (int e = 0; e < 8; ++e) { f[e] = bf2f((bf16_t)raw[e]); s += f[e] * f[e]; }
    s += shx(s, 1); s += shx(s, 2); s += shx(s, 4); s += shx(s, 8);
    const float rs = rsqrtf(s * (1.f / 128.f) + EPS_);
    u32x4 o;
    o.x = pk2(f[0] * rs * gain[l16 * 8 + 0], f[1] * rs * gain[l16 * 8 + 1]); o.y = pk2(f[2] * rs * gain[l16 * 8 + 2], f[3] * rs * gain[l16 * 8 + 3]);
    o.z = pk2(f[4] * rs * gain[l16 * 8 + 4], f[5] * rs * gain[l16 * 8 + 5]); o.w = pk2(f[6] * rs * gain[l16 * 8 + 6], f[7] * rs * gain[l16 * 8 + 7]);
    *(u32x4*)rp = o;
  }
}

struct AttnState { f32x16 o[4]; float m, l; };
DI void attn_init(AttnState& s) { for (int i = 0; i < 4; ++i) s.o[i] = zero16(); s.m = NEG_INF; s.l = 0.f; }
DI int crow(int i, int g) { return (i & 3) + 8 * (i >> 2) + 4 * g; }

DI void load_q_raw(bf16x8 (&qf)[8], const bf16_t* qrow, int g) {
#pragma unroll
  for (int ks = 0; ks < 8; ++ks) qf[ks] = *(const bf16x8*)(qrow + ks * 16 + g * 8);
}
DI void load_q_norm(bf16x8 (&qf)[8], const bf16_t* qrow, int g, const float* __restrict__ gain, float scale) {
  float ss = 0.f;
#pragma unroll
  for (int ks = 0; ks < 8; ++ks) { qf[ks] = *(const bf16x8*)(qrow + ks * 16 + g * 8);
#pragma unroll
    for (int e = 0; e < 8; ++e) { const float f = bf2f((bf16_t)qf[ks][e]); ss += f * f; } }
  ss = xhalf_sum(ss);
  const float rs = rsqrtf(ss * (1.f / 128.f) + EPS_) * scale;
#pragma unroll
  for (int ks = 0; ks < 8; ++ks) {
    const f32x4 g0 = *(const f32x4*)(gain + ks * 16 + g * 8), g1 = *(const f32x4*)(gain + ks * 16 + g * 8 + 4);
    u32x4 o;
    o.x = pk2(bf2f((bf16_t)qf[ks][0]) * rs * g0[0], bf2f((bf16_t)qf[ks][1]) * rs * g0[1]);
    o.y = pk2(bf2f((bf16_t)qf[ks][2]) * rs * g0[2], bf2f((bf16_t)qf[ks][3]) * rs * g0[3]);
    o.z = pk2(bf2f((bf16_t)qf[ks][4]) * rs * g1[0], bf2f((bf16_t)qf[ks][5]) * rs * g1[1]);
    o.w = pk2(bf2f((bf16_t)qf[ks][6]) * rs * g1[2], bf2f((bf16_t)qf[ks][7]) * rs * g1[3]);
    qf[ks] = __builtin_bit_cast(bf16x8, o);
  }
}
DI f32x16 score_tile(const bf16x8 (&qf)[8], const bf16_t* __restrict__ Kp  , unsigned koff  ) {
  f32x16 acc = zero16();
  const char* kr = (const char*)Kp;
#pragma unroll
  for (int ks = 0; ks < 8; ++ks) { const bf16x8 a = *(const bf16x8*)(kr + (size_t)(koff + ks * 32)); acc = mfma32(a, qf[ks], acc); }
  return acc;
}
typedef __bf16 hwbf16x2 __attribute__((ext_vector_type(2)));
typedef float f32x2 __attribute__((ext_vector_type(2)));
DI unsigned pk2h(float lo, float hi) { const f32x2 f = {lo, hi}; const hwbf16x2 r = __builtin_convertvector(f, hwbf16x2); return __builtin_bit_cast(unsigned, r); }
DI bf16x8 pack8(const float* p) { u32x4 o; o.x = pk2h(p[0], p[1]); o.y = pk2h(p[2], p[3]); o.z = pk2h(p[4], p[5]); o.w = pk2h(p[6], p[7]); return __builtin_bit_cast(bf16x8, o); }
DI void pv_tile(f32x16 (&o)[4], const bf16x8 (&pf)[2], const bf16_t* __restrict__ VTp  , size_t ldv, unsigned voff  ) {
#pragma unroll
  for (int vt = 0; vt < 4; ++vt) {
    const char* vr = (const char*)(VTp + (size_t)(vt * 32) * ldv);
#pragma unroll
    for (int s = 0; s < 2; ++s) {
      const s16x4 lo = *(const s16x4*)(vr + (size_t)(voff + 32 * s)), hi = *(const s16x4*)(vr + (size_t)(voff + 32 * s + 16));
      const bf16x8 a = __builtin_shufflevector(lo, hi, 0, 1, 2, 3, 4, 5, 6, 7);
      o[vt] = mfma32(a, pf[s], o[vt]);
    }
  }
}
DI void softmax_step(AttnState& st, float (&sc)[16], const bf16_t* __restrict__ VTp, size_t ldv, unsigned voff) {
  float mx = st.m;
#pragma unroll
  for (int i = 0; i < 16; ++i) mx = fmaxf(mx, sc[i]);
  mx = xhalf_max(mx);
  const float ms = (mx == NEG_INF) ? 0.f : mx;
  const float alpha = fexp2(st.m - ms);
  st.m = mx;
  float ps = 0.f;
#pragma unroll
  for (int i = 0; i < 16; ++i) { sc[i] = fexp2(sc[i] - ms); ps += sc[i]; }
  st.l = st.l * alpha + ps;
#pragma unroll
  for (int vt = 0; vt < 4; ++vt)
#pragma unroll
    for (int i = 0; i < 16; ++i) st.o[vt][i] *= alpha;
  bf16x8 pf[2]; pf[0] = pack8(sc); pf[1] = pack8(sc + 8);
  pv_tile(st.o, pf, VTp, ldv, voff);
}
DI float attn_inv_l(const AttnState& st) { const float l = xhalf_sum(st.l); return l > 0.f ? frcp(l) : 0.f; }
DI void store_o(const f32x16 (&o)[4], float scale, bf16_t* orow, int g) {
#pragma unroll
  for (int vt = 0; vt < 4; ++vt)
#pragma unroll
    for (int q = 0; q < 4; ++q) {
      f32x4 v; for (int e = 0; e < 4; ++e) v[e] = o[vt][q * 4 + e] * scale;
      st_bf16x4(orow + vt * 32 + q * 8 + 4 * g, v);
    }
}

constexpr int AT_STAGE = 16384;
#define AT_WAIT_V(n) asm volatile("s_waitcnt vmcnt(" #n ")" ::: "memory")
#define AT_WAIT_L0() asm volatile("s_waitcnt lgkmcnt(0)" ::: "memory")
#define AT_BAR() __builtin_amdgcn_s_barrier()
struct LaneKV {
  unsigned ksrc, vsrc, ldsw;
  unsigned kx, xh, vrow, vo[4];
};
DI void lanekv_init(LaneKV& L, int tid, int wid) {
  const int lane = tid & 63, lr = lane & 31, g = lane >> 5, r = tid >> 4, pos = tid & 15;
  L.ksrc = (unsigned)(r * 256 + ((pos ^ (r & 15)) << 4)); L.vsrc = (unsigned)tid * 16u; L.ldsw = (unsigned)wid * 1024u;
  L.kx = (unsigned)(lr * 256 + ((g ^ (lr & 1)) << 4)); L.xh = (unsigned)((lr & 15) >> 1); L.vrow = (unsigned)lr * 64u;
  const int y = (lr >> 2) & 7;
#pragma unroll
  for (int q = 0; q < 4; ++q) L.vo[q] = (unsigned)(((g + 2 * q) ^ y) << 3);
}
DI void kv_issue(LAS unsigned char* st, const bf16_t* Kt, const bf16_t* Vt, const LaneKV& L) {
  __builtin_amdgcn_global_load_lds((const unsigned*)((const char*)Kt + L.ksrc), (LAS unsigned*)(st + L.ldsw), 16, 0, 0);
  __builtin_amdgcn_global_load_lds((const unsigned*)((const char*)Vt + L.vsrc), (LAS unsigned*)(st + 8192 + L.ldsw), 16, 0, 0);
}
DI f32x16 score_tile_lds(const bf16x8 (&qf)[8], const LAS unsigned char* st, const LaneKV& L) {
  f32x16 acc = zero16();
#pragma unroll
  for (int ks = 0; ks < 8; ++ks) { const bf16x8 a = *(const LAS bf16x8*)(st + L.kx + (((unsigned)ks ^ L.xh) << 5)); acc = mfma32(a, qf[ks], acc); }
  return acc;
}
DI void pv_tile_lds(f32x16 (&o)[4], const bf16x8 (&pf)[2], const LAS unsigned char* stv, const LaneKV& L) {
#pragma unroll
  for (int vt = 0; vt < 4; ++vt) {
#pragma unroll
    for (int s2 = 0; s2 < 2; ++s2) {
      const s16x4 lo = *(const LAS s16x4*)(stv + vt * 2048 + L.vrow + L.vo[2 * s2]), hi = *(const LAS s16x4*)(stv + vt * 2048 + L.vrow + L.vo[2 * s2 + 1]);
      const bf16x8 a = __builtin_shufflevector(lo, hi, 0, 1, 2, 3, 4, 5, 6, 7);
      o[vt] = mfma32(a, pf[s2], o[vt]);
    }
  }
}
DI void softmax_step_lds(AttnState& st, float (&sc)[16], const LAS unsigned char* stv, const LaneKV& L) {
  float mx = st.m;
#pragma unroll
  for (int i = 0; i < 16; ++i) mx = fmaxf(mx, sc[i]);
  mx = xhalf_max(mx);
  const float ms = (mx == NEG_INF) ? 0.f : mx;
  if (__builtin_amdgcn_ballot_w64(mx > st.m) != 0ull) {
    const float alpha = fexp2(st.m - ms);
    st.l *= alpha;
#pragma unroll
    for (int vt = 0; vt < 4; ++vt)
#pragma unroll
      for (int i = 0; i < 16; ++i) st.o[vt][i] *= alpha;
  }
  st.m = mx;
  float ps = 0.f;
#pragma unroll
  for (int i = 0; i < 16; ++i) { sc[i] = fexp2(sc[i] - ms); ps += sc[i]; }
  st.l += ps;
  bf16x8 pf[2]; pf[0] = pack8(sc); pf[1] = pack8(sc + 8);
  pv_tile_lds(st.o, pf, stv, L);
}

DI void softmax_step2_lds(AttnState& st, float (&sa)[16], float (&sb)[16], const LAS unsigned char* stva, const LAS unsigned char* stvb, const LaneKV& L) {
  float mx = st.m;
#pragma unroll
  for (int i = 0; i < 16; ++i) mx = fmaxf(mx, fmaxf(sa[i], sb[i]));
  mx = xhalf_max(mx);
  const float ms = (mx == NEG_INF) ? 0.f : mx;
  if (__builtin_amdgcn_ballot_w64(mx > st.m) != 0ull) {
    const float alpha = fexp2(st.m - ms);
    st.l *= alpha;
#pragma unroll
    for (int vt = 0; vt < 4; ++vt)
#pragma unroll
      for (int i = 0; i < 16; ++i) st.o[vt][i] *= alpha;
  }
  st.m = mx;
  float ps = 0.f;
#pragma unroll
  for (int i = 0; i < 16; ++i) { sa[i] = fexp2(sa[i] - ms); sb[i] = fexp2(sb[i] - ms); ps += sa[i] + sb[i]; }
  st.l += ps;
  bf16x8 pfa[2], pfb[2]; pfa[0] = pack8(sa); pfa[1] = pack8(sa + 8); pfb[0] = pack8(sb); pfb[1] = pack8(sb + 8);
  __builtin_amdgcn_sched_barrier(0);
  pv_tile_lds(st.o, pfa, stva, L);
  __builtin_amdgcn_sched_barrier(0);
  pv_tile_lds(st.o, pfb, stvb, L);
  __builtin_amdgcn_sched_barrier(0);
}

DI void memattn_block(const Params& p, int layer, int bh, int tile4) {
  extern __shared__ __attribute__((aligned(16))) char dyn_lds[];
  LAS unsigned char* ldsb = (LAS unsigned char*)dyn_lds;
  const int tid = TIDX, wid = __builtin_amdgcn_readfirstlane(tid >> 6), lane = tid & 63, lr = lane & 31, g = lane >> 5;
  const int tile = tile4 * 4 + (wid & 3);
  const int tq = tile * 32 + lr, b = bh >> 2, h = bh & 3;
  const bf16_t* Kb = (const bf16_t*)(p.ws + A_MEMK) + ((size_t)layer * 8 + bh) * 256 * 128;
  const bf16_t* VT = (const bf16_t*)(p.ws + A_MEMVT) + ((size_t)layer * 8 + bh) * 128 * 256;
  LaneKV L; lanekv_init(L, tid, wid);
#pragma unroll
  for (int kt = 0; kt < 8; ++kt) kv_issue(ldsb + kt * AT_STAGE, Kb + (size_t)kt * 4096, VT + (size_t)kt * 4096, L);
  bf16x8 qf[8];
  if (wid < 4) {
    const size_t mrow = (size_t)b * T_ + tq;
    const bf16_t* qp = (const bf16_t*)(p.ws + A_SCR) + mrow * 512 + h * 128 + g * 8;
    const float* sp8 = (const float*)(p.ws + A_SSP) + SZ_SSP / 4 + mrow * 8;
    const f32x4 s0 = *(const f32x4*)sp8, s1 = *(const f32x4*)(sp8 + 4);
    const float rr = rsqrtf((((s0[0] + s0[1]) + (s0[2] + s0[3])) + ((s1[0] + s1[1]) + (s1[2] + s1[3]))) * (1.f / D_) + EPS_);
    f32x4 qa[8], qb[8]; float ss = 0.f;
#pragma unroll
    for (int ks = 0; ks < 8; ++ks) {
      f32x4 a = (f32x4){0.f, 0.f, 0.f, 0.f}, c = a;
#pragma unroll
      for (int sp = 0; sp < 4; ++sp) { const bf16x8 r8 = *(const bf16x8*)(qp + (size_t)sp * M_ * 512 + ks * 16);
#pragma unroll
        for (int i = 0; i < 4; ++i) { a[i] += bf2f((bf16_t)r8[i]); c[i] += bf2f((bf16_t)r8[4 + i]); } }
      a = a * rr; c = c * rr; qa[ks] = a; qb[ks] = c;
      ss += (a[0] * a[0] + a[1] * a[1]) + (a[2] * a[2] + a[3] * a[3]) + (c[0] * c[0] + c[1] * c[1]) + (c[2] * c[2] + c[3] * c[3]);
    }
    ss = xhalf_sum(ss);
    const float rs = rsqrtf(ss * (1.f / 128.f) + EPS_) * (ATTN_SCALE * LOG2E);
    const float* gain = p.in[26] + layer * 128 + g * 8;
#pragma unroll
    for (int ks = 0; ks < 8; ++ks) {
      const f32x4 g0 = *(const f32x4*)(gain + ks * 16), g1 = *(const f32x4*)(gain + ks * 16 + 4);
      float v[8];
#pragma unroll
      for (int i = 0; i < 4; ++i) { v[i] = qa[ks][i] * rs * g0[i]; v[4 + i] = qb[ks][i] * rs * g1[i]; }
      qf[ks] = pack8(v);
    }
  }
  AT_WAIT_V(0);
  AT_BAR();
  if (wid < 4) {
    AttnState st; attn_init(st);
#pragma unroll 1
    for (int kt = 0; kt < 8; ++kt) {
      const LAS unsigned char* sg = ldsb + kt * AT_STAGE;
      f32x16 acc = score_tile_lds(qf, sg, L);
      float sc[16];
#pragma unroll
      for (int i = 0; i < 16; ++i) sc[i] = acc[i];
      softmax_step_lds(st, sc, sg + 8192, L);
    }
    const float inv = attn_inv_l(st);
    store_o(st.o, inv, (bf16_t*)(p.ws + A_MAO) + (size_t)(b * T_ + tq) * 512 + h * 128, g);
  }
  AT_WAIT_L0();
  __syncthreads();
}

DI void fox_block(const Params& p, int e, int bh, int j) {
  extern __shared__ __attribute__((aligned(16))) char dyn_lds[];
  LAS unsigned char* lds = (LAS unsigned char*)dyn_lds;
  LAS float* c2l = (LAS float*)(lds + 4 * AT_STAGE);
  const int tid = TIDX, wid = __builtin_amdgcn_readfirstlane(tid >> 6), lane = tid & 63, lr = lane & 31, g = lane >> 5;
  const int kidx = wid < 4 ? wid : 11 - wid, tile = j + 16 * kidx, nsteps = (j + 114) >> 1;
  const int tq = tile * 32 + lr, b = bh >> 3, h = bh & 7;
  const bf16_t* Q = (const bf16_t*)(p.ws + E_FQ) + (size_t)bh * T_ * 128;
  const bf16_t* Kb = (const bf16_t*)(p.ws + E_FK) + (size_t)bh * T_ * 128;
  const bf16_t* VT = (const bf16_t*)(p.ws + E_FVT) + (size_t)bh * 128 * T_;
  const float* c2 = (const float*)(p.ws + E_FC) + (size_t)bh * T_;
  LaneKV L; lanekv_init(L, tid, wid);
  kv_issue(lds, Kb, VT, L);
  kv_issue(lds + AT_STAGE, Kb + 4096, VT + 4096, L);
  { const int nc = nsteps * 64 < T_ ? nsteps * 64 : T_; for (int i = tid; i < nc; i += NTH) c2l[i] = c2[i]; }
  bf16x8 qf[8];
  load_q_norm(qf, Q + (size_t)tq * 128, g, p.in[9] + e * 128, ATTN_SCALE * LOG2E);
  AttnState st; attn_init(st);
  AT_WAIT_L0();
#pragma unroll 1
  for (int i = 0; i < nsteps; ++i) {
    AT_WAIT_V(0);
    AT_BAR();
    if (i + 1 < nsteps) {
      LAS unsigned char* nx = lds + ((i + 1) & 1) * 2 * AT_STAGE;
      kv_issue(nx, Kb + (size_t)(2 * i + 2) * 4096, VT + (size_t)(2 * i + 2) * 4096, L);
      kv_issue(nx + AT_STAGE, Kb + (size_t)(2 * i + 3) * 4096, VT + (size_t)(2 * i + 3) * 4096, L);
    }
    const int ka = 2 * i, kb = ka + 1;
    const LAS unsigned char* sg = lds + (i & 1) * 2 * AT_STAGE;
    if (kb <= tile) {
      f32x16 acca = score_tile_lds(qf, sg, L); __builtin_amdgcn_sched_barrier(0); f32x16 accb = score_tile_lds(qf, sg + AT_STAGE, L); __builtin_amdgcn_sched_barrier(0);
      float sa[16], sb[16];
#pragma unroll
      for (int q = 0; q < 4; ++q) {
        const f32x4 ca = *(const LAS f32x4*)(c2l + ka * 32 + 8 * q + 4 * g), cb = *(const LAS f32x4*)(c2l + kb * 32 + 8 * q + 4 * g);
#pragma unroll
        for (int e2 = 0; e2 < 4; ++e2) { sa[q * 4 + e2] = acca[q * 4 + e2] - ca[e2]; sb[q * 4 + e2] = accb[q * 4 + e2] - cb[e2]; }
      }
      if (kb == tile) {
#pragma unroll
        for (int q = 0; q < 16; ++q) sb[q] = (crow(q, g) <= lr) ? sb[q] : NEG_INF;
      }
      softmax_step2_lds(st, sa, sb, sg + 8192, sg + AT_STAGE + 8192, L);
    } else if (ka <= tile) {
      f32x16 acc = score_tile_lds(qf, sg, L);
      float sc[16];
#pragma unroll
      for (int q = 0; q < 4; ++q) {
        const f32x4 cs = *(const LAS f32x4*)(c2l + ka * 32 + 8 * q + 4 * g);
#pragma unroll
        for (int e2 = 0; e2 < 4; ++e2) sc[q * 4 + e2] = acc[q * 4 + e2] - cs[e2];
      }
#pragma unroll
      for (int q = 0; q < 16; ++q) sc[q] = (crow(q, g) <= lr) ? sc[q] : NEG_INF;
      softmax_step_lds(st, sc, sg + 8192, L);
    }
  }
  const float inv = attn_inv_l(st);
  store_o(st.o, inv, (bf16_t*)(p.ws + A_MIXO) + (size_t)(b * T_ + tq) * D_ + h * 128, g);
  AT_WAIT_L0();
  __syncthreads();
}

DI void fox_task(const Params& p, int e, int bh, int tile) {
  const int lane = TIDX & 63, lr = lane & 31, g = lane >> 5;
  const unsigned koff = (unsigned)(lr * 128 + g * 8) * 2u, voffT = (unsigned)(lr * 32 + 4 * g) * 2u, voff256 = (unsigned)(lr * 256 + 4 * g) * 2u; (void)koff; (void)voffT; (void)voff256;
  const int t0 = tile * 32, tq = t0 + lr, b = bh >> 3, h = bh & 7;
  const bf16_t* Q = (const bf16_t*)(p.ws + E_FQ) + (size_t)bh * T_ * 128;
  const bf16_t* Kb = (const bf16_t*)(p.ws + E_FK) + (size_t)bh * T_ * 128;
  const bf16_t* VT = (const bf16_t*)(p.ws + E_FVT) + (size_t)bh * 128 * T_;
  const float* c2 = (const float*)(p.ws + E_FC) + (size_t)bh * T_;
  bf16x8 qf[8];
  load_q_norm(qf, Q + (size_t)tq * 128, g, p.in[9] + e * 128, ATTN_SCALE * LOG2E);
  const float ct = c2[tq];
  AttnState st; attn_init(st);
  for (int kt = 0; kt <= tile; ++kt) {
    const int key0 = kt * 32;
    f32x16 acc = score_tile(qf, Kb + (size_t)key0 * 128, koff);
    float sc[16];
#pragma unroll
    for (int q = 0; q < 4; ++q) {
      const f32x4 cs = *(const f32x4*)(c2 + key0 + 8 * q + 4 * g);
#pragma unroll
      for (int e2 = 0; e2 < 4; ++e2) {
        const int i = q * 4 + e2; const int key = key0 + crow(i, g);
        const float s = acc[i] + (ct - cs[e2]);
        sc[i] = (key <= tq) ? s : NEG_INF;
      }
    }
    softmax_step(st, sc, VT + (size_t)key0 * 128, 32, voffT);
  }
  const float inv = attn_inv_l(st);
  store_o(st.o, inv, (bf16_t*)(p.ws + A_MIXO) + (size_t)(b * T_ + tq) * D_ + h * 128, g);
}

DI void hgrn_prep(const Params& p, int e) {
  const float* HF = (const float*)(p.ws + E_HF);
  const bf16_t* HQ = (const bf16_t*)(p.ws + E_HQ);
  bf16_t* QT = (bf16_t*)(p.ws + E_QT); bf16_t* KT = (bf16_t*)(p.ws + E_KT); bf16_t* QS = (bf16_t*)(p.ws + E_QS); bf16_t* KUT = (bf16_t*)(p.ws + E_KUT);
  float* DL = (float*)(p.ws + E_DL);
  const float* lg = p.in[11];
  for (int idx = blockIdx.x * NTH + TIDX; idx < 16 * 64 * 128; idx += gridDim.x * NTH) {
    const int k = idx & 127, c = (idx >> 7) & 63, bh = idx >> 13, b = bh >> 3, h = bh & 7, col = h * 128 + k;
    const float lb = (e == 0) ? 0.f : 1.f / (1.f + __expf(lg[col] - lg[1024 + col]));
    const size_t m0 = (size_t)b * T_ + c * 64;
    float bsum = 0.f, bmid = 0.f;
#pragma unroll 1
    for (int t16 = 0; t16 < 4; ++t16) {
      float zc[16];
#pragma unroll
      for (int tt = 0; tt < 16; ++tt) zc[tt] = HF[(m0 + t16 * 16 + tt) * 1024 + col];
#pragma unroll
      for (int tt = 0; tt < 16; ++tt) {
        const float z = zc[tt];
        const float a = __expf(-fabsf(z)), ri = __builtin_amdgcn_rcpf(1.f + a);
        const float sg = z >= 0.f ? ri : a * ri;
        bsum += (e == 0) ? (fminf(z, 0.f) - __logf(1.f + a)) : __logf(lb + (1.f - lb) * sg);
      }
      if (t16 == 1) bmid = bsum;
    }
    const float blast = bsum;
    DL[((size_t)bh * 64 + c) * 128 + k] = __expf(blast);
    const float emid = __expf(bmid), elast = __expf(blast - bmid);
    bsum = 0.f;
    const size_t hb = ((size_t)bh * T_ + c * 64) * 128 + k;
    bf16_t* kut = KUT + (((size_t)bh * 64 + c) * 128 + k) * 64;
#pragma unroll 1
    for (int t8 = 0; t8 < 8; ++t8) {
      float ku[8], zc[8], qc[8];
#pragma unroll
      for (int tt = 0; tt < 8; ++tt) { zc[tt] = HF[(m0 + t8 * 8 + tt) * 1024 + col]; qc[tt] = bf2f(HQ[(m0 + t8 * 8 + tt) * 1024 + col]); }
#pragma unroll
      for (int tt = 0; tt < 8; ++tt) {
        const int t = t8 * 8 + tt;
        const float z = zc[tt];
        const float a = __expf(-fabsf(z)), ri = __builtin_amdgcn_rcpf(1.f + a);
        const float sg = z >= 0.f ? ri : a * ri, sgn = z >= 0.f ? a * ri : ri;
        bsum += (e == 0) ? (fminf(z, 0.f) - __logf(1.f + a)) : __logf(lb + (1.f - lb) * sg);
        const float kh = (1.f - lb) * sgn;
        const float qv = qc[tt]; const float qh = qv * __builtin_amdgcn_rcpf(1.f + __expf(-qv));
        const float ed = __expf(bsum - bmid), edi = __builtin_amdgcn_rcpf(ed);
        QT[hb + (size_t)t * 128] = f2bf(qh * ed);
        KT[hb + (size_t)t * 128] = f2bf(kh * edi);
        QS[hb + (size_t)t * 128] = f2bf(qh * ed * emid);
        ku[tt] = kh * edi * elast;
      }
      *(bf16x8*)(kut + t8 * 8) = pack8(ku);
    }
  }
}
DI void fox_cumsum(const Params& p, int e) {
  extern __shared__ __attribute__((aligned(16))) char dyn_lds[];
  LAS float* wsum = (LAS float*)dyn_lds;
  const int tid = TIDX, lane = tid & 63, w = tid >> 6;
  for (int bh = blockIdx.x; bh < 16; bh += gridDim.x) {
    const int b = bh >> 3, h = bh & 7;
    const float* FF = (const float*)(p.ws + E_FF) + (size_t)b * T_ * 8 + h;
    float* FC = (float*)(p.ws + E_FC) + (size_t)bh * T_;
    const float bias = p.in[8][e * 8 + h];
    float v[8], s = 0.f;
#pragma unroll
    for (int i = 0; i < 8; ++i) { const float x = FF[(size_t)(tid * 8 + i) * 8] + bias; s += fminf(x, 0.f) - log1pf(__expf(-fabsf(x))); v[i] = s; }
    float incl = s;
#pragma unroll
    for (int o = 1; o < 64; o <<= 1) { const float u = shidx(incl, lane - o); if (lane >= o) incl += u; }
    if (lane == 63) wsum[w] = incl;
    __syncthreads();
    float base = incl - s;
    for (int q = 0; q < w; ++q) base += wsum[q];
#pragma unroll
    for (int i = 0; i < 8; ++i) FC[tid * 8 + i] = (base + v[i]) * LOG2E;
    __syncthreads();
  }
}
DI void hgrn_u_task(const Params& p, int bh, int c, int vt) {
  const int lane = TIDX & 63, lr = lane & 31, g = lane >> 5;
  const bf16_t* VT = (const bf16_t*)(p.ws + E_HIT) + (size_t)bh * 128 * T_ + (size_t)(c * 2) * 4096 + (vt * 32 + lr) * 32 + g * 8;
  const bf16_t* KUT = (const bf16_t*)(p.ws + E_KUT) + (((size_t)bh * 64 + c) * 128 + lr) * 64 + g * 8;
  f32x16 acc[4];
#pragma unroll
  for (int kt = 0; kt < 4; ++kt) acc[kt] = zero16();
#pragma unroll
  for (int ts = 0; ts < 4; ++ts) {
    const bf16x8 a = *(const bf16x8*)(VT + (ts >> 1) * 4096 + (ts & 1) * 16);
#pragma unroll
    for (int kt = 0; kt < 4; ++kt) { const bf16x8 bb = *(const bf16x8*)(KUT + (size_t)kt * 32 * 64 + ts * 16); acc[kt] = mfma32(a, bb, acc[kt]); }
  }
  bf16_t* U = (bf16_t*)(p.ws + E_U) + ((size_t)bh * 64 + c) * 128 * 128;
#pragma unroll
  for (int kt = 0; kt < 4; ++kt)
#pragma unroll
    for (int i = 0; i < 16; ++i) U[(size_t)(vt * 32 + crow(i, g)) * 128 + kt * 32 + lr] = f2bf(acc[kt][i]);
}
DI void hgrn_scan(const Params& p) {
  const bf16_t* U = (const bf16_t*)(p.ws + E_U); const float* DL = (const float*)(p.ws + E_DL); bf16_t* ST = (bf16_t*)(p.ws + E_ST);
  for (int idx = blockIdx.x * NTH + TIDX; idx < 16 * 128 * 128; idx += gridDim.x * NTH) {
    const int k = idx & 127, v = (idx >> 7) & 127, bh = idx >> 14;
    float S = 0.f;
#pragma unroll 8
    for (int c = 0; c < 64; ++c) {
      const size_t o = (((size_t)bh * 64 + c) * 128 + v) * 128 + k;
      ST[o] = f2bf(S);
      S = DL[((size_t)bh * 64 + c) * 128 + k] * S + bf2f(U[o]);
    }
  }
}
DI void hgrn_out_task(const Params& p, int e, int bh, int c, int tt) {
  const int lane = TIDX & 63, lr = lane & 31, g = lane >> 5, b = bh >> 3, h = bh & 7;
  const unsigned koff = (unsigned)(lr * 128 + g * 8) * 2u, voffT = (unsigned)(lr * 32 + 4 * g) * 2u, voff256 = (unsigned)(lr * 256 + 4 * g) * 2u; (void)koff; (void)voffT; (void)voff256;
  const size_t rowbase = (size_t)bh * T_ + c * 64;
  const bf16_t* QT = (const bf16_t*)(p.ws + E_QT) + rowbase * 128;
  const bf16_t* KT = (const bf16_t*)(p.ws + E_KT) + rowbase * 128;
  const bf16_t* QS = (const bf16_t*)(p.ws + E_QS) + rowbase * 128;
  const bf16_t* VT = (const bf16_t*)(p.ws + E_HIT) + (size_t)bh * 128 * T_ + (size_t)(c * 2) * 4096;
  const bf16_t* ST = (const bf16_t*)(p.ws + E_ST) + ((size_t)bh * 64 + c) * 128 * 128;
  f32x16 o[4];
#pragma unroll
  for (int i = 0; i < 4; ++i) o[i] = zero16();
  bf16x8 qf[8];
  load_q_raw(qf, QT + (size_t)(tt * 32 + lr) * 128, g);
  for (int st = 0; st <= tt; ++st) {
    f32x16 acc = score_tile(qf, KT + (size_t)st * 32 * 128, koff);
    float a[16];
#pragma unroll
    for (int i = 0; i < 16; ++i) a[i] = (st < tt || crow(i, g) <= lr) ? acc[i] : 0.f;
    bf16x8 pf[2]; pf[0] = pack8(a); pf[1] = pack8(a + 8);
    pv_tile(o, pf, VT + (size_t)st * 4096, 32, voffT);
  }
  load_q_raw(qf, QS + (size_t)(tt * 32 + lr) * 128, g);
#pragma unroll
  for (int vt = 0; vt < 4; ++vt) {
    const bf16_t* sr = ST + (size_t)(vt * 32 + lr) * 128 + g * 8;
#pragma unroll
    for (int ks = 0; ks < 8; ++ks) { const bf16x8 a = *(const bf16x8*)(sr + ks * 16); o[vt] = mfma32(a, qf[ks], o[vt]); }
  }
  float ss = 0.f;
#pragma unroll
  for (int vt = 0; vt < 4; ++vt)
#pragma unroll
    for (int i = 0; i < 16; ++i) ss += o[vt][i] * o[vt][i];
  ss = xhalf_sum(ss);
  const float rs = rsqrtf(ss * (1.f / 128.f) + EPS_);
  const size_t m = (size_t)b * T_ + c * 64 + tt * 32 + lr;
  const bf16_t* hg = (const bf16_t*)(p.ws + E_HG) + m * 1024 + h * 128;
  const float* og = p.in[12] + e * 128;
  bf16_t* orow = (bf16_t*)(p.ws + A_MIXO) + m * D_ + 1024 + h * 128;
#pragma unroll
  for (int vt = 0; vt < 4; ++vt)
#pragma unroll
    for (int q = 0; q < 4; ++q) {
      const int d0 = vt * 32 + q * 8 + 4 * g;
      const s16x4 gv = *(const s16x4*)(hg + d0); const f32x4 gn = *(const f32x4*)(og + d0);
      f32x4 v;
#pragma unroll
      for (int e2 = 0; e2 < 4; ++e2) { const float gg = bf2f((bf16_t)gv[e2]); v[e2] = o[vt][q * 4 + e2] * rs * gn[e2] * (gg * frcp(1.f + __expf(-gg))); }
      st_bf16x4(orow + d0, v);
    }
}

constexpr int PS_LD = 260;
constexpr int NSA_PS_OFF = 65536, NSA_ML_OFF = NSA_PS_OFF + 2 * 32 * PS_LD * 4, NSA_SEL_OFF = NSA_ML_OFF + 8 * 32 * 2 * 4, NSA_LDS = NSA_SEL_OFF + 2 * 32 * 8;
DI void stash_set(LAS unsigned* stw, const f32x16 (&o)[4], float f) {
#pragma unroll
  for (int vt = 0; vt < 4; ++vt)
#pragma unroll
    for (int i = 0; i < 8; ++i) stw[(vt * 8 + i) * 64] = pk2(o[vt][2 * i] * f, o[vt][2 * i + 1] * f);
}
DI void stash_add(LAS unsigned* stw, const f32x16 (&o)[4], float f) {
#pragma unroll
  for (int vt = 0; vt < 4; ++vt)
#pragma unroll
    for (int i = 0; i < 8; ++i) { const unsigned w = stw[(vt * 8 + i) * 64];
      stw[(vt * 8 + i) * 64] = pk2(__uint_as_float(w << 16) + o[vt][2 * i] * f, __uint_as_float(w & 0xffff0000u) + o[vt][2 * i + 1] * f); }
}
struct NsaCtx { int b, gk, tile64, o_idx; };
#define NSA_LANE_CTX() \
  const int tidx = TIDX; \
  const int wave = __builtin_amdgcn_readfirstlane(tidx >> 6), lane = tidx & 63, lr = lane & 31, g = lane >> 5; \
  const int sub = wave >> 2, j = wave & 3, h = c.gk * 4 + j; \
  const int t0 = c.tile64 * 64 + sub * 32, tq = t0 + lr; \
  const unsigned koff = (unsigned)(lr * 128 + g * 8) * 2u, voffT = (unsigned)(lr * 32 + 4 * g) * 2u, voff256 = (unsigned)(lr * 256 + 4 * g) * 2u; \
  const size_t kvh = (size_t)(c.b * 4 + c.gk); \
  const float slope2 = fexp2(-0.5f * (float)(h + 1)) * LOG2E; \
  const int thr = __builtin_amdgcn_readfirstlane((int)(200.f / slope2) + 1);     \
  LAS unsigned char* ldsb = (LAS unsigned char*)dyn_lds; \
  LAS float* psum = (LAS float*)(ldsb + NSA_PS_OFF); LAS float* ml = (LAS float*)(ldsb + NSA_ML_OFF); \
  LAS unsigned long long* sel = (LAS unsigned long long*)(ldsb + NSA_SEL_OFF); \
  LAS unsigned* stw = (LAS unsigned*)ldsb + wave * 32 * 64 + lane; \
  const bf16_t* NQ = (const bf16_t*)(p.ws + O_NQ); const float* qgain = p.in[15] + c.o_idx * 128; \
  (void)koff; (void)voffT; (void)voff256; (void)kvh; (void)slope2; (void)thr; (void)psum; (void)ml; (void)sel; (void)stw; (void)NQ; (void)qgain; (void)sub; (void)j; (void)h; (void)tq; (void)t0

DI void nsa_cmp1(const Params& p, const NsaCtx c) {
  extern __shared__ __attribute__((aligned(16))) char dyn_lds[];
  NSA_LANE_CTX();
  const bf16_t* KCMP = (const bf16_t*)(p.ws + O_KCMP) + kvh * 256 * 128;
  const bf16_t* VCMPT = (const bf16_t*)(p.ws + O_VCMPT) + kvh * 128 * 256;
  const float ftq = (float)tq;
  const int ntile_c = (t0 >> 4) / 32 + 1;
  bf16x8 qf[8];
  load_q_norm(qf, NQ + ((size_t)(c.b * 16 + h) * T_ + tq) * 128, g, qgain, ATTN_SCALE * LOG2E);
  AttnState st; attn_init(st);
#pragma unroll 1
  for (int kt = 0; kt < ntile_c; ++kt) {
    if (t0 - (16 * (32 * kt + 31) + 16) > thr + 32) continue;
    f32x16 acc = score_tile(qf, KCMP + (size_t)kt * 32 * 128, koff);
    float sc[16];
#pragma unroll
    for (int i = 0; i < 16; ++i) {
      const int n = kt * 32 + crow(i, g);
      const float s = acc[i] - slope2 * (ftq - ((float)(16 * n) + 15.5f));
      sc[i] = (16 * n + 31 <= tq) ? s : NEG_INF;
    }
    softmax_step(st, sc, VCMPT + (size_t)kt * 4096, 32, voffT);
  }
  const float inv = attn_inv_l(st);
  const float g_cmp = sigmoidf_(((const float*)(p.ws + O_GT))[((size_t)c.b * T_ + tq) * 48 + h * 3]);
  stash_set(stw, st.o, inv * g_cmp);
  if (g == 0) { ml[(wave * 32 + lr) * 2] = (st.m == NEG_INF) ? 0.f : st.m; ml[(wave * 32 + lr) * 2 + 1] = inv; }
}
DI void nsa_cmp2(const Params& p, const NsaCtx c) {
  extern __shared__ __attribute__((aligned(16))) char dyn_lds[];
  NSA_LANE_CTX();
  const bf16_t* KCMP = (const bf16_t*)(p.ws + O_KCMP) + kvh * 256 * 128;
  const float ftq = (float)tq;
  const int ntile_c = (t0 >> 4) / 32 + 1;
#pragma unroll 1
  for (int kk = 0; kk < 2; ++kk) {
    const int kt = j + 4 * kk;
    float ps[16];
#pragma unroll
    for (int i = 0; i < 16; ++i) ps[i] = 0.f;
    if (kt < ntile_c) {
#pragma unroll 1
      for (int jj = 0; jj < 4; ++jj) {
        const int hh = c.gk * 4 + jj;
        bf16x8 q2[8];
        load_q_norm(q2, NQ + ((size_t)(c.b * 16 + hh) * T_ + tq) * 128, g, qgain, ATTN_SCALE * LOG2E);
        const float sl2 = fexp2(-0.5f * (float)(hh + 1)) * LOG2E;
        if (t0 - (16 * (32 * kt + 31) + 16) > __builtin_amdgcn_readfirstlane((int)(200.f / sl2) + 1) + 32) continue;
        const float mm = ml[((sub * 4 + jj) * 32 + lr) * 2], iv = ml[((sub * 4 + jj) * 32 + lr) * 2 + 1];
        f32x16 acc = score_tile(q2, KCMP + (size_t)kt * 32 * 128, koff);
#pragma unroll
        for (int i = 0; i < 16; ++i) {
          const int n = kt * 32 + crow(i, g);
          const float s = acc[i] - sl2 * (ftq - ((float)(16 * n) + 15.5f));
          const float pr = (16 * n + 31 <= tq) ? fexp2(s - mm) * iv : 0.f;
          ps[i] += pr;
        }
      }
    }
#pragma unroll
    for (int q = 0; q < 4; ++q) {
      f32x4 v; for (int e2 = 0; e2 < 4; ++e2) v[e2] = ps[q * 4 + e2];
      *(LAS f32x4*)(psum + (sub * 32 + lr) * PS_LD + kt * 32 + q * 8 + 4 * g) = v;
    }
  }
}
DI void nsa_topk(const Params& p, const NsaCtx c) {
  extern __shared__ __attribute__((aligned(16))) char dyn_lds[];
  NSA_LANE_CTX();
#pragma unroll 1
  for (int rr = 0; rr < 8; ++rr) {
    const int row = j * 8 + rr, t = c.tile64 * 64 + sub * 32 + row;
    const LAS float* pr = psum + (sub * 32 + row) * PS_LD;
    float imp = 0.f;
#pragma unroll
    for (int d = -1; d <= 3; ++d) { const int n = 4 * lane + d; if (n >= 0 && n <= 254) imp += pr[n]; }
    if (64 * lane > t) imp = NEG_INF;
    if (lane == (t >> 6) || lane == 0) imp = __builtin_inff();
    LAS float* sbw = ml + wave * 64;
    sbw[lane] = imp;
    int rank = 0;
#pragma unroll
    for (int m4 = 0; m4 < 16; ++m4) {
      const f32x4 v4 = *(const LAS f32x4*)(sbw + m4 * 4);
#pragma unroll
      for (int e2 = 0; e2 < 4; ++e2) { const int mm = m4 * 4 + e2; rank += (v4[e2] > imp || (v4[e2] == imp && mm < lane)) ? 1 : 0; }
    }
    const unsigned long long msk = __ballot(rank < 16);
    if (lane == 0) sel[sub * 32 + row] = msk;
  }
}
DI void nsa_winslc(const Params& p, const NsaCtx c) {
  extern __shared__ __attribute__((aligned(16))) char dyn_lds[];
  NSA_LANE_CTX();
  LAS unsigned char* stg = ldsb + NSA_PS_OFF;
  LAS int* tl = (LAS int*)(ldsb + NSA_PS_OFF + 3 * AT_STAGE);
  const bf16_t* KW = (const bf16_t*)(p.ws + O_KW) + kvh * T_ * 128;
  const bf16_t* VWT = (const bf16_t*)(p.ws + O_VWT) + kvh * 128 * T_;
  const bf16_t* KS = (const bf16_t*)(p.ws + O_KS) + kvh * T_ * 128;
  const bf16_t* VST = (const bf16_t*)(p.ws + O_VST) + kvh * 128 * T_;
  const unsigned long long mymask = sel[sub * 32 + lr];
  LaneKV L; lanekv_init(L, tidx, wave);
  bf16x8 qf[8];
  load_q_norm(qf, NQ + ((size_t)(c.b * 16 + h) * T_ + tq) * 128, g, qgain, ATTN_SCALE * LOG2E);
  const size_t m = (size_t)c.b * T_ + tq;
  const float* gt = (const float*)(p.ws + O_GT) + m * 48 + h * 3;
  AttnState st;
  {
    const int hi = c.tile64 * 2 + 1, lo = c.tile64 * 2 - 16 > 0 ? c.tile64 * 2 - 16 : 0, nsteps = hi - lo + 1;
    const int myhi = t0 >> 5, mylo = myhi - 16;
    attn_init(st);
    kv_issue(stg, KW + (size_t)lo * 4096, VWT + (size_t)lo * 4096, L);
    kv_issue(stg + AT_STAGE, KW + (size_t)(lo + 1) * 4096, VWT + (size_t)(lo + 1) * 4096, L);
#pragma unroll 1
    for (int i = 0; i < nsteps; ++i) {
      const int kt = lo + i;
      if (i + 1 < nsteps) AT_WAIT_V(2); else AT_WAIT_V(0);
      AT_BAR();
      if (i + 2 < nsteps) kv_issue(stg + ((i + 2) % 3) * AT_STAGE, KW + (size_t)(kt + 2) * 4096, VWT + (size_t)(kt + 2) * 4096, L);
      if (kt >= mylo && kt <= myhi && t0 - (kt * 32 + 31) <= thr) {
        const LAS unsigned char* sg = stg + (i % 3) * AT_STAGE;
        f32x16 acc = score_tile_lds(qf, sg, L);
        float sc[16];
        const int key0 = kt * 32, d0 = tq - key0 - 4 * g;
        const float fb = slope2 * (float)d0;
#pragma unroll
        for (int q = 0; q < 16; ++q) sc[q] = fmaf(slope2, (float)((q & 3) + 8 * (q >> 2)), acc[q]) - fb;
        if (kt == mylo || kt == myhi) {
#pragma unroll
          for (int q = 0; q < 16; ++q) { const int dist = d0 - ((q & 3) + 8 * (q >> 2)); sc[q] = (dist >= 0 && dist < 512) ? sc[q] : NEG_INF; }
        }
        softmax_step_lds(st, sc, sg + 8192, L);
      }
    }
    stash_add(stw, st.o, attn_inv_l(st) * sigmoidf_(gt[2]));
  }
  unsigned long long uni;
  {
    unsigned lo32 = (unsigned)mymask, hi32 = (unsigned)(mymask >> 32);
#pragma unroll
    for (int o = 1; o < 32; o <<= 1) { lo32 |= shxu(lo32, o); hi32 |= shxu(hi32, o); }
    uni = ((unsigned long long)(unsigned)__builtin_amdgcn_readfirstlane((int)hi32) << 32) | (unsigned)__builtin_amdgcn_readfirstlane((int)lo32);
    const int mbw = t0 >> 6;
    uni &= (mbw >= 63) ? ~0ull : ((1ull << (mbw + 1)) - 1ull);
    if (lane == 0) { tl[160 + wave * 2] = (int)(unsigned)uni; tl[160 + wave * 2 + 1] = (int)(unsigned)(uni >> 32); }
  }
  AT_WAIT_L0();
  AT_BAR();
  {
    unsigned long long ub = 0ull;
#pragma unroll
    for (int w2 = 0; w2 < 8; w2 += 4) ub |= ((unsigned long long)(unsigned)tl[160 + w2 * 2 + 1] << 32) | (unsigned)tl[160 + w2 * 2];
    int n = 0;
    if (wave == 0 && lane == 0) {
      const int thrg = (int)(200.f / (exp2f(-0.5f * (float)(c.gk * 4 + 4)) * LOG2E)) + 1;
      for (int mb = 0; mb <= c.tile64; ++mb) if (((ub >> mb) & 1ull) && c.tile64 * 64 - (mb * 64 + 63) <= thrg) { tl[n++] = mb * 2; tl[n++] = mb * 2 + 1; }
      tl[159] = n;
    }
  }
  AT_WAIT_L0();
  AT_BAR();
  {
    const int nsteps = __builtin_amdgcn_readfirstlane(tl[159]);
    attn_init(st);
    if (nsteps > 0) { const int k0 = __builtin_amdgcn_readfirstlane(tl[0]); kv_issue(stg, KS + (size_t)k0 * 4096, VST + (size_t)k0 * 4096, L); }
    if (nsteps > 1) { const int k1 = __builtin_amdgcn_readfirstlane(tl[1]); kv_issue(stg + AT_STAGE, KS + (size_t)k1 * 4096, VST + (size_t)k1 * 4096, L); }
#pragma unroll 1
    for (int i = 0; i < nsteps; ++i) {
      const int kt = __builtin_amdgcn_readfirstlane(tl[i]);
      if (i + 1 < nsteps) AT_WAIT_V(2); else AT_WAIT_V(0);
      AT_BAR();
      if (i + 2 < nsteps) { const int k2 = __builtin_amdgcn_readfirstlane(tl[i + 2]); kv_issue(stg + ((i + 2) % 3) * AT_STAGE, KS + (size_t)k2 * 4096, VST + (size_t)k2 * 4096, L); }
      const int mb = kt >> 1, key0 = kt * 32;
      if (((uni >> mb) & 1ull) && key0 <= t0 + 31 && t0 - (key0 + 31) <= thr) {
        const bool mine = (mymask >> mb) & 1ull;
        const LAS unsigned char* sg = stg + (i % 3) * AT_STAGE;
        f32x16 acc = score_tile_lds(qf, sg, L);
        float sc[16];
        const int d0 = tq - key0 - 4 * g;
        const float fb = mine ? slope2 * (float)d0 : __builtin_inff();
#pragma unroll
        for (int q = 0; q < 16; ++q) sc[q] = fmaf(slope2, (float)((q & 3) + 8 * (q >> 2)), acc[q]) - fb;
        if (key0 >= t0) {
#pragma unroll
          for (int q = 0; q < 16; ++q) sc[q] = (d0 - ((q & 3) + 8 * (q >> 2)) >= 0) ? sc[q] : NEG_INF;
        }
        softmax_step_lds(st, sc, sg + 8192, L);
      }
    }
  }
  const float f = attn_inv_l(st) * sigmoidf_(gt[1]);
  bf16_t* orow = (bf16_t*)(p.ws + A_MIXO) + m * D_ + h * 128;
#pragma unroll
  for (int vt = 0; vt < 4; ++vt)
#pragma unroll
    for (int q = 0; q < 4; ++q) {
      const unsigned w0 = stw[(vt * 8 + q * 2) * 64], w1 = stw[(vt * 8 + q * 2 + 1) * 64];
      f32x4 v; v[0] = __uint_as_float(w0 << 16) + st.o[vt][q * 4] * f; v[1] = __uint_as_float(w0 & 0xffff0000u) + st.o[vt][q * 4 + 1] * f;
      v[2] = __uint_as_float(w1 << 16) + st.o[vt][q * 4 + 2] * f; v[3] = __uint_as_float(w1 & 0xffff0000u) + st.o[vt][q * 4 + 3] * f;
      st_bf16x4(orow + vt * 32 + q * 8 + 4 * g, v);
    }
  AT_WAIT_L0();
}
DI void nsa_task(const Params& p, int o_idx, int b, int gk, int tile64) {
  const NsaCtx c{b, gk, tile64, o_idx};
  nsa_cmp1(p, c);
  __syncthreads();
  nsa_cmp2(p, c);
  __syncthreads();
  nsa_topk(p, c);
  __syncthreads();
  nsa_winslc(p, c);
  __syncthreads();
}

DI void cmp2_task(const Params& p, int e, int kv, int rt) {
  const int lane = TIDX & 63, lr = lane & 31, g = lane >> 5;
  const int row = rt * 32 + lr;
  const float* SPL = (const float*)(p.ws + O_SPL) + (size_t)kv * 8 * 2048 * 256 + (size_t)row * 256 + g * 8;
  const float* bias = (const float*)(p.ws + A_BIAS1) + (e * 2 + kv) * 256 + g * 8;
  const bf16_t* W2 = (const bf16_t*)(p.ws + W_C2 + (size_t)(e * 2 + kv) * SZ_C2) + (size_t)lr * 256 + g * 8;
  f32x16 acc[4];
#pragma unroll
  for (int i = 0; i < 4; ++i) acc[i] = zero16();
#pragma unroll 2
  for (int ks = 0; ks < 16; ++ks) {
    f32x4 a0 = *(const f32x4*)(bias + ks * 16), a1 = *(const f32x4*)(bias + ks * 16 + 4);
#pragma unroll
    for (int sp = 0; sp < 8; ++sp) { const float* q = SPL + (size_t)sp * 2048 * 256 + ks * 16; a0 += *(const f32x4*)q; a1 += *(const f32x4*)(q + 4); }
    float hv[8];
#pragma unroll
    for (int i = 0; i < 4; ++i) { hv[i] = gelu_tanh(a0[i]); hv[4 + i] = gelu_tanh(a1[i]); }
    const bf16x8 hb = pack8(hv);
#pragma unroll
    for (int dt = 0; dt < 4; ++dt) { const bf16x8 w = *(const bf16x8*)(W2 + (size_t)dt * 32 * 256 + ks * 16); acc[dt] = mfma32(w, hb, acc[dt]); }
  }
  if (kv == 0) {
    float ss = 0.f;
#pragma unroll
    for (int dt = 0; dt < 4; ++dt)
#pragma unroll
      for (int i = 0; i < 16; ++i) ss += acc[dt][i] * acc[dt][i];
    ss = xhalf_sum(ss);
    const float rs = rsqrtf(ss * (1.f / 128.f) + EPS_);
    const float* gn = p.in[16] + (e * 3 + 0) * 128;
    bf16_t* orow = (bf16_t*)(p.ws + O_KCMP) + (size_t)row * 128;
#pragma unroll
    for (int dt = 0; dt < 4; ++dt)
#pragma unroll
      for (int q = 0; q < 4; ++q) {
        const int d0 = dt * 32 + q * 8 + 4 * g;
        const f32x4 gg = *(const f32x4*)(gn + d0);
        f32x4 v; for (int e2 = 0; e2 < 4; ++e2) v[e2] = acc[dt][q * 4 + e2] * rs * gg[e2];
        st_bf16x4(orow + d0, v);
      }
  } else {
    bf16_t* ob = (bf16_t*)(p.ws + O_VCMPT) + (size_t)(row >> 8) * 128 * 256 + (size_t)((row & 255) >> 5) * 4096 + (row & 31);
#pragma unroll
    for (int dt = 0; dt < 4; ++dt)
#pragma unroll
      for (int i = 0; i < 16; ++i) ob[(size_t)(dt * 32 + crow(i, g)) * 32] = f2bf(acc[dt][i]);
  }
}

DI void cmp_bias_jobs(const Params& p) {
  extern __shared__ __attribute__((aligned(16))) char dyn_lds[];
  float* red = (float*)dyn_lds;
  const int tid = TIDX, part = tid >> 5, cl = tid & 31;
  for (int it = (int)gridDim.x - 1 - (int)blockIdx.x; it < 32; it += gridDim.x) {
    const int job = it >> 3, cg8 = it & 7, l = job >> 1, kv = job & 1;
    const float* pe = p.in[kv ? 20 : 17] + (size_t)l * 4096;
    const float* w1 = p.in[kv ? 21 : 18] + (size_t)l * 4096 * 256;
    const int c = cg8 * 32 + cl;
    float s = 0.f;
#pragma unroll 8
    for (int k = part * 256; k < part * 256 + 256; ++k) s += pe[k] * w1[(size_t)k * 256 + c];
    red[part * 32 + cl] = s;
    __syncthreads();
    if (tid < 32) { float a = 0.f; for (int q = 0; q < 16; ++q) a += red[q * 32 + tid]; ((float*)(p.ws + A_BIAS1))[job * 256 + cg8 * 32 + tid] = a; }
    __syncthreads();
  }
}

#define XB_TMO      128
#define XB_XCNT(j)  (256  + 64 * (j))
#define XB_XSUB(j)  (1280 + 64 * (j))
#define XB_XGEN(j)  (2304 + 64 * (j))
#define XB_TOP      3328
#define XB_TOPGEN   3392
#define XCD_BAR_WORDS 3456
#define XB_SPIN_CAP (1u << 18)
DI unsigned xb_ld(unsigned* q)              { return __hip_atomic_load(q, __ATOMIC_RELAXED, __HIP_MEMORY_SCOPE_AGENT); }
DI unsigned xb_add(unsigned* q, unsigned v) { return __hip_atomic_fetch_add(q, v, __ATOMIC_RELAXED, __HIP_MEMORY_SCOPE_AGENT); }
DI unsigned xb_xcc_id() { return (unsigned)__builtin_amdgcn_s_getreg((3 << 11) | 20) & 0xFu; }
#define XB_SPIN(cond, bar) do { unsigned _sp = 0; while (cond) { __builtin_amdgcn_s_sleep(1); \
    if ((++_sp & 255u) == 0u) { if (xb_ld(&(bar)[XB_TMO])) break; if (_sp > XB_SPIN_CAP) { atomicAdd(&(bar)[XB_TMO], 1u); break; } } } } while (0)
struct XcdBarrier { unsigned* bar; unsigned x; volatile LAS unsigned* st; };
DI XcdBarrier xcd_barrier_post(unsigned* bar, volatile LAS unsigned* st) {
  XcdBarrier b; b.bar = bar; b.x = xb_xcc_id(); b.st = st;
  if (threadIdx.x == 0) (void)xb_add(&bar[XB_XCNT(b.x)], 1u);
  return b;
}
DI void xcd_barrier_complete(unsigned* bar, unsigned x, unsigned& nloc, unsigned& nx) {
  const unsigned G = gridDim.x * gridDim.y * gridDim.z;
  unsigned sum, cnt, mine, sp = 0u;
  for (;;) {
    sum = 0u; cnt = 0u; mine = 0u;
#pragma unroll
    for (unsigned j = 0; j < 16; ++j) { const unsigned c = xb_ld(&bar[XB_XCNT(j)]); sum += c; cnt += (c > 0u) ? 1u : 0u; mine = (j == x) ? c : mine; }
    if (sum == G) break;
    __builtin_amdgcn_s_sleep(1);
    if ((++sp & 255u) == 0u) { if (xb_ld(&bar[XB_TMO])) break; if (sp > XB_SPIN_CAP) { atomicAdd(&bar[XB_TMO], 1u); break; } }
  }
  nloc = mine > 0u ? mine : 1u; nx = cnt > 0u ? cnt : 1u;
}
DI void xcd_barrier(const XcdBarrier& b) {
  asm volatile("s_waitcnt vmcnt(0)" ::: "memory");
  __syncthreads();
  if (threadIdx.x == 0) {
    unsigned* bar = b.bar;
    __builtin_amdgcn_s_waitcnt(0);
    unsigned nloc = b.st[0], nx = b.st[1];
    if (nloc == 0u) { xcd_barrier_complete(bar, b.x, nloc, nx); b.st[0] = nloc; b.st[1] = nx; }
    const unsigned old = xb_add(&bar[XB_XSUB(b.x)], 1u);
    const unsigned gen = old / nloc;
    if (old + 1u == (gen + 1u) * nloc) {
      __builtin_amdgcn_fence(__ATOMIC_RELEASE, "agent");
      asm volatile("s_waitcnt vmcnt(0)" ::: "memory");
      const unsigned og = xb_add(&bar[XB_TOP], 1u);
      const unsigned tg = og / nx;
      if (og + 1u == (tg + 1u) * nx) xb_add(&bar[XB_TOPGEN], 1u);
      else XB_SPIN(xb_ld(&bar[XB_TOPGEN]) == tg, bar);
      __builtin_amdgcn_fence(__ATOMIC_ACQUIRE, "agent");
      xb_add(&bar[XB_XGEN(b.x)], 1u);
      asm volatile("s_waitcnt vmcnt(0)" ::: "memory");
    } else {
      XB_SPIN(xb_ld(&bar[XB_XGEN(b.x)]) == gen, bar);
      __builtin_amdgcn_fence(__ATOMIC_ACQUIRE, "agent");
      asm volatile("s_waitcnt vmcnt(0)" ::: "memory");
    }
  }
  __syncthreads();
}

#ifndef ONLY_KEY
#define ONLY_KEY (-1)
#endif
#define KEYOK(k) (ONLY_KEY < 0 || ONLY_KEY == (k))
constexpr int PH_PRE = 1, PH_PER_LAYER = 11, PH_TOTAL = PH_PRE + 4 * PH_PER_LAYER;

DI void run_phase(const Params& p0, int ph) {
  Params p = p0;
  { unsigned long long w_ = (unsigned long long)p0.ws; asm volatile("" : "+s"(w_)); p.ws = (unsigned char*)(__attribute__((address_space(1))) unsigned char*)w_; }
  unsigned char* ws = p.ws;
  if (ph == 0) {
    if (!KEYOK(0)) return;
    transpose_jobs(p);
    rmsnorm_rows(p.in[1], nullptr, (bf16_t*)(ws + A_MEMN), 512);
    xprep_rows(p.in[0], (bf16_t*)(ws + A_H), (float*)(ws + A_SSP), M_);
    cmp_bias_jobs(p);
    return;
  }
  const int layer = (ph - PH_PRE) / PH_PER_LAYER, sidx = (ph - PH_PRE) % PH_PER_LAYER;
  const int step = sidx < 6 ? sidx + 1 : (sidx < 9 ? sidx + 2 : sidx + 3);
  float* sspA = (float*)(ws + A_SSP); float* sspB = sspA + (size_t)M_ * 8; float* sspC = sspB + (size_t)M_ * 8;
  const bool even = (layer & 1) == 0; const int e = layer >> 1;
  const float* xin = layer == 0 ? p.in[0] : (const float*)(ws + A_XRES);
  float* xres = (float*)(ws + A_XRES);
  bf16_t* H = (bf16_t*)(ws + A_H);
  switch (step) {
    case 1:
      if (even) { if (KEYOK(4)) { EpiEvenIn epi{sspA, ws}; gemm_run(H, D_, (const bf16_t*)(ws + W_EIN + e * SZ_EIN), D_, M_, N_EIN, D_, epi); }
        if (layer == 0) { if (KEYOK(1)) { EpiMemKV epi{(bf16_t*)(ws + A_MEMK), (bf16_t*)(ws + A_MEMVT)};
          gemm_run((const bf16_t*)(ws + A_MEMN), D_, (const bf16_t*)(ws + W_MKV), D_, 512, 4096, D_, epi, 160); } } }
      else { if (KEYOK(18)) { EpiOddIn epi{sspA, ws}; gemm_run(H, D_, (const bf16_t*)(ws + W_OIN + e * SZ_OIN), D_, M_, N_OIN, D_, epi); } }
      break;
    case 2:
      if (even) {
        if (KEYOK(5)) {
        headnorm_rows((bf16_t*)(ws + E_FK), 16 * T_, p.in[10] + e * 128, 0, 0);
        if (layer == 0) for (int l = 0; l < 4; ++l) headnorm_rows((bf16_t*)(ws + A_MEMK) + (size_t)l * 8 * 256 * 128, 8 * 256, p.in[27] + l * 128, 0, 0);
        fox_cumsum(p, e);
        hgrn_prep(p, e);
        }
      } else {
        if (KEYOK(19)) {
        headnorm_rows((bf16_t*)(ws + O_KS), 8 * T_, p.in[16] + (e * 3 + 1) * 128, 0, 0);
        headnorm_rows((bf16_t*)(ws + O_KW), 8 * T_, p.in[16] + (e * 3 + 2) * 128, 0, 0);
#pragma unroll 1
        for (int c = 0; c < 16; ++c) {
          const int kv = c >> 3, sp = c & 7;
          EpiF32 epi{(float*)(ws + O_SPL) + (size_t)c * 2048 * 256, 256};
          gemm_run((const bf16_t*)(ws + (kv ? O_VC : O_KC)) + sp * 512, 2048, (const bf16_t*)(ws + W_C1 + (e * 2 + kv) * SZ_C1) + sp * 512, 4096, 2048, 256, 512, epi, c * 8);
        }
        }
      }
      break;
    case 3:
      if (even) {
        if (KEYOK(6)) {
          for (int bt = blockIdx.x; bt < 256; bt += gridDim.x) fox_block(p, e, bt >> 4, bt & 15);
        }
        if (KEYOK(7)) {
          const int wave = TIDX >> 6;
          for (int ti = wave * gridDim.x + blockIdx.x; ti < 4096; ti += 8 * gridDim.x) hgrn_u_task(p, ti >> 8, (ti >> 2) & 63, ti & 3);
        }
      } else {
        if (KEYOK(20)) { const int wave = TIDX >> 6; for (int ti = wave * gridDim.x + blockIdx.x; ti < 128; ti += 8 * gridDim.x) cmp2_task(p, e, ti >> 6, ti & 63); }
      }
      break;
    case 4:
      if (even) { if (KEYOK(8)) hgrn_scan(p); }
      break;
    case 5:
      if (even) {
        if (KEYOK(9)) { const int wave = TIDX >> 6; for (int ti = wave * gridDim.x + blockIdx.x; ti < 2048; ti += 8 * gridDim.x) hgrn_out_task(p, e, ti >> 7, (ti >> 1) & 63, ti & 1); }
      } else {
        if (KEYOK(22)) {
          extern __shared__ __attribute__((aligned(16))) char dyn_lds[];
          volatile LAS unsigned* qs = (volatile LAS unsigned*)((LAS unsigned char*)dyn_lds + NSA_LDS) + 2;
          unsigned* ctr = (unsigned*)(ws + A_BAR) + 3600 + 64 * e;
          for (;;) {
            if (threadIdx.x == 0) qs[0] = __hip_atomic_fetch_add(ctr, 1u, __ATOMIC_RELAXED, __HIP_MEMORY_SCOPE_AGENT);
            __syncthreads();
            const int q = __builtin_amdgcn_readfirstlane((int)qs[0]);
            __syncthreads();
            if (q >= 512) break;
            const int bg = q & 7;
            nsa_task(p, e, bg >> 2, bg & 3, 63 - (q >> 3));
          }
        }
      }
      break;
    case 6: if (KEYOK(10)) {
      EpiResid epi{xin, xres, H, sspB};
      gemm_run((const bf16_t*)(ws + A_MIXO), D_, (const bf16_t*)(ws + (even ? W_EOUT : W_OOUT) + e * SZ_SQ), D_, M_, D_, D_, epi);
    } break;
    case 8: if (KEYOK(11)) {
#pragma unroll 1
      for (int sp = 0; sp < 4; ++sp) {
        EpiBf16Tok epi{(bf16_t*)(ws + A_SCR) + (size_t)sp * M_ * 512, 512};
        gemm_run(H + sp * 512, D_, (const bf16_t*)(ws + W_MQ + layer * SZ_MQ) + sp * 512, D_, M_, 512, 512, epi, sp * 64);
      }
    } break;
    case 9:
      if (KEYOK(12)) { for (int bt = blockIdx.x; bt < 256; bt += gridDim.x) memattn_block(p, layer, bt >> 5, bt & 31); }
      break;
    case 10: if (KEYOK(10)) { EpiResid epi{xres, xres, H, sspC}; gemm_run((const bf16_t*)(ws + A_MAO), 512, (const bf16_t*)(ws + W_MO + layer * SZ_MQ), 512, M_, D_, 512, epi); } break;
    case 12: if (KEYOK(13)) { EpiSwiglu epi{sspC, (bf16_t*)(ws + F_HID)}; gemm_run(H, D_, (const bf16_t*)(ws + W_F13 + layer * SZ_F13), D_, M_, N_F13, D_, epi); } break;
    default: if (KEYOK(10)) { EpiResid epi{xres, layer == 3 ? p.out : xres, layer == 3 ? nullptr : H, layer == 3 ? nullptr : sspA}; gemm_run((const bf16_t*)(ws + F_HID), FFN_, (const bf16_t*)(ws + W_F2 + layer * SZ_F2), FFN_, M_, D_, FFN_, epi); } break;
  }
}

__global__ void __launch_bounds__(NTH) fwd_megakernel(Params p) {
#if ONE_LAUNCH
  cg::grid_group grid = cg::this_grid();
  extern __shared__ __attribute__((aligned(16))) char dyn_lds[];
  volatile LAS unsigned* xst = (volatile LAS unsigned*)((LAS unsigned char*)dyn_lds + NSA_LDS);
  if (threadIdx.x == 0) { xst[0] = 0u; xst[1] = 0u; xst[2] = 0u; xst[3] = 0u; }
  __syncthreads();
  const XcdBarrier xb = xcd_barrier_post((unsigned*)(p.ws + A_BAR), xst);
  for (int ph = p.ph_lo; ph < p.ph_hi; ++ph) {
    if (ph >= PH_PRE && (((ph - PH_PRE) / PH_PER_LAYER) & 1) == 1 && (ph - PH_PRE) % PH_PER_LAYER == 3) continue;
    run_phase(p, ph);
    if (ph + 1 < p.ph_hi) { if (ph == 0) grid.sync(); else xcd_barrier(xb); }
  }
#else
  for (int ph = p.ph_lo; ph < p.ph_hi; ++ph) run_phase(p, ph);
#endif
}

extern "C" void kernel_launch(void* const* d_in, const int* in_sizes, int n_in, void* d_out, int out_size, void* d_ws, size_t ws_size, hipStream_t stream) {
  static int grid_blocks = 0;
  constexpr size_t kDynLds = NSA_LDS + 16;
  if (grid_blocks == 0) {
    if (n_in != 31 || ws_size < WS_NEED) { fprintf(stderr, "kernel_launch: need 31 inputs and %zu workspace bytes; got %d, %zu\n", (size_t)WS_NEED, n_in, ws_size); grid_blocks = -1; return; }
    int dev = 0, cus = 0, per_cu = 0;
    hipGetDevice(&dev);
    hipDeviceGetAttribute(&cus, hipDeviceAttributeMultiprocessorCount, dev);
    hipFuncSetAttribute((const void*)fwd_megakernel, hipFuncAttributeMaxDynamicSharedMemorySize, (int)kDynLds);
    hipOccupancyMaxActiveBlocksPerMultiprocessor(&per_cu, (const void*)fwd_megakernel, NTH, kDynLds);
    if (per_cu < 1) per_cu = 1;
    grid_blocks = cus * per_cu;
    if (grid_blocks > 256) grid_blocks = 256;
  }
  if (grid_blocks < 0) return;
  hipMemsetAsync((unsigned char*)d_ws + A_BAR, 0, BAR_BYTES, stream);
  Params p{};
  for (int i = 0; i < 31; ++i) p.in[i] = (const float*)d_in[i];
  p.out = (float*)d_out; p.ws = (unsigned char*)d_ws;
#if ONE_LAUNCH
  p.ph_lo = 0; p.ph_hi = PH_TOTAL;
  void* args[] = {&p};
  hipError_t e = hipLaunchCooperativeKernel((const void*)fwd_megakernel, dim3(grid_blocks), dim3(NTH), args, kDynLds, stream);
  if (e != hipSuccess) fprintf(stderr, "cooperative launch failed: %s (grid %d)\n", hipGetErrorString(e), grid_blocks);
#else
  for (int ph = 0; ph < PH_TOTAL; ++ph) {
    p.ph_lo = ph; p.ph_hi = ph + 1;
    hipLaunchKernelGGL(fwd_megakernel, dim3(grid_blocks), dim3(NTH), kDynLds, stream, p);
  }
#endif
}
```
